# Optimizing an MI355X kernel written in HIP

```python
import jax, jax.numpy as jnp
from jax import lax
import numpy as np

D_MODEL = 2048
BATCH = 4
SEQ = 4096
DEPTH = 2

CTX_LEN = 256
GRID_W = 64

D_MIX = D_MODEL
POOL_WIDTH = D_MIX // 4
POOL_WINDOWS = (2, 4, 8, 16)
POOL_GROUPS = 4
FNET_WIDTH = D_MIX // 4
FNET_HEADS = 4
MLA_HEADS = 8
QK_NOPE_DIM = 128
QK_ROPE_DIM = 64
QK_HEAD_DIM = QK_NOPE_DIM + QK_ROPE_DIM
V_HEAD_DIM = 128
MLA_WIDTH = MLA_HEADS * V_HEAD_DIM
Q_LORA_RANK = D_MODEL // 4
KV_LORA_RANK = D_MODEL // 4
N_FREQ_PER_AXIS = QK_ROPE_DIM // 4
ROPE_THETA = 10000.0
EPS = 1e-6
Q_BLOCK = 128
SM_SCALE = QK_HEAD_DIM ** -0.5

OFF_POOL = 0
OFF_POOL_GATE = OFF_POOL + POOL_WIDTH
OFF_FNET = OFF_POOL_GATE + POOL_WIDTH
OFF_FNET_GATE = OFF_FNET + FNET_WIDTH
OFF_CQ = OFF_FNET_GATE + FNET_WIDTH
OFF_CKV = OFF_CQ + Q_LORA_RANK
OFF_KROPE = OFF_CKV + KV_LORA_RANK
OFF_MLA_GATE = OFF_KROPE + QK_ROPE_DIM
D_IN = OFF_MLA_GATE + MLA_WIDTH

kernel_name = 'hybrid_pool_fnet_mla_diffusion_block'


def _rmsnorm(x, w):
    xf = x.astype(jnp.float32)
    y = xf * lax.rsqrt(jnp.mean(xf * xf, axis=-1, keepdims=True) + EPS)
    return (y * w.astype(jnp.float32)).astype(x.dtype)


def _rotate_half(x):
    x1, x2 = jnp.split(x, 2, axis=-1)
    return jnp.concatenate([-x2, x1], axis=-1)


def _axial_rope_tables(n_tokens):
    rows = n_tokens // GRID_W
    r, col = jnp.meshgrid(jnp.arange(rows, dtype=jnp.float32),
                          jnp.arange(GRID_W, dtype=jnp.float32), indexing='ij')
    inv_freq = ROPE_THETA ** (-jnp.arange(N_FREQ_PER_AXIS, dtype=jnp.float32) / N_FREQ_PER_AXIS)
    ang_r = r.reshape(-1)[:, None] * inv_freq
    ang_c = col.reshape(-1)[:, None] * inv_freq
    ang = jnp.concatenate([ang_r, ang_r, ang_c, ang_c], axis=-1)
    return jnp.cos(ang), jnp.sin(ang)


def _apply_axial_rope(x, cos, sin):
    half = QK_ROPE_DIM // 2
    xf = x.astype(jnp.float32)
    rot = jnp.concatenate([_rotate_half(xf[..., :half]), _rotate_half(xf[..., half:])], axis=-1)
    return (xf * cos[:, None, :] + rot * sin[:, None, :]).astype(x.dtype)


def _rope_tail(x, cos, sin):
    return jnp.concatenate([x[..., :QK_NOPE_DIM], _apply_axial_rope(x[..., QK_NOPE_DIM:], cos, sin)], axis=-1)


def _window_mean_minus_self(x, w):
    n = x.shape[1]
    lo = w // 2
    hi = w - lo - 1
    xf = x.astype(jnp.float32)
    csum = jnp.concatenate([jnp.zeros_like(xf[:, :1]), jnp.cumsum(xf, axis=1)], axis=1)
    t = jnp.arange(n)
    start = jnp.clip(t - lo, 0, n)
    end = jnp.clip(t + hi + 1, 0, n)
    count = (end - start).astype(jnp.float32)[None, :, None]
    return ((csum[:, end] - csum[:, start]) / count - xf).astype(x.dtype)


def _pool_mixer(u, pool_w, pool_scale):
    b, n, _ = u.shape
    g = u.reshape(b, n, POOL_GROUPS, POOL_WIDTH // POOL_GROUPS)
    pooled = jnp.stack([_window_mean_minus_self(g[:, :, i], w) for i, w in enumerate(POOL_WINDOWS)], axis=2)
    y = jnp.einsum('blgc,gcd->blgd', pooled, pool_w).reshape(b, n, POOL_WIDTH)
    return y * pool_scale


def _fourier_mixer(u, fnet_w):
    b, n, _ = u.shape
    g = u.reshape(b, n, FNET_HEADS, FNET_WIDTH // FNET_HEADS).astype(jnp.float32)
    f = jnp.fft.fft2(g, axes=(1, 3), norm='ortho').real.astype(u.dtype)
    return jnp.einsum('blgc,gcd->blgd', f, fnet_w).reshape(b, n, FNET_WIDTH)


def _mla_q(p, q_norm_w, w_uq, q_head_norm_w):
    cq = _rmsnorm(p[..., OFF_CQ:OFF_CKV], q_norm_w)
    q = cq @ w_uq
    q = q.reshape(q.shape[0], q.shape[1], MLA_HEADS, QK_HEAD_DIM)
    return _rmsnorm(q, q_head_norm_w)


def _mla_kv(kv_in, kv_norm_w, w_ukv, k_head_norm_w):
    b, n, _ = kv_in.shape
    ckv = _rmsnorm(kv_in[..., :KV_LORA_RANK], kv_norm_w)
    k_rope = kv_in[..., KV_LORA_RANK:]
    kv = (ckv @ w_ukv).reshape(b, n, MLA_HEADS, QK_NOPE_DIM + V_HEAD_DIM)
    k_nope, v = kv[..., :QK_NOPE_DIM], kv[..., QK_NOPE_DIM:]
    k = jnp.concatenate([k_nope, jnp.broadcast_to(k_rope[:, :, None, :], (b, n, MLA_HEADS, QK_ROPE_DIM))], axis=-1)
    return _rmsnorm(k, k_head_norm_w), v


def _softmax_attend(q, k, v):
    s = jnp.einsum('bqhd,bkhd->bhqk', q, k).astype(jnp.float32) * SM_SCALE
    p = jax.nn.softmax(s, axis=-1).astype(v.dtype)
    return jnp.einsum('bhqk,bkhd->bqhd', p, v)


def _attend_blocked(q, k, v):
    b, n, h, dq = q.shape
    nb = n // Q_BLOCK
    qb = q.reshape(b, nb, Q_BLOCK, h, dq).transpose(1, 0, 2, 3, 4)
    o = lax.map(lambda blk: _softmax_attend(blk, k, v), qb)
    return o.transpose(1, 0, 2, 3, 4).reshape(b, n, h * V_HEAD_DIM)


def _mixer_concat(p, mla_out, pool_w, pool_scale, fnet_w):
    a = jax.nn.silu(p[..., OFF_POOL_GATE:OFF_FNET]) * _pool_mixer(p[..., OFF_POOL:OFF_POOL_GATE], pool_w, pool_scale)
    f = jax.nn.silu(p[..., OFF_FNET_GATE:OFF_CQ]) * _fourier_mixer(p[..., OFF_FNET:OFF_FNET_GATE], fnet_w)
    m = jax.nn.silu(p[..., OFF_MLA_GATE:D_IN]) * mla_out
    return jnp.concatenate([a, f, m], axis=-1)


def _layer(x, ctx, c, c_ctx, norm_w, w_ada, b_ada, w_in, pool_w, pool_scale, fnet_w,
           q_norm_w, w_uq, kv_norm_w, w_ukv, q_head_norm_w, k_head_norm_w, w_out, ctx_out):
    shift, scale, gate = jnp.split(jax.nn.silu(c) @ w_ada + b_ada, 3, axis=-1)
    shift_c, scale_c, gate_c = jnp.split(jax.nn.silu(c_ctx) @ w_ada + b_ada, 3, axis=-1)
    h = _rmsnorm(x, norm_w) * (1.0 + scale[:, None, :]) + shift[:, None, :]
    hc = _rmsnorm(ctx, norm_w) * (1.0 + scale_c) + shift_c

    if ctx_out:
        pc = hc @ w_in
        kvc_in = pc[..., OFF_CKV:OFF_MLA_GATE]
    else:
        kvc_in = hc @ w_in[:, OFF_CKV:OFF_MLA_GATE]
    k_c, v_c = _mla_kv(kvc_in, kv_norm_w, w_ukv, k_head_norm_w)

    p = h @ w_in
    cos, sin = _axial_rope_tables(x.shape[1])
    q = _rope_tail(_mla_q(p, q_norm_w, w_uq, q_head_norm_w), cos, sin)
    k_l, v_l = _mla_kv(p[..., OFF_CKV:OFF_MLA_GATE], kv_norm_w, w_ukv, k_head_norm_w)
    k_l = _rope_tail(k_l, cos, sin)
    attn = _attend_blocked(q, jnp.concatenate([k_c, k_l], axis=1), jnp.concatenate([v_c, v_l], axis=1))
    y = _mixer_concat(p, attn, pool_w, pool_scale, fnet_w) @ w_out
    x = x + gate[:, None, :] * y

    if ctx_out:
        q_c = _mla_q(pc, q_norm_w, w_uq, q_head_norm_w)
        attn_c = _softmax_attend(q_c, k_c, v_c).reshape(ctx.shape[0], ctx.shape[1], MLA_WIDTH)
        yc = _mixer_concat(pc, attn_c, pool_w, pool_scale, fnet_w) @ w_out
        ctx = ctx + gate_c * yc
    return x, ctx


def setup_inputs(seed: int = 0) -> dict:
    key = jax.random.key(seed)
    ks = jax.random.split(key, 20)
    f32 = jnp.float32
    nrm = lambda k, shape, s: jax.random.normal(k, shape, f32) * s
    gpc = POOL_WIDTH // POOL_GROUPS
    gfc = FNET_WIDTH // FNET_HEADS
    return {
        'x': nrm(ks[0], (BATCH, SEQ, D_MODEL), 1.0),
        'c': nrm(ks[1], (BATCH, D_MODEL), 1.0),
        'ctx': nrm(ks[2], (BATCH, CTX_LEN, D_MODEL), 1.0),
        'c_ctx': nrm(ks[3], (D_MODEL,), 1.0),
        'norm_w': 1.0 + nrm(ks[4], (DEPTH, D_MODEL), 0.02),
        'w_ada': nrm(ks[5], (DEPTH, D_MODEL, 3 * D_MODEL), 0.5 * D_MODEL ** -0.5),
        'b_ada': nrm(ks[6], (DEPTH, 3 * D_MODEL), 0.02),
        'w_in': nrm(ks[7], (DEPTH, D_MODEL, D_IN), D_MODEL ** -0.5),
        'pool_w': nrm(ks[8], (DEPTH, POOL_GROUPS, gpc, gpc), gpc ** -0.5),
        'pool_scale': 1.0 + nrm(ks[9], (DEPTH, POOL_WIDTH), 0.1),
        'fnet_w': nrm(ks[10], (DEPTH, FNET_HEADS, gfc, gfc), gfc ** -0.5),
        'q_norm_w': 1.0 + nrm(ks[11], (DEPTH, Q_LORA_RANK), 0.02),
        'w_uq': nrm(ks[12], (DEPTH, Q_LORA_RANK, MLA_HEADS * QK_HEAD_DIM), Q_LORA_RANK ** -0.5),
        'kv_norm_w': 1.0 + nrm(ks[13], (DEPTH, KV_LORA_RANK), 0.02),
        'w_ukv': nrm(ks[14], (DEPTH, KV_LORA_RANK, MLA_HEADS * (QK_NOPE_DIM + V_HEAD_DIM)), KV_LORA_RANK ** -0.5),
        'q_head_norm_w': 1.0 + nrm(ks[15], (DEPTH, QK_HEAD_DIM), 0.02),
        'k_head_norm_w': 1.0 + nrm(ks[16], (DEPTH, QK_HEAD_DIM), 0.02),
        'w_out': nrm(ks[17], (DEPTH, D_MIX, D_MODEL), D_MIX ** -0.5),
    }


def reference(x, c, ctx, c_ctx, norm_w, w_ada, b_ada, w_in, pool_w, pool_scale, fnet_w,
              q_norm_w, w_uq, kv_norm_w, w_ukv, q_head_norm_w, k_head_norm_w, w_out):
    for i in range(DEPTH):
        x, ctx = _layer(x, ctx, c, c_ctx, norm_w[i], w_ada[i], b_ada[i], w_in[i], pool_w[i], pool_scale[i],
                        fnet_w[i], q_norm_w[i], w_uq[i], kv_norm_w[i], w_ukv[i], q_head_norm_w[i],
                        k_head_norm_w[i], w_out[i], i < DEPTH - 1)
    return x
```

```cpp
#include <hip/hip_runtime.h>
#include <hip/hip_bf16.h>
#include <cstdio>
#include <cstdint>
#include <cmath>

#ifndef MK_ONE_LAUNCH
#define MK_ONE_LAUNCH 1
#endif
#ifndef REP_EJ
#define REP_EJ 0
#endif
#ifndef REP_F
#define REP_F 0
#endif
#ifndef REP_P
#define REP_P 0
#endif

constexpr int DM = 2048, NB = 4, SEQ = 4096, NL = 2, CTX = 256;
constexpr int MLAT = NB * SEQ, MCTX = NB * CTX, MT = MLAT + MCTX;
constexpr int DIN = 4160, NIN = 4352;
constexpr int OFF_POOL = 0, OFF_PGATE = 512, OFF_FNET = 1024, OFF_FGATE = 1536, OFF_CQ = 2048, OFF_CKV = 2560, OFF_KROPE = 3072, OFF_MGATE = 3136;
constexpr int NH = 8, DQK = 192, NQ = NH * DQK, NKV = NH * 256;
constexpr int PCSW = 2304;
constexpr int DPITCH = SEQ + 64;
constexpr float EPS = 1e-6f;

constexpr size_t al256(size_t x) { return (x + 255) / 256 * 256; }
constexpr size_t WS_CTL = 0, CTL_BYTES = 1u << 20;
constexpr size_t WS_MODS = WS_CTL + CTL_BYTES;
constexpr size_t WS_ROPE = WS_MODS + al256((size_t)NL * 5 * 6144 * 4);
constexpr size_t WS_SMB = WS_ROPE + al256(64 * 16 * 2 * 4);
constexpr size_t WS_WIN = WS_SMB + 256;
constexpr size_t WS_WUQ = WS_WIN + (size_t)NL * NIN * DM * 2;
constexpr size_t WS_WUKV = WS_WUQ + (size_t)NL * NQ * 512 * 2;
constexpr size_t WS_WOUT = WS_WUKV + (size_t)NL * NKV * 512 * 2;
constexpr size_t WS_FWAB = WS_WOUT + (size_t)NL * DM * DM * 2;
constexpr size_t WS_DCTX = WS_FWAB + (size_t)NL * 512 * 512 * 2;
constexpr size_t WS_HMIX = WS_DCTX + 2 * 256 * 256 * 2;
constexpr size_t WS_P = WS_HMIX + (size_t)MT * DM * 2;
constexpr size_t WS_Q = WS_P + (size_t)MT * NIN * 2;
constexpr size_t WS_KV = WS_Q + (size_t)MT * NQ * 2;
constexpr size_t WS_XTC = WS_KV + (size_t)MT * NKV * 2;
constexpr size_t WS_XTS = WS_XTC + (size_t)1280 * DPITCH * 2;
constexpr size_t WS_XTCC = WS_XTS + (size_t)1024 * DPITCH * 2;
constexpr size_t WS_XTSC = WS_XTCC + (size_t)1280 * 256 * 2;
constexpr size_t WS_PCS = WS_XTSC + (size_t)1024 * 256 * 2;
constexpr size_t WS_PCSC = WS_PCS + (size_t)4096 * PCSW * 2;
constexpr size_t WS_CTXN = WS_PCSC + (size_t)256 * PCSW * 2;
constexpr size_t WS_KH = WS_CTXN + (size_t)MCTX * DM * 4;
constexpr size_t WS_SS = WS_KH + (size_t)MT * NQ * 2;
constexpr size_t WS_RS = WS_SS + (size_t)MLAT * 32 * 4;
constexpr size_t WS_BIAS = WS_RS + al256((size_t)MT * 4);
constexpr size_t WS_SQ = WS_BIAS + al256((size_t)5 * NIN * 4);
constexpr size_t WS_RH = WS_SQ + (size_t)18 * MT * 4;
constexpr size_t WS_END = WS_RH + (size_t)MT * 8 * 4;
static_assert((size_t)2 * 2048 * 2176 * 2 <= (size_t)NIN * DM * 2, "layer-1 DFT matrices fit layer 0's WinT");
static_assert(WS_END <= (size_t)512 * 1024 * 1024, "workspace map exceeds 512 MiB");

#define LAS __attribute__((address_space(3)))
typedef unsigned short bf16_t;
typedef short bf16x8 __attribute__((ext_vector_type(8)));
typedef short s16x4 __attribute__((ext_vector_type(4)));
typedef float f32x4 __attribute__((ext_vector_type(4)));
typedef float f32x2 __attribute__((ext_vector_type(2)));
typedef float f32x16 __attribute__((ext_vector_type(16)));
typedef unsigned u32x4 __attribute__((ext_vector_type(4)));
typedef unsigned u32x2 __attribute__((ext_vector_type(2)));
#define RLX_AGENT __ATOMIC_RELAXED, __HIP_MEMORY_SCOPE_AGENT

__device__ __forceinline__ int lane_id() { int r; asm volatile("v_mbcnt_lo_u32_b32 %0, -1, 0\n\tv_mbcnt_hi_u32_b32 %0, -1, %0" : "=v"(r)); return r; }
__device__ __forceinline__ unsigned f2bf(float f) { unsigned u = __builtin_bit_cast(unsigned, f); return (u + 0x7fffu + ((u >> 16) & 1u)) >> 16; }
__device__ __forceinline__ unsigned pk2(float lo, float hi) { return f2bf(lo) | (f2bf(hi) << 16); }
__device__ __forceinline__ float bf2f(unsigned short h) { return __builtin_bit_cast(float, (unsigned)h << 16); }
__device__ __forceinline__ float bflo(unsigned w) { return __builtin_bit_cast(float, w << 16); }
__device__ __forceinline__ float bfhi(unsigned w) { return __builtin_bit_cast(float, w & 0xffff0000u); }
__device__ __forceinline__ float siluf(float v) { return v * __builtin_amdgcn_rcpf(1.f + __builtin_amdgcn_exp2f(-1.4426950408889634f * v)); }
template <int O> __device__ __forceinline__ float lane_xor(float v) {
    return __builtin_bit_cast(float, __builtin_amdgcn_ds_swizzle(__builtin_bit_cast(int, v), (O << 10) | 0x1f));
}
__device__ __forceinline__ float wave_sum(float v) {
    v += lane_xor<1>(v); v += lane_xor<2>(v); v += lane_xor<4>(v); v += lane_xor<8>(v); v += lane_xor<16>(v);
    auto rr = __builtin_amdgcn_permlane32_swap(__float_as_uint(v), __float_as_uint(v), false, false);
    return __uint_as_float(rr[0]) + __uint_as_float(rr[1]);
}
__device__ __forceinline__ float wave_max(float v) {
    v = fmaxf(v, lane_xor<1>(v)); v = fmaxf(v, lane_xor<2>(v)); v = fmaxf(v, lane_xor<4>(v)); v = fmaxf(v, lane_xor<8>(v)); v = fmaxf(v, lane_xor<16>(v));
    auto rr = __builtin_amdgcn_permlane32_swap(__float_as_uint(v), __float_as_uint(v), false, false);
    return fmaxf(__uint_as_float(rr[0]), __uint_as_float(rr[1]));
}
__device__ __forceinline__ void unpack8(const u32x4 w, float* f) {
    f[0] = bflo(w.x); f[1] = bfhi(w.x); f[2] = bflo(w.y); f[3] = bfhi(w.y); f[4] = bflo(w.z); f[5] = bfhi(w.z); f[6] = bflo(w.w); f[7] = bfhi(w.w);
}
__device__ __forceinline__ u32x4 pack8(const float* f) { u32x4 w; w.x = pk2(f[0], f[1]); w.y = pk2(f[2], f[3]); w.z = pk2(f[4], f[5]); w.w = pk2(f[6], f[7]); return w; }

namespace pg8 {
#define PG8_LAS __attribute__((address_space(3)))
constexpr int BM = 256, BK = 64, HALF = 128, HTB = HALF * BK * 2, STAGE_BYTES = 8 * HTB, NXCD = 8, WGM = 8;
__host__ __device__ __forceinline__ int lds_byte(int r, int c) { const int st = (r >> 4) * 2 + (c >> 5), rr = r & 15, cc = c & 31, ob = rr * 64 + cc * 2; return st * 1024 + (ob ^ (((ob >> 9) & 1) << 5)); }
__host__ __device__ __forceinline__ void stage_rc(int b, int& R, int& C) { const int st = b / 1024, sb = b % 1024, swz = sb ^ (((sb >> 9) & 1) << 5); R = (st >> 1) * 16 + swz / 64; C = (st & 1) * 32 + (swz % 64) / 2; }
__host__ __device__ __forceinline__ int perm32(int rho) { const int n = rho >> 4, i = rho & 15; return 8 * (i >> 2) + 4 * n + (i & 3); }

struct Unit { int pm, pn; };
struct Gemm { const bf16_t* A; const bf16_t* Bt; int lda, ldb, K, mper; long abatch; };

template <int WG_M> struct StaticOrderT {
    int nM, nN, nwg, G, c;
    __device__ void init(int nM_, int nN_, int G_, int c_) { nM = nM_; nN = nN_; nwg = nM * nN; G = G_; c = c_; }
    __device__ bool next(int i, Unit& u) const {
        const long L = (long)i * G + c; if (c < 0 || L >= nwg) return false;
        int wgid = (int)L; { const int q = nwg / NXCD, r = nwg % NXCD, xcd = wgid % NXCD, off = wgid / NXCD; wgid = (xcd < r ? xcd * (q + 1) : r * (q + 1) + (xcd - r) * q) + off; }
        const int nig = WG_M * nN, gid = wgid / nig, fm = gid * WG_M, rem = wgid - gid * nig;
        u.pm = fm + (rem % WG_M); u.pn = rem / WG_M; return true;
    }
};
typedef StaticOrderT<4> StaticOrder;
struct RangeOrder {
    int nM, nN, first, last, G, c;
    __device__ void init(int nM_, int nN_, int G_, int c_) { nM = nM_; nN = nN_; first = 0; last = nM_ * nN_; G = G_; c = (c_ >= 0 && c_ < G_) ? c_ : -1; }
    __device__ void init_range(int nM_, int nN_, int first_, int last_, int G_, int c_) { nM = nM_; nN = nN_; first = first_; last = last_; G = G_; c = (c_ >= 0 && c_ < G_) ? c_ : -1; }
    __device__ bool next(int i, Unit& u) const {
        if (c < 0) return false; const long L = (long)first + (long)i * G + c; if (L >= last) return false;
        u.pm = (int)(L % nM); u.pn = (int)(L / nM); return true;
    }
};

__device__ __forceinline__ unsigned cvt_pk_bf16(float lo, float hi) { unsigned r; asm volatile("v_cvt_pk_bf16_f32 %0, %1, %2" : "=v"(r) : "v"(lo), "v"(hi)); return r; }

struct Epi {
    static constexpr bool PERM = true, AFTER_DRAIN = false;
    int kind;
    bf16_t* O; int ldc; int rowoff; int cmul, cadd, csplit, cadd2;
    int mirror;
    bf16_t* xt_lat; bf16_t* xt_ctx;
    const float* kr2; bf16_t* kh; float* rh; const float* kw; const float* qwk; PG8_LAS float* part;
    const float* sq8; float* sqo;
    const float* rs; const float* bias;
    const bf16_t* P; const bf16_t* NY; const float* fw; int nseq, lgseq;
    const float* xin_lat; const float* xin_ctx; float* out_lat; float* out_ctx; const float* mods;
    const bf16_t* xbr;
    bf16_t* xb; const float* nw1; const float* sc1; float* ss;
    __device__ __forceinline__ void k4(f32x4 (&acc)[2][2][4][2], const Unit& u, int wr, int wc, int fr, int fq) const {
        const int row0 = u.pm * BM + wr * 64 + fr;
        const int cl0 = wc * 32 + 8 * fq;
        {
            const int h = u.pn, rowl0 = wr * 64 + fr;
#pragma unroll
            for (int ai = 0; ai < 2; ++ai) {
                float t[4][8], rr4[4];
#pragma unroll
                for (int m = 0; m < 4; ++m)
#pragma unroll
                    for (int k = 0; k < 8; ++k) t[m][k] = sq8[(size_t)k * MT + (row0 + ai * HALF + m * 16)];
#pragma unroll
                for (int m = 0; m < 4; ++m) rr4[m] = 1.0f / sqrtf((((t[m][0] + t[m][1]) + (t[m][2] + t[m][3])) + ((t[m][4] + t[m][5]) + (t[m][6] + t[m][7]))) * (1.f / 512.f) + EPS);
#pragma unroll
                for (int m = 0; m < 4; ++m) { const int rk = row0 + ai * HALF + m * 16; const float rr = rr4[m];
                    { const f32x4 v0 = acc[ai][1][m][0] * rr, v1 = acc[ai][1][m][1] * rr;
                      u32x4 w; w.x = cvt_pk_bf16(v0[0], v0[1]); w.y = cvt_pk_bf16(v0[2], v0[3]); w.z = cvt_pk_bf16(v1[0], v1[1]); w.w = cvt_pk_bf16(v1[2], v1[3]);
                      *(u32x4*)(O + (size_t)rk * ldc + h * 256 + HALF + cl0) = w; }
                    acc[ai][0][m][0] = acc[ai][0][m][0] * rr; acc[ai][0][m][1] = acc[ai][0][m][1] * rr;
                    const f32x4 k0 = acc[ai][0][m][0], k1 = acc[ai][0][m][1];
                    float sq = ((k0[0] * k0[0] + k0[1] * k0[1]) + (k0[2] * k0[2] + k0[3] * k0[3])) + ((k1[0] * k1[0] + k1[1] * k1[1]) + (k1[2] * k1[2] + k1[3] * k1[3]));
                    sq += lane_xor<16>(sq);
                    { auto pr = __builtin_amdgcn_permlane32_swap(__float_as_uint(sq), __float_as_uint(sq), false, false); sq = __uint_as_float(pr[0]) + __uint_as_float(pr[1]); }
                    if (fq == 0) part[wc * 256 + rowl0 + ai * HALF + m * 16] = sq; }
            }
            float krs[2][4];
#pragma unroll
            for (int ai = 0; ai < 2; ++ai)
#pragma unroll
                for (int m = 0; m < 4; ++m) { const int rk = row0 + ai * HALF + m * 16; typedef const __attribute__((address_space(1))) float* gfp;
                    krs[ai][m] = ((gfp)kr2)[rk] + ((gfp)kr2)[(size_t)MT + rk]; }
            asm volatile("s_waitcnt lgkmcnt(0)" ::: "memory");
            __builtin_amdgcn_s_barrier();
            const f32x4 kw0 = *(const f32x4*)(kw + cl0) * *(const f32x4*)(qwk + cl0), kw1 = *(const f32x4*)(kw + cl0 + 4) * *(const f32x4*)(qwk + cl0 + 4);
#pragma unroll
            for (int ai = 0; ai < 2; ++ai)
#pragma unroll
                for (int m = 0; m < 4; ++m) { const int rk = row0 + ai * HALF + m * 16, rl = rowl0 + ai * HALF + m * 16;
                    const float tot = ((part[rl] + part[256 + rl]) + (part[512 + rl] + part[768 + rl])) + krs[ai][m];
                    const float rhv = 1.0f / sqrtf(tot * (1.f / 192.f) + EPS);
                    if (wc == 0 && fq == 0) rh[(size_t)rk * 8 + h] = rhv;
                    const f32x4 k0 = acc[ai][0][m][0] * rhv * kw0, k1 = acc[ai][0][m][1] * rhv * kw1;
                    u32x4 w; w.x = cvt_pk_bf16(k0[0], k0[1]); w.y = cvt_pk_bf16(k0[2], k0[3]); w.z = cvt_pk_bf16(k1[0], k1[1]); w.w = cvt_pk_bf16(k1[2], k1[3]);
                    *(u32x4*)(kh + (size_t)rk * (8 * 192) + h * 192 + cl0) = w; }
        }
    }
    __device__ __forceinline__ void operator()(f32x4 (&acc)[2][2][4][2], const Unit& u, int wr, int wc, int fr, int fq) const {
        const int row0 = u.pm * BM + wr * 64 + fr;
        const int cl0 = wc * 32 + 8 * fq;
        if (kind == 0 && xt_lat && (u.pn == 4 || u.pn == 5)) {
            const bool lat = u.pm < MLAT / 256;
            const int b = lat ? (u.pm >> 4) : (u.pm - MLAT / 256);
            const int nseq = lat ? DPITCH : CTX;
            bf16_t* XC = lat ? xt_lat : xt_ctx; bf16_t* XS = XC + (size_t)1280 * nseq;
            const int tok0 = (lat ? (u.pm & 15) * 256 : 0) + wr * 64 + fr;
            float rv[2][4];
#pragma unroll
            for (int ai = 0; ai < 2; ++ai)
#pragma unroll
                for (int m = 0; m < 4; ++m) rv[ai][m] = rs ? rs[row0 + ai * HALF + m * 16] : 1.f;
#pragma unroll
            for (int bj = 0; bj < 2; ++bj) {
                const int n0 = (u.pn - 4) * BM + bj * HALF + cl0, g = n0 >> 7, j0 = n0 & 127;
                f32x4 bz[2]; bz[0] = (f32x4){0.f, 0.f, 0.f, 0.f}; bz[1] = bz[0];
                if (rs) { const float* bp = bias + (size_t)(lat ? b : 4) * NIN + u.pn * BM + bj * HALF + cl0; bz[0] = *(const f32x4*)bp; bz[1] = *(const f32x4*)(bp + 4); }
                bf16_t* base = (j0 < 64 ? XC + (size_t)(b * 256 + g * 64 + j0) * nseq : XS + (size_t)(b * 256 + g * 64 + (j0 - 64)) * nseq) + tok0;
                bf16_t* nyq = XC + (size_t)(1024 + b * 4 + g) * nseq + tok0;
#pragma unroll
                for (int ai = 0; ai < 2; ++ai)
#pragma unroll
                    for (int m = 0; m < 4; ++m) { const int to = ai * HALF + m * 16;
                        unsigned W[4];
#pragma unroll
                        for (int pq = 0; pq < 4; ++pq) { const int c0 = 2 * pq, c1 = 2 * pq + 1;
                            W[pq] = cvt_pk_bf16(acc[ai][bj][m][c0 >> 2][c0 & 3] * rv[ai][m] + bz[c0 >> 2][c0 & 3], acc[ai][bj][m][c1 >> 2][c1 & 3] * rv[ai][m] + bz[c1 >> 2][c1 & 3]); }
                        const int qi = fr & 3; const bool b0 = (qi & 1) != 0, b1 = (qi & 2) != 0;
#pragma unroll
                        for (int pq = 0; pq < 4; pq += 2) { const unsigned snd = b0 ? W[pq] : W[pq + 1];
                            const unsigned rcv = (unsigned)__builtin_amdgcn_update_dpp((int)snd, (int)snd, 0xB1, 0xf, 0xf, false);
                            if (b0) W[pq] = rcv; else W[pq + 1] = rcv; }
#pragma unroll
                        for (int pq = 0; pq < 2; ++pq) { const unsigned snd = b1 ? W[pq] : W[pq + 2];
                            const unsigned rcv = (unsigned)__builtin_amdgcn_update_dpp((int)snd, (int)snd, 0x4E, 0xf, 0xf, false);
                            if (b1) W[pq] = rcv; else W[pq + 2] = rcv; }
                        u32x2 o0, o1;
                        o0.x = __builtin_amdgcn_perm(W[1], W[0], 0x05040100u); o0.y = __builtin_amdgcn_perm(W[3], W[2], 0x05040100u);
                        o1.x = __builtin_amdgcn_perm(W[1], W[0], 0x07060302u); o1.y = __builtin_amdgcn_perm(W[3], W[2], 0x07060302u);
                        *(u32x2*)(base + (size_t)(2 * qi) * nseq + to - qi) = o0; *(u32x2*)(base + (size_t)(2 * qi + 1) * nseq + to - qi) = o1;
                        if (j0 == 64 && qi == 0) *(u32x2*)(nyq + to) = o0; }
            }
        } else if (kind == 0) {
            const int dcol = (u.pn < csplit ? u.pn * cmul + cadd : cadd2) + cl0;
            f32x4 bz[2][2];
#pragma unroll
            for (int bj = 0; bj < 2; ++bj) { bz[bj][0] = (f32x4){0.f, 0.f, 0.f, 0.f}; bz[bj][1] = bz[bj][0]; }
            if (rs) { const float* bp = bias + (size_t)(row0 < MLAT ? (row0 >> 12) : 4) * NIN + dcol;
#pragma unroll
                for (int bj = 0; bj < 2; ++bj) { bz[bj][0] = *(const f32x4*)(bp + bj * HALF); bz[bj][1] = *(const f32x4*)(bp + bj * HALF + 4); } }
            const bool wsq = sqo != nullptr && ((u.pn >= 8 && u.pn < 12) || (u.pn == 12 && wc < 2));
#pragma unroll
            for (int ai = 0; ai < 2; ++ai) {
                float rr4[4];
                if (sq8) {
                    float t[4][8];
#pragma unroll
                    for (int m = 0; m < 4; ++m)
#pragma unroll
                        for (int k = 0; k < 8; ++k) t[m][k] = sq8[(size_t)k * MT + (rowoff + row0 + ai * HALF + m * 16)];
#pragma unroll
                    for (int m = 0; m < 4; ++m) rr4[m] = 1.0f / sqrtf((((t[m][0] + t[m][1]) + (t[m][2] + t[m][3])) + ((t[m][4] + t[m][5]) + (t[m][6] + t[m][7]))) * (1.f / 512.f) + EPS);
                } else {
#pragma unroll
                    for (int m = 0; m < 4; ++m) rr4[m] = rs ? rs[rowoff + row0 + ai * HALF + m * 16] : 1.f;
                }
#pragma unroll
                for (int m = 0; m < 4; ++m) { const int rk = rowoff + row0 + ai * HALF + m * 16; bf16_t* rowp = O + (size_t)rk * ldc + dcol;
                    bf16_t* mirp = O + (size_t)(SEQ - rk) * ldc + dcol; const unsigned sx = (mirror < 0) ? 0x80008000u : 0u;
                    const float rr = rr4[m]; float sq = 0.f;
#pragma unroll
                    for (int bj = 0; bj < 2; ++bj) { const f32x4 v0 = acc[ai][bj][m][0] * rr + bz[bj][0], v1 = acc[ai][bj][m][1] * rr + bz[bj][1];
                        u32x4 w; w.x = cvt_pk_bf16(v0[0], v0[1]); w.y = cvt_pk_bf16(v0[2], v0[3]); w.z = cvt_pk_bf16(v1[0], v1[1]); w.w = cvt_pk_bf16(v1[2], v1[3]);
                        const bool st = dcol + bj * HALF < DIN && !(mirror > 0 && u.pn >= csplit && cl0 + bj * HALF >= 16);
                        if (st) *(u32x4*)(rowp + bj * HALF) = w;
                        if (st && mirror != 0 && rk > 0) { u32x4 wm; wm.x = w.x ^ sx; wm.y = w.y ^ sx; wm.z = w.z ^ sx; wm.w = w.w ^ sx; *(u32x4*)(mirp + bj * HALF) = wm; }
                        if (wsq && (u.pn != 12 || bj == 0)) sq += ((v0[0] * v0[0] + v0[1] * v0[1]) + (v0[2] * v0[2] + v0[3] * v0[3])) + ((v1[0] * v1[0] + v1[1] * v1[1]) + (v1[2] * v1[2] + v1[3] * v1[3])); }
                    if (wsq) { sq += lane_xor<16>(sq);
                        { auto pr = __builtin_amdgcn_permlane32_swap(__float_as_uint(sq), __float_as_uint(sq), false, false); sq = __uint_as_float(pr[0]) + __uint_as_float(pr[1]); }
                        if (fq == 0) sqo[(size_t)((u.pn - 8) * 4 + wc) * MT + rk] = sq; } }
            }
        } else if (kind == 1) {
#pragma unroll
            for (int bj = 0; bj < 2; ++bj) {
                const int n0 = u.pn * BM + bj * HALF + cl0;
                const int g = n0 >> 7, d0 = n0 & 127;
                const f32x4 f0 = *(const f32x4*)(fw + (size_t)(g * 128 + 64) * 128 + d0), f1 = *(const f32x4*)(fw + (size_t)(g * 128 + 64) * 128 + d0 + 4);
                u32x4 gw[2][4]; unsigned short nyb[2][4];
#pragma unroll
                for (int ai = 0; ai < 2; ++ai)
#pragma unroll
                    for (int m = 0; m < 4; ++m) { const int rl = row0 + ai * HALF + m * 16; const int b = rl >> lgseq, k = rl & (nseq - 1);
                        nyb[ai][m] = NY[(size_t)k * PCSW + 2048 + b * 4 + g]; gw[ai][m] = *(const u32x4*)(P + ((size_t)rowoff + rl) * NIN + OFF_FGATE + n0); }
                asm volatile("" ::: "memory");
#pragma unroll
                for (int ai = 0; ai < 2; ++ai)
#pragma unroll
                    for (int m = 0; m < 4; ++m) {
                        const size_t R = (size_t)rowoff + row0 + ai * HALF + m * 16;
                        const float ny = bf2f(nyb[ai][m]);
                        float gt[8]; unpack8(gw[ai][m], gt);
                        const f32x4 v0 = acc[ai][bj][m][0], v1 = acc[ai][bj][m][1];
                        float o[8];
#pragma unroll
                        for (int e = 0; e < 4; ++e) { o[e] = (v0[e] + ny * f0[e]) * siluf(gt[e]); o[4 + e] = (v1[e] + ny * f1[e]) * siluf(gt[4 + e]); }
                        u32x4 w; w.x = cvt_pk_bf16(o[0], o[1]); w.y = cvt_pk_bf16(o[2], o[3]); w.z = cvt_pk_bf16(o[4], o[5]); w.w = cvt_pk_bf16(o[6], o[7]);
                        *(u32x4*)(O + R * ldc + 512 + n0) = w;
                    }
                asm volatile("" ::: "memory");
            }
        } else if (kind == 3) {
#pragma unroll
            for (int ai = 0; ai < 2; ++ai)
#pragma unroll
                for (int m = 0; m < 4; ++m) { float* xo = out_ctx + (size_t)(row0 + ai * HALF + m * 16) * DM + u.pn * BM + cl0;
#pragma unroll
                    for (int bj = 0; bj < 2; ++bj)
#pragma unroll
                        for (int n = 0; n < 2; ++n) *(f32x4*)(xo + bj * HALF + 4 * n) = acc[ai][bj][m][n]; }
        } else {
            const int R0 = row0;
            const bool lat = R0 < MLAT;
            const int mr = lat ? (R0 >> 12) : 4;
            const float* xi0 = (lat ? xin_lat + (size_t)R0 * DM : xin_ctx + (size_t)(R0 - MLAT) * DM) + u.pn * BM + cl0;
            float* xo0 = (lat ? out_lat + (size_t)R0 * DM : out_ctx + (size_t)(R0 - MLAT) * DM) + u.pn * BM + cl0;
            const float* gp = mods + (size_t)mr * 6144 + 4096 + u.pn * BM + cl0;
            f32x4 gv[2][2], cf[2][2];
#pragma unroll
            for (int bj = 0; bj < 2; ++bj)
#pragma unroll
                for (int n = 0; n < 2; ++n) { gv[bj][n] = *(const f32x4*)(gp + bj * HALF + 4 * n); cf[bj][n] = gv[bj][n]; }
            if (xb || xbr) { const float* n1 = nw1 + u.pn * BM + cl0; const float* s1 = sc1 + (size_t)mr * 6144 + u.pn * BM + cl0;
#pragma unroll
                for (int bj = 0; bj < 2; ++bj)
#pragma unroll
                    for (int n = 0; n < 2; ++n) cf[bj][n] = *(const f32x4*)(n1 + bj * HALF + 4 * n) * (*(const f32x4*)(s1 + bj * HALF + 4 * n) + 1.f); }
            if (xb) {
#pragma unroll
                for (int ch = 0; ch < 3; ++ch) {
                    constexpr int NCH = 3;
                    f32x4 xv[NCH][2][2];
#pragma unroll
                    for (int mm = 0; mm < NCH; ++mm) { const int q = ch * NCH + mm; if (q < 8) { const int ai = q >> 2, m = q & 3;
#pragma unroll
                            for (int bj = 0; bj < 2; ++bj)
#pragma unroll
                                for (int n = 0; n < 2; ++n) xv[mm][bj][n] = *(const f32x4*)(xi0 + (size_t)(ai * HALF + m * 16) * DM + bj * HALF + 4 * n); } }
                    asm volatile("" ::: "memory");
#pragma unroll
                    for (int mm = 0; mm < NCH; ++mm) { const int q = ch * NCH + mm; if (q < 8) { const int ai = q >> 2, m = q & 3; const size_t R = (size_t)(R0 + ai * HALF + m * 16); float sq = 0.f;
#pragma unroll
                            for (int bj = 0; bj < 2; ++bj) { const f32x4 o0 = xv[mm][bj][0] + gv[bj][0] * acc[ai][bj][m][0], o1 = xv[mm][bj][1] + gv[bj][1] * acc[ai][bj][m][1];
                                sq += ((o0[0] * o0[0] + o0[1] * o0[1]) + (o0[2] * o0[2] + o0[3] * o0[3])) + ((o1[0] * o1[0] + o1[1] * o1[1]) + (o1[2] * o1[2] + o1[3] * o1[3]));
                                const f32x4 h0 = o0 * cf[bj][0], h1 = o1 * cf[bj][1];
                                u32x4 w; w.x = cvt_pk_bf16(h0[0], h0[1]); w.y = cvt_pk_bf16(h0[2], h0[3]); w.z = cvt_pk_bf16(h1[0], h1[1]); w.w = cvt_pk_bf16(h1[2], h1[3]);
                                *(u32x4*)(xb + R * DM + u.pn * BM + cl0 + bj * HALF) = w; }
                            sq += lane_xor<16>(sq);
                            { auto pr = __builtin_amdgcn_permlane32_swap(__float_as_uint(sq), __float_as_uint(sq), false, false); sq = __uint_as_float(pr[0]) + __uint_as_float(pr[1]); }
                            if (fq == 0) ss[(size_t)(u.pn * 4 + wc) * MLAT + R] = sq; } }
                    asm volatile("" ::: "memory");
                }
            } else {
                f32x4 rcf[2][2];
#pragma unroll
                for (int bj = 0; bj < 2; ++bj)
#pragma unroll
                    for (int n = 0; n < 2; ++n)
#pragma unroll
                        for (int e = 0; e < 4; ++e) rcf[bj][n][e] = cf[bj][n][e] != 0.f ? __builtin_amdgcn_rcpf(cf[bj][n][e]) : 0.f;
                const bf16_t* xr0 = xbr + (size_t)R0 * DM + u.pn * BM + cl0;
#pragma unroll
            for (int ai = 0; ai < 2; ++ai) {
                u32x4 xw[4][2];
#pragma unroll
                for (int m = 0; m < 4; ++m)
#pragma unroll
                    for (int bj = 0; bj < 2; ++bj) xw[m][bj] = *(const u32x4*)(xr0 + (size_t)(ai * HALF + m * 16) * DM + bj * HALF);
                asm volatile("" ::: "memory");
#pragma unroll
                for (int m = 0; m < 4; ++m)
#pragma unroll
                    for (int bj = 0; bj < 2; ++bj) { float xf[8]; unpack8(xw[m][bj], xf);
                        const f32x4 x0 = {xf[0], xf[1], xf[2], xf[3]}, x1 = {xf[4], xf[5], xf[6], xf[7]};
                        *(f32x4*)(xo0 + (size_t)(ai * HALF + m * 16) * DM + bj * HALF) = x0 * rcf[bj][0] + gv[bj][0] * acc[ai][bj][m][0];
                        *(f32x4*)(xo0 + (size_t)(ai * HALF + m * 16) * DM + bj * HALF + 4) = x1 * rcf[bj][1] + gv[bj][1] * acc[ai][bj][m][1]; }
                asm volatile("" ::: "memory");
            }
            }
        }
    }
};

struct Epi4 {
    static constexpr bool PERM = true, AFTER_DRAIN = false;
    Epi e;
    __device__ __forceinline__ void prefetch(const Unit&, int, PG8_LAS unsigned char*) const {}
    __device__ __forceinline__ void operator()(f32x4 (&acc)[2][2][4][2], const Unit& u, int wr, int wc, int fr, int fq) const { e.k4(acc, u, wr, wc, fr, fq); }
};

template <class Epi, class Sched, bool ALIGN_EPI = false, bool SP2 = false>
__device__ __forceinline__ void gemm_phase(PG8_LAS unsigned char* lds, const Gemm g, const Sched& S, const Epi& E, int wave_) {
    int tid_ = wave_ * 64 + lane_id(); asm volatile("" : "+v"(tid_));
    const int tid = tid_, wid = __builtin_amdgcn_readfirstlane(tid >> 6), lane = tid & 63, wr = wid >> 2, wc = wid & 3, fr = lane & 15, fq = lane >> 4;
    const int K = g.K, nt = K / BK;
    unsigned voffA[2], voffB[2];
#pragma unroll
    for (int i = 0; i < 2; ++i) { int R, C; stage_rc(tid * 16 + i * 8192, R, C); const int Rb = Epi::PERM ? ((R & ~31) + perm32(R & 31)) : R;
        voffA[i] = (unsigned)(R * g.lda + C) * 2u; voffB[i] = (unsigned)(Rb * g.ldb + C) * 2u; }
    const size_t kstep = (size_t)(BK * 2);
    const size_t hA = (size_t)HALF * g.lda * 2, hB = (size_t)HALF * g.ldb * 2;
    const unsigned ldsw = (unsigned)wid * 1024u;
    const int aoff = lds_byte(wr * 64 + fr, fq * 8), boff = lds_byte(wc * 32 + fr, fq * 8);
#define PG8_TA(pm) ((const char*)g.A + ((size_t)((pm) % g.mper) * 2 * hA + (size_t)((pm) / g.mper) * (size_t)g.abatch * 2))
#define PG8_TB(pn) ((const char*)g.Bt + (size_t)(pn) * 2 * hB)
#define PG8_SA(b, h) (((b) * 2 + (h)) * HTB)
#define PG8_SB(b, h) ((4 + (b) * 2 + (h)) * HTB)
#define PG8_STAGE(bufoff, gbase, voff) do { _Pragma("unroll") for (int _i = 0; _i < 2; ++_i) \
        __builtin_amdgcn_global_load_lds((const unsigned*)((const char*)(gbase) + (voff)[_i]), (PG8_LAS unsigned*)(lds + (bufoff) + ldsw + _i * 8192), 16, 0, 0); } while (0)
#define PG8_LDA(dst, b, h) do { _Pragma("unroll") for (int m = 0; m < 4; ++m) _Pragma("unroll") for (int k = 0; k < 2; ++k) dst[m][k] = *(const PG8_LAS bf16x8*)(lds + PG8_SA(b, h) + aoff + m * 2048 + k * 1024); } while (0)
#define PG8_LDB(dst, b, h) do { _Pragma("unroll") for (int n = 0; n < 2; ++n) _Pragma("unroll") for (int k = 0; k < 2; ++k) dst[n][k] = *(const PG8_LAS bf16x8*)(lds + PG8_SB(b, h) + boff + n * 2048 + k * 1024); } while (0)
#define PG8_MMA(ai, bj, At, Bt) do { __builtin_amdgcn_s_setprio(1); _Pragma("unroll") for (int m = 0; m < 4; ++m) _Pragma("unroll") for (int n = 0; n < 2; ++n) _Pragma("unroll") for (int k = 0; k < 2; ++k) \
        acc[ai][bj][m][n] = __builtin_amdgcn_mfma_f32_16x16x32_bf16(Bt[n][k], At[m][k], acc[ai][bj][m][n], 0, 0, 0); __builtin_amdgcn_s_setprio(0); } while (0)
#define PG8_WAIT_V(n) asm volatile("s_waitcnt vmcnt(" #n ")" ::: "memory")
#define PG8_WAIT_L(n) asm volatile("s_waitcnt lgkmcnt(" #n ")" ::: "memory")
#define PG8_BAR __builtin_amdgcn_s_barrier()
#define PG8_SCHED __builtin_amdgcn_sched_barrier(0)
    Unit cur, nxt; int ui = 0;
    if (!S.next(0, cur)) return;
    f32x4 acc[2][2][4][2];
#pragma unroll
    for (int a = 0; a < 2; ++a)
#pragma unroll
        for (int b = 0; b < 2; ++b)
#pragma unroll
            for (int m = 0; m < 4; ++m)
#pragma unroll
                for (int n = 0; n < 2; ++n) acc[a][b][m][n] = (f32x4){0.f, 0.f, 0.f, 0.f};
    bf16x8 At[4][2], B0[2][2], B1[2][2];
    const char* cA = PG8_TA(cur.pm); const char* cB = PG8_TB(cur.pn);
    if constexpr (SP2) {
        PG8_STAGE(PG8_SB(0, 0), cB, voffB); PG8_STAGE(PG8_SB(0, 1), cB + hB, voffB); PG8_STAGE(PG8_SA(0, 0), cA, voffA); PG8_STAGE(PG8_SA(0, 1), cA + hA, voffA);
        if (wr == 1) PG8_BAR;
        PG8_WAIT_V(2); PG8_BAR;
        PG8_STAGE(PG8_SB(1, 0), cB + kstep, voffB); PG8_STAGE(PG8_SA(1, 0), cA + kstep, voffA); PG8_STAGE(PG8_SB(1, 1), cB + hB + kstep, voffB);
        PG8_WAIT_V(6); PG8_BAR;
    } else {
        PG8_STAGE(PG8_SB(0, 0), cB, voffB); PG8_STAGE(PG8_SA(0, 0), cA, voffA); PG8_STAGE(PG8_SB(0, 1), cB + hB, voffB); PG8_STAGE(PG8_SA(0, 1), cA + hA, voffA);
        if (wr == 1) PG8_BAR;
        PG8_WAIT_V(4); PG8_BAR;
        PG8_STAGE(PG8_SB(1, 0), cB + kstep, voffB); PG8_STAGE(PG8_SA(1, 0), cA + kstep, voffA); PG8_STAGE(PG8_SB(1, 1), cB + hB + kstep, voffB);
        PG8_WAIT_V(6); PG8_BAR;
    }
    for (;;) {
        const bool has_next = S.next(ui + 1, nxt);
        const char* nA = has_next ? PG8_TA(nxt.pm) : cA; const char* nB = has_next ? PG8_TB(nxt.pn) : cB;
        for (int t = 0; t < nt; t += 2) {
            const bool last = (t == nt - 2);
            const char* a1 = cA + (size_t)(t + 1) * kstep;
            const char* a2 = last ? nA : cA + (size_t)(t + 2) * kstep; const char* b2 = last ? nB : cB + (size_t)(t + 2) * kstep;
            const char* a3 = a2 + kstep; const char* b3 = b2 + kstep;
            if constexpr (SP2) {
            PG8_LDB(B0, 0, 0); PG8_LDB(B1, 0, 1); PG8_SCHED; PG8_LDA(At, 0, 0); PG8_STAGE(PG8_SA(1, 1), a1 + hA, voffA);
            PG8_WAIT_V(8); PG8_WAIT_L(0); PG8_BAR; PG8_MMA(0, 0, At, B0); PG8_MMA(0, 1, At, B1); PG8_BAR; PG8_SCHED;
            PG8_LDA(At, 0, 1); PG8_STAGE(PG8_SB(0, 0), b2, voffB); PG8_STAGE(PG8_SB(0, 1), b2 + hB, voffB); PG8_STAGE(PG8_SA(0, 0), a2, voffA);
            PG8_WAIT_V(8); PG8_WAIT_L(0); PG8_BAR; PG8_MMA(1, 0, At, B0); PG8_MMA(1, 1, At, B1); PG8_BAR; PG8_SCHED;
            PG8_LDB(B0, 1, 0); PG8_LDB(B1, 1, 1); PG8_SCHED; PG8_LDA(At, 1, 0); PG8_STAGE(PG8_SA(0, 1), a2 + hA, voffA);
            PG8_WAIT_V(8); PG8_WAIT_L(0); PG8_BAR; PG8_MMA(0, 0, At, B0); PG8_MMA(0, 1, At, B1); PG8_BAR; PG8_SCHED;
            PG8_LDA(At, 1, 1); PG8_STAGE(PG8_SB(1, 0), b3, voffB); PG8_STAGE(PG8_SB(1, 1), b3 + hB, voffB); PG8_STAGE(PG8_SA(1, 0), a3, voffA);
            PG8_WAIT_V(8); PG8_WAIT_L(0); PG8_BAR; PG8_MMA(1, 0, At, B0); PG8_MMA(1, 1, At, B1); PG8_BAR; PG8_SCHED;
            } else {
            PG8_LDB(B0, 0, 0); PG8_SCHED; PG8_LDA(At, 0, 0); PG8_STAGE(PG8_SA(1, 1), a1 + hA, voffA);
            PG8_WAIT_L(8); PG8_BAR; PG8_WAIT_L(0); PG8_MMA(0, 0, At, B0); PG8_BAR; PG8_SCHED;
            PG8_LDB(B1, 0, 1); PG8_STAGE(PG8_SB(0, 0), b2, voffB);
            PG8_BAR; PG8_WAIT_L(0); PG8_MMA(0, 1, At, B1); PG8_BAR;
            PG8_LDA(At, 0, 1); PG8_STAGE(PG8_SA(0, 0), a2, voffA);
            PG8_BAR; PG8_WAIT_L(0); PG8_MMA(1, 0, At, B0); PG8_BAR; PG8_SCHED;
            PG8_STAGE(PG8_SB(0, 1), b2 + hB, voffB);
            PG8_WAIT_V(6); PG8_BAR; PG8_MMA(1, 1, At, B1); PG8_BAR;
            PG8_LDB(B0, 1, 0); PG8_SCHED; PG8_LDA(At, 1, 0); PG8_STAGE(PG8_SA(0, 1), a2 + hA, voffA);
            PG8_WAIT_L(8); PG8_BAR; PG8_WAIT_L(0); PG8_MMA(0, 0, At, B0); PG8_BAR; PG8_SCHED;
            PG8_LDB(B1, 1, 1); PG8_STAGE(PG8_SB(1, 0), b3, voffB);
            PG8_BAR; PG8_WAIT_L(0); PG8_MMA(0, 1, At, B1); PG8_BAR;
            PG8_LDA(At, 1, 1); PG8_STAGE(PG8_SA(1, 0), a3, voffA);
            PG8_BAR; PG8_WAIT_L(0); PG8_MMA(1, 0, At, B0); PG8_BAR; PG8_SCHED;
            PG8_STAGE(PG8_SB(1, 1), b3 + hB, voffB);
            PG8_WAIT_V(6); PG8_BAR; PG8_MMA(1, 1, At, B1); PG8_BAR;
            }
        }
        if constexpr (ALIGN_EPI) { if (wr == 0) PG8_BAR; }
        { int te_ = wave_ * 64 + lane_id(); asm volatile("" : "+v"(te_));
          E(acc, cur, wr, wc, te_ & 15, (te_ & 63) >> 4); }
        if (!has_next) break;
#pragma unroll
        for (int a = 0; a < 2; ++a)
#pragma unroll
            for (int b = 0; b < 2; ++b)
#pragma unroll
                for (int m = 0; m < 4; ++m)
#pragma unroll
                    for (int n = 0; n < 2; ++n) acc[a][b][m][n] = (f32x4){0.f, 0.f, 0.f, 0.f};
        cur = nxt; cA = nA; cB = nB; ++ui;
        if constexpr (ALIGN_EPI) { if (wr == 1) PG8_BAR; }
    }
    PG8_WAIT_V(0);
    if constexpr (!ALIGN_EPI) { if (wr == 0) PG8_BAR; }
    PG8_BAR;
#undef PG8_TA
#undef PG8_TB
#undef PG8_SA
#undef PG8_SB
#undef PG8_STAGE
#undef PG8_LDA
#undef PG8_LDB
#undef PG8_MMA
#undef PG8_WAIT_V
#undef PG8_WAIT_L
#undef PG8_BAR
#undef PG8_SCHED
}
}

namespace att {
constexpr int NW = 8, QBLK = 32, KVBLK = 64;
constexpr float SCALE = 0.07216878364870322f;
#ifndef ATT_SDEPTH
#define ATT_SDEPTH 1
#endif
constexpr int SDEPTH = ATT_SDEPTH;
#ifndef ATT_QKT_GRP
#define ATT_QKT_GRP 4
#endif
constexpr int QKT_GRP = ATT_QKT_GRP;
constexpr int LDQ = NQ, LDKK = NQ, LDV = NKV;
constexpr int KPITCH = 400;
constexpr int SHM_V = KVBLK * 128 * 2, SHM_K = KVBLK * KPITCH;
constexpr int SHM_QR = 2 * SHM_V + 2 * SHM_K + NW * 64 * 4;
#ifndef ATT_NQR
#define ATT_NQR 6
#endif
constexpr int NQR = ATT_NQR, QLB = (12 - NQR) * 1024;
constexpr int SHM_ATTN = SHM_QR + NW * QLB;
#define KSWZ(row, colB) ((row) * KPITCH + (colB))
#define SBAR() __builtin_amdgcn_sched_barrier(0)
__device__ __forceinline__ int crow(int r, int hi) { return (r & 3) + 8 * (r >> 2) + 4 * hi; }
__device__ __forceinline__ unsigned cvtpk(float lo, float hi) { unsigned r; asm volatile("v_cvt_pk_bf16_f32 %0, %1, %2" : "=v"(r) : "v"(lo), "v"(hi)); return r; }

__device__ __forceinline__ void partialSM(f32x16& p0, f32x16& p1, float) {
#pragma unroll
    for (int r = 0; r < 16; ++r) p0[r] = __builtin_amdgcn_exp2f(p0[r]);
}
__device__ __forceinline__ void finishSM(f32x16& p0, f32x16& p1, float& l_reg, bf16x8& pa0, bf16x8& pa1, bf16x8& pa2, bf16x8& pa3) {
#pragma unroll
    for (int r = 0; r < 16; ++r) p1[r] = __builtin_amdgcn_exp2f(p1[r]);
    float s0 = p0[0] + p1[0], s1 = p0[1] + p1[1], s2 = p0[2] + p1[2], s3 = p0[3] + p1[3];
#pragma unroll
    for (int r = 4; r < 16; r += 4) { s0 += p0[r] + p1[r]; s1 += p0[r + 1] + p1[r + 1]; s2 += p0[r + 2] + p1[r + 2]; s3 += p0[r + 3] + p1[r + 3]; }
    l_reg += (s0 + s1) + (s2 + s3);
#define PK4(P, BASE, OUT) do { unsigned a0 = cvtpk(P[BASE + 0], P[BASE + 1]), a1 = cvtpk(P[BASE + 2], P[BASE + 3]);   \
    unsigned b0 = cvtpk(P[BASE + 4], P[BASE + 5]), b1 = cvtpk(P[BASE + 6], P[BASE + 7]);                              \
    auto r0 = __builtin_amdgcn_permlane32_swap(a0, b0, false, false); auto r1 = __builtin_amdgcn_permlane32_swap(a1, b1, false, false); \
    u32x4 w = {r0[0], r1[0], r0[1], r1[1]}; OUT = *reinterpret_cast<bf16x8*>(&w); } while (0)
    PK4(p0, 0, pa0); PK4(p0, 8, pa1); PK4(p1, 0, pa2); PK4(p1, 8, pa3);
#undef PK4
}
template <int OFF> __device__ __forceinline__ void lds_rd128(bf16x8& d, unsigned a) { asm volatile("ds_read_b128 %0, %1 offset:%2" : "=v"(d) : "v"(a), "i"(OFF) : "memory"); }
template <int N> __device__ __forceinline__ void lds_wait2(bf16x8& a, bf16x8& b) { asm volatile("s_waitcnt lgkmcnt(%2)" : "+v"(a), "+v"(b) : "i"(N) : "memory"); }
template <int N> __device__ __forceinline__ void lds_wait3(bf16x8& a, bf16x8& b, bf16x8& c) { asm volatile("s_waitcnt lgkmcnt(%3)" : "+v"(a), "+v"(b), "+v"(c) : "i"(N) : "memory"); }
constexpr int qkt_cnt(int d0) { return (d0 > 11) ? 0 : ((d0 >= NQR) ? 3 : 2); }
template <int KOFF, int D0> struct QktStep {
    static __device__ __forceinline__ void load(bf16x8& k0, bf16x8& k1, bf16x8& q, unsigned kad, unsigned qa) {
        lds_rd128<KOFF + D0 * 32>(k0, kad); lds_rd128<KOFF + 32 * KPITCH + D0 * 32>(k1, kad);
        if constexpr (D0 >= NQR) lds_rd128<(D0 - NQR) * 1024>(q, qa);
    }
};
struct DmaPlan { const char* kb; const char* vb; LAS unsigned char* kdst; LAS unsigned char* vdst; unsigned koff0, koff1, koff2, voff0, voff1; int wave; bool dok, dov; };
template <int I> __device__ __forceinline__ void dma_piece(const DmaPlan& d) {
    if constexpr (I < 3) { if (d.dok) __builtin_amdgcn_global_load_lds((const unsigned*)(d.kb + (I == 0 ? d.koff0 : I == 1 ? d.koff1 : d.koff2)), (LAS unsigned*)(d.kdst + (d.wave + 8 * I) * 1024), 16, 0, 0); }
    else if constexpr (I == 3) { if (d.dok && d.wave == 0) { const int p_ = 24 * 64 + lane_id(), r_ = p_ / 25, c_ = p_ - r_ * 25;
            __builtin_amdgcn_global_load_lds((const unsigned*)(d.kb + (unsigned)(r_ * LDKK * 2 + c_ * 16)), (LAS unsigned*)(d.kdst + 24 * 1024), 16, 0, 0); } }
    else { if (d.dov) __builtin_amdgcn_global_load_lds((const unsigned*)(d.vb + (I == 4 ? d.voff0 : d.voff1)), (LAS unsigned*)(d.vdst + (d.wave * 2 + (I - 4)) * 1024), 16, 0, 0); }
}
template <int KOFF, bool FIN, bool DMA> __device__ __forceinline__ void qkt(f32x16& p0, f32x16& p1, const bf16x8* qr, unsigned kad, unsigned qa_in, float negMC,
                                                              f32x16& x0, f32x16& x1, float& l_reg, bf16x8& pa0, bf16x8& pa1, bf16x8& pa2, bf16x8& pa3, const DmaPlan& dm) {
    p0 = f32x16{}; p1 = f32x16{};
    unsigned qa = qa_in; asm volatile("" : "+v"(qa));
    bf16x8 ka[2], kb[2], qf[2];
    float s0 = 0.f, s1 = 0.f, s2 = 0.f, s3 = 0.f;
#define QL(S, D) QktStep<KOFF, D>::load(ka[S], kb[S], qf[S], kad, qa)
#define QM(S, D) do { if constexpr (D >= NQR) lds_wait3<qkt_cnt(D + 1)>(ka[S], kb[S], qf[S]); else lds_wait2<qkt_cnt(D + 1)>(ka[S], kb[S]); \
        const bf16x8 qq = (D < NQR) ? qr[D < NQR ? D : 0] : qf[S]; \
        p0 = __builtin_amdgcn_mfma_f32_32x32x16_bf16(ka[S], qq, p0, 0, 0, 0); p1 = __builtin_amdgcn_mfma_f32_32x32x16_bf16(kb[S], qq, p1, 0, 0, 0); } while (0)
#define PK4(P, BASE, OUT) do { if constexpr (FIN) { unsigned a0 = cvtpk(P[BASE + 0], P[BASE + 1]), a1 = cvtpk(P[BASE + 2], P[BASE + 3]);   \
    unsigned b0 = cvtpk(P[BASE + 4], P[BASE + 5]), b1 = cvtpk(P[BASE + 6], P[BASE + 7]);                              \
    auto r0 = __builtin_amdgcn_permlane32_swap(a0, b0, false, false); auto r1 = __builtin_amdgcn_permlane32_swap(a1, b1, false, false); \
    u32x4 w = {r0[0], r1[0], r0[1], r1[1]}; OUT = *reinterpret_cast<bf16x8*>(&w); } } while (0)
#define EX4(B) do { if constexpr (FIN) { x1[B] = __builtin_amdgcn_exp2f(x1[B]); x1[B + 1] = __builtin_amdgcn_exp2f(x1[B + 1]); x1[B + 2] = __builtin_amdgcn_exp2f(x1[B + 2]); x1[B + 3] = __builtin_amdgcn_exp2f(x1[B + 3]); } } while (0)
#define SUM8(X, B) do { if constexpr (FIN) { s0 += X[B] + X[B + 4]; s1 += X[B + 1] + X[B + 5]; s2 += X[B + 2] + X[B + 6]; s3 += X[B + 3] + X[B + 7]; } } while (0)
    QL(0, 0); QL(1, 1);
    QM(0, 0); QL(0, 2);                            if constexpr (DMA) dma_piece<0>(dm);
    QM(1, 1); QL(1, 3);                            if constexpr (DMA) dma_piece<1>(dm);
    QM(0, 2); QL(0, 4);  EX4(0); SUM8(x0, 0);      if constexpr (DMA) dma_piece<2>(dm);
    QM(1, 3); QL(1, 5);  EX4(4); SUM8(x0, 8);      if constexpr (DMA) dma_piece<3>(dm);
    QM(0, 4); QL(0, 6);  EX4(8); SUM8(x1, 0);      if constexpr (DMA) dma_piece<4>(dm);
    QM(1, 5); QL(1, 7);  EX4(12);                  if constexpr (DMA) dma_piece<5>(dm);
    QM(0, 6); QL(0, 8);  SUM8(x1, 8); PK4(x0, 0, pa0);
    QM(1, 7); QL(1, 9);  PK4(x0, 8, pa1);
    QM(0, 8); QL(0, 10); PK4(x1, 0, pa2);
    QM(1, 9); QL(1, 11); PK4(x1, 8, pa3);
    QM(0, 10); if constexpr (FIN) l_reg += (s0 + s1) + (s2 + s3);
    QM(1, 11);
#undef QL
#undef QM
#undef PK4
#undef EX4
#undef SUM8
}
__device__ __forceinline__ int v_st(int k, int c) { const int kk = (k & ~0xC) | ((k & 4) << 1) | ((k & 8) >> 1); return ((kk >> 3) * 4 + (c >> 5)) * 512 + ((kk & 7) * 32 + (c & 31)) * 2; }
__device__ __forceinline__ int v_rd_base(int lane) { return ((lane & 3) << 3) | (((lane >> 2) & 3) << 6) | (((lane >> 4) & 1) << 5) | (((lane >> 5) & 1) << 8); }
constexpr int v_rd_off(int d0, int ks, int half) { return d0 * 512 + ks * 4096 + half * 2048; }
template <int OFF> __device__ __forceinline__ s16x4 tr_read(int vb) {
    s16x4 r; asm volatile("ds_read_b64_tr_b16 %0, %1 offset:%2" : "=&v"(r) : "v"(vb), "i"(OFF) : "memory"); return r;
}
template <int D0> __device__ __forceinline__ void pv_one(f32x16& od, int vb, bf16x8 pa0, bf16x8 pa1, bf16x8 pa2, bf16x8 pa3) {
    const s16x4 l0 = tr_read<v_rd_off(D0, 0, 0)>(vb), h0 = tr_read<v_rd_off(D0, 0, 1)>(vb), l1 = tr_read<v_rd_off(D0, 1, 0)>(vb), h1 = tr_read<v_rd_off(D0, 1, 1)>(vb);
    const s16x4 l2 = tr_read<v_rd_off(D0, 2, 0)>(vb), h2 = tr_read<v_rd_off(D0, 2, 1)>(vb), l3 = tr_read<v_rd_off(D0, 3, 0)>(vb), h3 = tr_read<v_rd_off(D0, 3, 1)>(vb);
    asm volatile("s_waitcnt lgkmcnt(0)" ::: "memory"); SBAR();
#define PK(L, H) (bf16x8){L[0], L[1], L[2], L[3], H[0], H[1], H[2], H[3]}
    od = __builtin_amdgcn_mfma_f32_32x32x16_bf16(pa0, PK(l0, h0), od, 0, 0, 0);
    od = __builtin_amdgcn_mfma_f32_32x32x16_bf16(pa1, PK(l1, h1), od, 0, 0, 0);
    od = __builtin_amdgcn_mfma_f32_32x32x16_bf16(pa2, PK(l2, h2), od, 0, 0, 0);
    od = __builtin_amdgcn_mfma_f32_32x32x16_bf16(pa3, PK(l3, h3), od, 0, 0, 0);
#undef PK
}
__device__ __forceinline__ void pv_d0(f32x16* o, int vb, bf16x8 pa0, bf16x8 pa1, bf16x8 pa2, bf16x8 pa3) {
    pv_one<0>(o[0], vb, pa0, pa1, pa2, pa3); pv_one<1>(o[1], vb, pa0, pa1, pa2, pa3); pv_one<2>(o[2], vb, pa0, pa1, pa2, pa3); pv_one<3>(o[3], vb, pa0, pa1, pa2, pa3);
}
struct VFrag { s16x4 l0, h0, l1, h1, l2, h2, l3, h3; };
template <int D0> __device__ __forceinline__ void v_reads(VFrag& f, int vb) {
    f.l0 = tr_read<v_rd_off(D0, 0, 0)>(vb); f.h0 = tr_read<v_rd_off(D0, 0, 1)>(vb); f.l1 = tr_read<v_rd_off(D0, 1, 0)>(vb); f.h1 = tr_read<v_rd_off(D0, 1, 1)>(vb);
    f.l2 = tr_read<v_rd_off(D0, 2, 0)>(vb); f.h2 = tr_read<v_rd_off(D0, 2, 1)>(vb); f.l3 = tr_read<v_rd_off(D0, 3, 0)>(vb); f.h3 = tr_read<v_rd_off(D0, 3, 1)>(vb);
}
template <int N> __device__ __forceinline__ void v_wait(VFrag& f) {
    asm volatile("s_waitcnt lgkmcnt(%8)" : "+v"(f.l0), "+v"(f.h0), "+v"(f.l1), "+v"(f.h1), "+v"(f.l2), "+v"(f.h2), "+v"(f.l3), "+v"(f.h3) : "i"(N) : "memory");
}
__device__ __forceinline__ void v_mfmas(f32x16& od, const VFrag& f, bf16x8 pa0, bf16x8 pa1, bf16x8 pa2, bf16x8 pa3) {
#define PK(L, H) (bf16x8){L[0], L[1], L[2], L[3], H[0], H[1], H[2], H[3]}
    od = __builtin_amdgcn_mfma_f32_32x32x16_bf16(pa0, PK(f.l0, f.h0), od, 0, 0, 0);
    od = __builtin_amdgcn_mfma_f32_32x32x16_bf16(pa1, PK(f.l1, f.h1), od, 0, 0, 0);
    od = __builtin_amdgcn_mfma_f32_32x32x16_bf16(pa2, PK(f.l2, f.h2), od, 0, 0, 0);
    od = __builtin_amdgcn_mfma_f32_32x32x16_bf16(pa3, PK(f.l3, f.h3), od, 0, 0, 0);
#undef PK
}
template <bool EXP> __device__ __forceinline__ void pv_exp(f32x16* o, int vb, bf16x8 pa0, bf16x8 pa1, bf16x8 pa2, bf16x8 pa3, f32x16& x0) {
#define EX4(B) do { if constexpr (EXP) { x0[B] = __builtin_amdgcn_exp2f(x0[B]); x0[B + 1] = __builtin_amdgcn_exp2f(x0[B + 1]); x0[B + 2] = __builtin_amdgcn_exp2f(x0[B + 2]); x0[B + 3] = __builtin_amdgcn_exp2f(x0[B + 3]); } } while (0)
    VFrag fa, fb;
    v_reads<0>(fa, vb); v_reads<1>(fb, vb);
    v_wait<8>(fa); v_mfmas(o[0], fa, pa0, pa1, pa2, pa3); EX4(0);
    v_reads<2>(fa, vb);
    v_wait<8>(fb); v_mfmas(o[1], fb, pa0, pa1, pa2, pa3); EX4(4);
    v_reads<3>(fb, vb);
    v_wait<8>(fa); v_mfmas(o[2], fa, pa0, pa1, pa2, pa3); EX4(8);
    v_wait<0>(fb); v_mfmas(o[3], fb, pa0, pa1, pa2, pa3); EX4(12);
#undef EX4
}

__device__ __forceinline__ void attn_unit(const bf16_t* __restrict__ Qg, const bf16_t* __restrict__ KHg, const bf16_t* __restrict__ KVg, const bf16_t* __restrict__ Pg, bf16_t* __restrict__ mix,
                                          const float* __restrict__ qhw, const float* __restrict__ ropet,
                                          int h, int qrow0, int kc0, int kl0, int nct, int NT, float negMC, char* lds, int wave_) {
    int tid_ = wave_ * 64 + lane_id(); asm volatile("" : "+v"(tid_));
    const int tid = tid_, wid = tid >> 6, lane = tid & 63, r32 = lane & 31, hi = lane >> 5;
    char* V_lds = lds; char* K_lds = lds + 2 * SHM_V;
    bf16x8 qr[NQR];
    const bf16_t* Qw = Qg + (size_t)(qrow0 + wid * QBLK + r32) * LDQ + h * DQK + hi * 8;
    const unsigned qa = (unsigned)(uintptr_t)(lds + SHM_QR) + wid * QLB + lane * 16;
    {
        u32x4 qx[12]; f32x4 wr[4][2], rt[2][4];
        const bool latq = qrow0 < 16384; const int trow = (qrow0 + wid * QBLK + r32) & 4095;
#pragma unroll
        for (int d0 = 0; d0 < 12; ++d0) qx[d0] = *reinterpret_cast<const u32x4*>(Qw + d0 * 16);
#pragma unroll
        for (int i = 0; i < 4; ++i) { wr[i][0] = *(const f32x4*)(qhw + 128 + 16 * i + 8 * hi); wr[i][1] = *(const f32x4*)(qhw + 128 + 16 * i + 8 * hi + 4); }
#pragma unroll
        for (int pp = 0; pp < 2; ++pp) { const int pos = latq ? (pp == 0 ? (trow >> 6) : (trow & 63)) : 0;
            const f32x4* rp = (const f32x4*)(ropet + (size_t)(pos * 16 + 8 * hi) * 2);
#pragma unroll
            for (int q4 = 0; q4 < 4; ++q4) rt[pp][q4] = rp[q4]; }
        float ssq = 0.f;
#pragma unroll
        for (int d0 = 0; d0 < 12; ++d0) { float f[8]; unpack8(qx[d0], f);
#pragma unroll
            for (int e = 0; e < 8; ++e) ssq += f[e] * f[e]; }
        { auto pr = __builtin_amdgcn_permlane32_swap(__float_as_uint(ssq), __float_as_uint(ssq), false, false); ssq = __uint_as_float(pr[0]) + __uint_as_float(pr[1]); }
        const float rhq = (SCALE * 1.4426950408889634f) / sqrtf(ssq * (1.f / 192.f) + 1e-6f);
#pragma unroll
        for (int d0 = 0; d0 < 8; ++d0) { float f[8]; unpack8(qx[d0], f);
#pragma unroll
            for (int e = 0; e < 8; ++e) f[e] *= rhq;
            qx[d0] = pack8(f); }
#pragma unroll
        for (int pp = 0; pp < 2; ++pp) { float fa[8], fb[8]; unpack8(qx[8 + 2 * pp], fa); unpack8(qx[9 + 2 * pp], fb);
#pragma unroll
            for (int e = 0; e < 4; ++e) { fa[e] = fa[e] * rhq * wr[2 * pp][0][e]; fa[4 + e] = fa[4 + e] * rhq * wr[2 * pp][1][e]; fb[e] = fb[e] * rhq * wr[2 * pp + 1][0][e]; fb[4 + e] = fb[4 + e] * rhq * wr[2 * pp + 1][1][e]; }
            if (latq) {
#pragma unroll
                for (int q4 = 0; q4 < 4; ++q4) { const f32x4 v = rt[pp][q4];
#pragma unroll
                    for (int t2 = 0; t2 < 2; ++t2) { const int e = 2 * q4 + t2; const float cs = v[2 * t2], sn = v[2 * t2 + 1]; const float ya = fa[e], yb = fb[e];
                        fa[e] = ya * cs - yb * sn; fb[e] = yb * cs + ya * sn; } } }
            qx[8 + 2 * pp] = pack8(fa); qx[9 + 2 * pp] = pack8(fb); }
#pragma unroll
        for (int d0 = 0; d0 < NQR; ++d0) qr[d0] = __builtin_bit_cast(bf16x8, qx[d0]);
#pragma unroll
        for (int d0 = NQR; d0 < 12; ++d0) *(LAS u32x4*)(uintptr_t)(qa + (d0 - NQR) * 1024) = qx[d0];
    }
    float l_reg = 0; f32x16 o[4] = {};
    const int vb0 = (int)(uintptr_t)V_lds + v_rd_base(lane);
    const unsigned kad = (unsigned)(uintptr_t)K_lds + (unsigned)(r32 * KPITCH + hi * 16);
    const bf16_t* Kbase = KHg + h * DQK; const bf16_t* Vbase = KVg + h * 256 + 128;
    unsigned koff[3], voff[2];
#pragma unroll
    for (int i = 0; i < 3; ++i) { const int p = (wid + 8 * i) * 64 + lane, r = p / 25, c = p - r * 25; koff[i] = (unsigned)(r * LDKK * 2 + c * 16); }
#pragma unroll
    for (int i = 0; i < 2; ++i) { const int o = (wid * 2 + i) * 1024 + lane * 16, sub = o >> 9, kk = (sub >> 2) * 8 + ((o & 511) >> 6), k = (kk & ~0xC) | ((kk & 4) << 1) | ((kk & 8) >> 1), c = (sub & 3) * 32 + ((o & 63) >> 1);
        voff[i] = (unsigned)(k * LDV * 2 + c * 2); }
    LAS unsigned char* K3 = (LAS unsigned char*)(uintptr_t)(unsigned)(uintptr_t)K_lds; LAS unsigned char* V3 = (LAS unsigned char*)(uintptr_t)(unsigned)(uintptr_t)V_lds;
#define TROW(j) ((j) < nct ? kc0 + (j) * KVBLK : kl0 + ((j) - nct) * KVBLK)
#define DMA_K(j, slot) do { const char* kb_ = (const char*)Kbase + (size_t)TROW(j) * (LDKK * 2); _Pragma("unroll") for (int i_ = 0; i_ < 3; ++i_) \
    __builtin_amdgcn_global_load_lds((const unsigned*)(kb_ + koff[i_]), (LAS unsigned*)(K3 + (slot) * SHM_K + (wave_ + 8 * i_) * 1024), 16, 0, 0); \
    if (wave_ == 0) { int l4_ = lane_id(); const int p_ = 24 * 64 + l4_, r_ = p_ / 25, c_ = p_ - r_ * 25; \
        __builtin_amdgcn_global_load_lds((const unsigned*)(kb_ + (unsigned)(r_ * LDKK * 2 + c_ * 16)), (LAS unsigned*)(K3 + (slot) * SHM_K + 24 * 1024), 16, 0, 0); } } while (0)
#define DMA_V(j, slot) do { const char* vb_ = (const char*)Vbase + (size_t)TROW(j) * (LDV * 2); _Pragma("unroll") for (int i_ = 0; i_ < 2; ++i_) \
    __builtin_amdgcn_global_load_lds((const unsigned*)(vb_ + voff[i_]), (LAS unsigned*)(V3 + (slot) * SHM_V + (wave_ * 2 + i_) * 1024), 16, 0, 0); } while (0)
#define WAITBAR() do { asm volatile("s_waitcnt vmcnt(0)" ::: "memory"); __syncthreads(); } while (0)
    f32x16 pA0, pA1, pB0, pB1; bf16x8 pa0, pa1, pa2, pa3;
    DMA_K(0, 0); DMA_V(0, 0); DMA_K(1, 1);
    WAITBAR();
    const DmaPlan none0{nullptr, nullptr, K3, V3, 0u, 0u, 0u, 0u, 0u, wave_, false, false};
#define PLAN(tk, sk_, tv, sv_) DmaPlan{(const char*)Kbase + (size_t)TROW((tk) < NT ? (tk) : 0) * (LDKK * 2), (const char*)Vbase + (size_t)TROW((tv) < NT ? (tv) : 0) * (LDV * 2), \
        K3 + (sk_) * SHM_K, V3 + (sv_) * SHM_V, koff[0], koff[1], koff[2], voff[0], voff[1], wave_, (tk) < NT, (tv) < NT}
    if (wave_ < 4) {
#define STEPA(jj, ks, vs, PN0, PN1, PP0, PP1) do { const DmaPlan dp = PLAN((jj) + 1, 1 - (ks), (jj), 1 - (vs)); \
        qkt<0, true, true>(PN0, PN1, qr, kad + (ks) * SHM_K, qa, negMC, PP0, PP1, l_reg, pa0, pa1, pa2, pa3, dp); \
        pv_exp<true>(o, vb0 + (vs) * SHM_V, pa0, pa1, pa2, pa3, PN0); WAITBAR(); } while (0)
        qkt<0, false, false>(pA0, pA1, qr, kad, qa, negMC, pA0, pA1, l_reg, pa0, pa1, pa2, pa3, none0); partialSM(pA0, pA1, negMC);
        WAITBAR();
        for (int j = 1; j + 1 < NT; j += 2) { STEPA(j, 1, 0, pB0, pB1, pA0, pA1); STEPA(j + 1, 0, 1, pA0, pA1, pB0, pB1); }
        STEPA(NT - 1, 1, 0, pB0, pB1, pA0, pA1);
        finishSM(pB0, pB1, l_reg, pa0, pa1, pa2, pa3); SBAR();
        pv_d0(o, vb0 + SHM_V, pa0, pa1, pa2, pa3);
#undef STEPA
    } else {
#define STEPB(jj, ks, vs) do { const DmaPlan dp = PLAN((jj) + 1, 1 - (ks), (jj), 1 - (vs)); \
        pv_exp<false>(o, vb0 + (vs) * SHM_V, pa0, pa1, pa2, pa3, pA0); \
        qkt<0, false, true>(pA0, pA1, qr, kad + (ks) * SHM_K, qa, negMC, pA0, pA1, l_reg, pa0, pa1, pa2, pa3, dp); \
        partialSM(pA0, pA1, negMC); finishSM(pA0, pA1, l_reg, pa0, pa1, pa2, pa3); WAITBAR(); } while (0)
        qkt<0, false, false>(pA0, pA1, qr, kad, qa, negMC, pA0, pA1, l_reg, pa0, pa1, pa2, pa3, none0); partialSM(pA0, pA1, negMC);
        finishSM(pA0, pA1, l_reg, pa0, pa1, pa2, pa3);
        WAITBAR();
        for (int j = 1; j + 1 < NT; j += 2) { STEPB(j, 1, 0); STEPB(j + 1, 0, 1); }
        STEPB(NT - 1, 1, 0);
        pv_d0(o, vb0 + SHM_V, pa0, pa1, pa2, pa3);
#undef STEPB
    }
    {
        int te_ = wave_ * 64 + lane_id(); asm volatile("" : "+v"(te_));
        const int ewid = te_ >> 6, elane = te_ & 63, er32 = elane & 31, ehi = elane >> 5;
        float* eli = (float*)(lds + 2 * SHM_V + 2 * SHM_K) + ewid * 64;
        { auto rr = __builtin_amdgcn_permlane32_swap(__float_as_uint(l_reg), __float_as_uint(l_reg), false, false); l_reg = __uint_as_float(rr[0]) + __uint_as_float(rr[1]); }
        if (ehi == 0) eli[er32] = l_reg; asm volatile("s_waitcnt lgkmcnt(0)" ::: "memory");
        const size_t Rw = (size_t)(qrow0 + ewid * QBLK);
        unsigned short gtb[16][4];
#pragma unroll
        for (int r = 0; r < 16; ++r)
#pragma unroll
            for (int d0 = 0; d0 < 4; ++d0) gtb[r][d0] = Pg[(Rw + crow(r, ehi)) * NIN + OFF_MGATE + h * 128 + d0 * 32 + er32];
        asm volatile("" ::: "memory");
#pragma unroll
        for (int r = 0; r < 16; ++r) { const size_t R = Rw + crow(r, ehi); const float rl = __builtin_amdgcn_rcpf(eli[crow(r, ehi)]);
#pragma unroll
            for (int d0 = 0; d0 < 4; ++d0) { const int d = h * 128 + d0 * 32 + er32;
                mix[R * DM + 1024 + d] = (bf16_t)f2bf(o[d0][r] * rl * siluf(bf2f(gtb[r][d0]))); } }
    }
    __syncthreads();
#undef TROW
#undef DMA_K
#undef DMA_V
#undef WAITBAR
#undef PLAN
}
#undef SBAR
}

constexpr int CW_BAR = 4096, CW_FOLD = 8192;
constexpr int KFOLD = 2176;
#define XB_TMO      128
#define XB_XCNT(j)  (256  + 64 * (j))
#define XB_XSUB(j)  (1280 + 64 * (j))
#define XB_XGEN(j)  (2304 + 64 * (j))
#define XB_TOP      3328
#define XB_TOPGEN   3392
#define XCD_BAR_WORDS 3456
#define XB_SPIN_CAP (1u << 18)
__device__ __forceinline__ unsigned xb_ld(unsigned* p)              { return __hip_atomic_load(p, __ATOMIC_RELAXED, __HIP_MEMORY_SCOPE_AGENT); }
__device__ __forceinline__ unsigned xb_add(unsigned* p, unsigned v) { return __hip_atomic_fetch_add(p, v, __ATOMIC_RELAXED, __HIP_MEMORY_SCOPE_AGENT); }
__device__ __forceinline__ unsigned xb_xcc_id() { return (unsigned)__builtin_amdgcn_s_getreg((3 << 11) | 20) & 0xFu; }
#define XB_SPIN(cond, bar) do { unsigned _sp = 0; while (cond) { __builtin_amdgcn_s_sleep(1); \
    if ((++_sp & 255u) == 0u) { if (xb_ld(&(bar)[XB_TMO])) break; if (_sp > XB_SPIN_CAP) { atomicAdd(&(bar)[XB_TMO], 1u); break; } } } } while (0)
struct XcdBarrier { unsigned* bar; unsigned x; volatile LAS unsigned* st; };
__device__ __forceinline__ XcdBarrier xcd_barrier_post(unsigned* bar, volatile LAS unsigned* st, int tid) {
    XcdBarrier b; b.bar = bar; b.x = xb_xcc_id(); b.st = st;
    if (tid == 0) (void)xb_add(&bar[XB_XCNT(b.x)], 1u);
    return b;
}
__device__ __forceinline__ void xcd_barrier_complete(unsigned* bar, unsigned x, unsigned& nloc, unsigned& nx) {
    const unsigned G = gridDim.x * gridDim.y * gridDim.z;
    unsigned sum, cnt, mine, sp = 0u;
    for (;;) {
        sum = 0u; cnt = 0u; mine = 0u;
#pragma unroll
        for (unsigned j = 0; j < 16; ++j) { const unsigned c = xb_ld(&bar[XB_XCNT(j)]); sum += c; cnt += (c > 0u) ? 1u : 0u; mine = (j == x) ? c : mine; }
        if (sum == G) break;
        __builtin_amdgcn_s_sleep(1);
        if ((++sp & 255u) == 0u) { if (xb_ld(&bar[XB_TMO])) break; if (sp > XB_SPIN_CAP) { atomicAdd(&bar[XB_TMO], 1u); break; } }
    }
    nloc = mine > 0u ? mine : 1u; nx = cnt > 0u ? cnt : 1u;
}
__device__ __forceinline__ void xcd_barrier(const XcdBarrier& b, int tid) {
    asm volatile("s_waitcnt vmcnt(0)" ::: "memory");
    __syncthreads();
    if (tid == 0) {
        unsigned* bar = b.bar;
        __builtin_amdgcn_s_waitcnt(0);
        unsigned nloc = b.st[0], nx = b.st[1];
        if (nloc == 0u) { xcd_barrier_complete(bar, b.x, nloc, nx); b.st[0] = nloc; b.st[1] = nx; }
        const unsigned old = xb_add(&bar[XB_XSUB(b.x)], 1u);
        const unsigned gen = old / nloc;
        if (old + 1u == (gen + 1u) * nloc) {
            __builtin_amdgcn_fence(__ATOMIC_RELEASE, "agent");
            asm volatile("s_waitcnt vmcnt(0)" ::: "memory");
            const unsigned og = xb_add(&bar[XB_TOP], 1u);
            const unsigned tg = og / nx;
            if (og + 1u == (tg + 1u) * nx) xb_add(&bar[XB_TOPGEN], 1u);
            else XB_SPIN(xb_ld(&bar[XB_TOPGEN]) == tg, bar);
            __builtin_amdgcn_fence(__ATOMIC_ACQUIRE, "agent");
            xb_add(&bar[XB_XGEN(b.x)], 1u);
            asm volatile("s_waitcnt vmcnt(0)" ::: "memory");
        } else {
            XB_SPIN(xb_ld(&bar[XB_XGEN(b.x)]) == gen, bar);
            __builtin_amdgcn_fence(__ATOMIC_ACQUIRE, "agent");
            asm volatile("s_waitcnt vmcnt(0)" ::: "memory");
        }
    }
    __syncthreads();
}

constexpr int NWAVES = 8, NCU = 256;
constexpr int RING_BYTES = 150528, LDSCTL_OFF = RING_BYTES, MISC_OFF = LDSCTL_OFF + 320, LDS_BYTES = 151552;
static_assert(att::SHM_ATTN <= RING_BYTES && pg8::STAGE_BYTES <= RING_BYTES, "phase scratch fits the ring");

struct Args { const void* in[18]; float* out; unsigned char* ws; int ph_lo, ph_hi; };

struct Frame {
    unsigned char* lds;
    LAS unsigned char* lds3;
    int wave, vcu, G, bx;
};
__device__ __forceinline__ const void* ldptr(LAS unsigned char*, int i) {
    typedef __attribute__((address_space(4))) const unsigned long long* kaptr_t;
    kaptr_t ka = (kaptr_t)__builtin_amdgcn_kernarg_segment_ptr();
    asm volatile("" : "+s"(ka));
    return (const void*)ka[i];
}
#define FRESH_TID(name) int name = F.wave * 64 + lane_id(); asm volatile("" : "+v"(name))
#define F_IN(i) ((const float*)ldptr(F.lds3, (i)))
#define F_OUT ((float*)ldptr(F.lds3, 18))
#define F_WS ((unsigned char*)ldptr(F.lds3, 19))
#define WSP(T, off) ((T*)(ws + (off)))

__device__ __forceinline__ void transpose_item(const float* W, int K, int N, bf16_t* WT, int row_off, float* scr, int item, int lane, const float* kscale = nullptr) {
    const int nblk = N / 32, kb = item / nblk, nb = item % nblk, k0 = 64 * kb, n0 = 32 * nb;
    float wv[32];
#pragma unroll
    for (int i = 0; i < 32; ++i) { const int kk = 2 * i + (lane >> 5); wv[i] = W[(size_t)(k0 + kk) * N + n0 + (lane & 31)]; }
    if (kscale) {
#pragma unroll
        for (int i = 0; i < 32; ++i) wv[i] *= kscale[k0 + 2 * i + (lane >> 5)]; }
#pragma unroll
    for (int i = 0; i < 32; ++i) { const int kk = 2 * i + (lane >> 5); scr[kk * 33 + (lane & 31)] = wv[i]; }
    asm volatile("s_waitcnt lgkmcnt(0)" ::: "memory");
    const int c = lane & 7;
#pragma unroll
    for (int j = 0; j < 4; ++j) { const int n = (lane >> 3) + 8 * j; const float* s = scr + (8 * c) * 33 + n;
        u32x4 o; o.x = pk2(s[0 * 33], s[1 * 33]); o.y = pk2(s[2 * 33], s[3 * 33]); o.z = pk2(s[4 * 33], s[5 * 33]); o.w = pk2(s[6 * 33], s[7 * 33]);
        *(u32x4*)(WT + (size_t)(row_off + n0 + n) * K + k0 + 8 * c) = o; }
    asm volatile("s_waitcnt lgkmcnt(0)" ::: "memory");
}

__device__ __forceinline__ void phase_prep(Frame& F, int part, int wg, int nwg) {
    float* ldsf = (float*)F.lds;
    FRESH_TID(tid_); const int tid = tid_, lane = tid & 63, wave = F.wave;
    unsigned char* ws = F_WS;
    const float* in_win = F_IN(7);
    if (part == 0) {
        const float* in_c = F_IN(1); const float* in_cctx = F_IN(3); const float* in_wada = F_IN(5); const float* in_bada = F_IN(6);
        float* s_c = ldsf;
        float* red = ldsf + 5 * 2048;
        for (int idx = tid; idx < 5 * 2048; idx += 512) { const int r = idx >> 11, k = idx & 2047; const float v = (r < 4) ? in_c[r * 2048 + k] : in_cctx[k]; s_c[idx] = siluf(v); }
        __syncthreads();
        float* mods = WSP(float, WS_MODS);
        for (int rp = 0; rp < ((REP_P & 1) ? 2 : 1); ++rp)
        for (int item = wg; item < 192; item += nwg) {
            const int l = item / 96, nb = item % 96, col = nb * 64 + lane;
            const float* w = in_wada + (size_t)l * 2048 * 6144 + col;
            float a0 = 0.f, a1 = 0.f, a2 = 0.f, a3 = 0.f, a4 = 0.f;
            const int kb = wave * 256;
            for (int k0 = 0; k0 < 256; k0 += 32) { float wv[32];
#pragma unroll
                for (int k = 0; k < 32; ++k) wv[k] = w[(size_t)(kb + k0 + k) * 6144];
#pragma unroll
                for (int k = 0; k < 32; ++k) { const int kk = kb + k0 + k;
                    a0 += s_c[kk] * wv[k]; a1 += s_c[2048 + kk] * wv[k]; a2 += s_c[4096 + kk] * wv[k]; a3 += s_c[6144 + kk] * wv[k]; a4 += s_c[8192 + kk] * wv[k]; } }
            red[(wave * 5 + 0) * 64 + lane] = a0; red[(wave * 5 + 1) * 64 + lane] = a1; red[(wave * 5 + 2) * 64 + lane] = a2; red[(wave * 5 + 3) * 64 + lane] = a3; red[(wave * 5 + 4) * 64 + lane] = a4;
            __syncthreads();
            if (tid < 320) { const int r = tid >> 6, ln = tid & 63; float s = 0.f;
#pragma unroll
                for (int w8 = 0; w8 < 8; ++w8) s += red[(w8 * 5 + r) * 64 + ln];
                mods[((size_t)l * 5 + r) * 6144 + nb * 64 + ln] = s + in_bada[(size_t)l * 6144 + nb * 64 + ln]; }
            __syncthreads();
        }
    }
    if (part == 0) {
        const float* in_poolw = F_IN(8); const float* in_pools = F_IN(9);
        float* Ml = ldsf;
        float* Wt = ldsf + 128 * 128;
        for (int rp = 0; rp < ((REP_P & 2) ? 2 : 1); ++rp)
        for (int item = wg; item < 512; item += nwg) {
            const int l = item >> 8, kind = (item >> 7) & 1, g = (item >> 5) & 3, kb = item & 31;
            __syncthreads();
            for (int idx = tid; idx < 128 * 128; idx += 512) { const int j = idx >> 7, n = idx & 127; float v;
                if (kind == 0) v = in_poolw[(((size_t)l * 4 + g) * 128 + j) * 128 + n] * in_pools[(size_t)l * 512 + g * 128 + n];
                else { const float sc = 0.08838834764831845f;
                    if (n <= 64) v = __builtin_amdgcn_cosf((float)((j * n) & 127) * (1.f / 128.f)) * sc;
                    else v = __builtin_amdgcn_sinf((float)((j * (n - 64)) & 127) * (1.f / 128.f)) * sc; }
                Ml[idx] = v; }
            const int colbase = (kind == 0 ? OFF_POOL : OFF_FNET) + g * 128;
            { float wv[16];
#pragma unroll
              for (int q = 0; q < 16; ++q) { const int idx = tid + q * 512, kk = idx >> 7, jj = idx & 127; wv[q] = in_win[((size_t)l * DM + kb * 64 + kk) * DIN + colbase + jj]; }
#pragma unroll
              for (int q = 0; q < 16; ++q) { const int idx = tid + q * 512, kk = idx >> 7, jj = idx & 127; Wt[jj * 68 + kk] = wv[q]; } }
            __syncthreads();
            const int n4 = (tid & 31) * 4, k4 = (tid >> 5) * 4;
            f32x4 acc4[4];
#pragma unroll
            for (int i = 0; i < 4; ++i) acc4[i] = (f32x4){0.f, 0.f, 0.f, 0.f};
#pragma unroll 8
            for (int j = 0; j < 128; ++j) { const f32x4 mv = *(const f32x4*)(Ml + j * 128 + n4), wq = *(const f32x4*)(Wt + j * 68 + k4);
#pragma unroll
                for (int i = 0; i < 4; ++i) acc4[i] += mv * wq[i]; }
            bf16_t* dst = WSP(bf16_t, WS_WIN) + ((size_t)l * NIN + colbase + n4) * DM + kb * 64 + k4;
#pragma unroll
            for (int e = 0; e < 4; ++e) { u32x2 w; w.x = pk2(acc4[0][e], acc4[1][e]); w.y = pk2(acc4[2][e], acc4[3][e]); *(u32x2*)(dst + (size_t)e * DM) = w; }
        }
        __syncthreads();
    }
    {
        const float* in_wuq = F_IN(12); const float* in_wukv = F_IN(14); const float* in_wout = F_IN(17); const float* in_qnw = F_IN(11); const float* in_kvnw = F_IN(13);
        float* scr = ldsf + wave * (64 * 33 + 16);
        const int gw = wg * NWAVES + wave, NGW = nwg * NWAVES;
        constexpr int I_IN = 32 * 130, I_UQ = 8 * 48, I_UKV = 8 * 64, I_OUT = 32 * 64, I_REST = I_UQ + I_UKV + I_OUT;
        const int ntot = (part == 0) ? 2 * I_IN : I_REST;
        for (int rp = 0; rp < ((REP_P & 4) ? 2 : 1); ++rp)
        for (int it = gw; it < ntot; it += NGW) {
            int r = it;
            if (part == 0) { const int l = r / I_IN; r -= l * I_IN; const int nb = r % 130; if (nb < 16 || (nb >= 32 && nb < 48)) continue;
                transpose_item(in_win + (size_t)l * DM * DIN, DM, DIN, WSP(bf16_t, WS_WIN) + (size_t)l * NIN * DM, 0, scr, r, lane); continue; }
            const int l = part - 1;
            if (r < I_UQ) { transpose_item(in_wuq + (size_t)l * 512 * NQ, 512, NQ, WSP(bf16_t, WS_WUQ) + (size_t)l * NQ * 512, 0, scr, r, lane, in_qnw + (size_t)l * 512); continue; } r -= I_UQ;
            if (r < I_UKV) { transpose_item(in_wukv + (size_t)l * 512 * NKV, 512, NKV, WSP(bf16_t, WS_WUKV) + (size_t)l * NKV * 512, 0, scr, r, lane, in_kvnw + (size_t)l * 512); continue; } r -= I_UKV;
            transpose_item(in_wout + (size_t)l * DM * DM, DM, DM, WSP(bf16_t, WS_WOUT) + (size_t)l * DM * DM, 0, scr, r, lane);
        }
    }
    {
        const int gt = wg * 512 + tid, NGT = nwg * 512;
        if (part == 1) {
            const float* in_fnetw = F_IN(10);
            for (int idx = gt; idx < NL * 512 * 512; idx += NGT) { const int l = idx >> 18, n = (idx >> 9) & 511, kidx = idx & 511;
                const int g = n >> 7, d = n & 127; const int g2 = (kidx & 255) >> 6, s = kidx & 63; float v = 0.f;
                if (g2 == g) { const float* fw = in_fnetw + (((size_t)l * 4 + g) * 128) * 128 + d;
                    if (kidx < 256) v = (s == 0) ? fw[0] : fw[(size_t)s * 128] + fw[(size_t)(128 - s) * 128];
                    else v = (s == 0) ? 0.f : fw[(size_t)s * 128] - fw[(size_t)(128 - s) * 128]; }
                WSP(bf16_t, WS_FWAB)[idx] = (bf16_t)f2bf(v); }
        }
        if (part == 0) {
            const float* in_qhw = F_IN(15); const float* in_khw = F_IN(16);
            for (int idx = gt; idx < 256 * 256; idx += NGT) { const int k = idx >> 8, n = idx & 255; const float ph = (float)((k * n) & 255) * (1.f / 256.f);
                WSP(bf16_t, WS_DCTX)[idx] = (bf16_t)f2bf(__builtin_amdgcn_cosf(ph) * 0.0625f);
                WSP(bf16_t, WS_DCTX)[65536 + idx] = (bf16_t)f2bf(-__builtin_amdgcn_sinf(ph) * 0.0625f); }
            if (wg == 0 && F.wave == 0) { for (int l = 0; l < NL; ++l) { float mq = 0.f, mk = 0.f;
                    for (int i = lane; i < DQK; i += 64) { mq = fmaxf(mq, fabsf(in_qhw[l * DQK + i])); mk = fmaxf(mk, fabsf(in_khw[l * DQK + i])); }
                    mq = wave_max(mq); mk = wave_max(mk);
                    if (lane == 0) WSP(float, WS_SMB)[l] = -(att::SCALE * (float)DQK * mq * mk) * 1.4426950408889634f; } }
            for (int idx = gt; idx < 1024; idx += NGT) { const int p = idx >> 4, i = idx & 15; const float inv = powf(10000.f, -(float)i / 16.f); const float ang = (float)p * inv;
                WSP(float, WS_ROPE)[2 * idx] = cosf(ang); WSP(float, WS_ROPE)[2 * idx + 1] = sinf(ang); }
        }
    }
}

__device__ __forceinline__ void phase_norm(Frame& F, int l) {
    FRESH_TID(tid_); const int lane = tid_ & 63;
    const int gw = F.vcu * NWAVES + F.wave, NGW = F.G * NWAVES;
    unsigned char* ws = F_WS;
    if (l == 0) {
        const float* mods = WSP(float, WS_MODS);
        const float* nw = F_IN(4);
        const float* src_lat = F_IN(0); const float* src_ctx = F_IN(2);
        bf16_t* H = WSP(bf16_t, WS_HMIX);
        for (int it = gw; it < MT / 2; it += NGW) {
            const int rowa = 2 * it;
            const bool lat = rowa < MLAT; const int rr = lat ? rowa : rowa - MLAT; const int mr = lat ? (rowa >> 12) : 4;
            const float* shp = mods + (size_t)mr * 6144; const float* scp = shp + 2048;
            f32x4 v[2][8], w4[8], sc4[8], sh4[8];
#pragma unroll
            for (int q = 0; q < 2; ++q) { const f32x4* xr = (const f32x4*)((lat ? src_lat : src_ctx) + (size_t)(rr + q) * DM) + lane;
#pragma unroll
                for (int j = 0; j < 8; ++j) v[q][j] = xr[64 * j]; }
#pragma unroll
            for (int j = 0; j < 8; ++j) { const int c0 = 4 * (lane + 64 * j); w4[j] = *(const f32x4*)(nw + c0); sc4[j] = *(const f32x4*)(scp + c0); sh4[j] = *(const f32x4*)(shp + c0); }
            float ssq[2];
#pragma unroll
            for (int q = 0; q < 2; ++q) { float s8 = 0.f;
#pragma unroll
                for (int j = 0; j < 8; ++j) s8 += (v[q][j][0] * v[q][j][0] + v[q][j][1] * v[q][j][1]) + (v[q][j][2] * v[q][j][2] + v[q][j][3] * v[q][j][3]);
                ssq[q] = wave_sum(s8); }
#pragma unroll
            for (int q = 0; q < 2; ++q) { const float rstd = 1.0f / sqrtf(ssq[q] * (1.f / DM) + EPS);
                u32x2* o8 = (u32x2*)(H + (size_t)(rowa + q) * DM) + lane;
#pragma unroll
                for (int j = 0; j < 8; ++j) { f32x4 hv;
#pragma unroll
                    for (int e = 0; e < 4; ++e) hv[e] = (v[q][j][e] * rstd * w4[j][e]) * (1.f + sc4[j][e]) + sh4[j][e];
                    u32x2 w; w.x = pk2(hv[0], hv[1]); w.y = pk2(hv[2], hv[3]); o8[64 * j] = w; } }
        }
        const float* mods1 = mods + (size_t)5 * 6144;
        LAS float* shl = (LAS float*)F.lds3;
        { float sv[20];
#pragma unroll
          for (int i = 0; i < 20; ++i) { const int e = tid_ + i * NWAVES * 64; sv[i] = mods1[(size_t)(e >> 11) * 6144 + (e & 2047)]; }
#pragma unroll
          for (int i = 0; i < 20; ++i) shl[tid_ + i * NWAVES * 64] = sv[i]; }
        __syncthreads();
        const bf16_t* WT = WSP(bf16_t, WS_WIN) + (size_t)NIN * DM; float* BI = WSP(float, WS_BIAS);
        u32x4 wv3[3][4];
#pragma unroll
        for (int ci = 0; ci < 3; ++ci) { const int c = gw + ci * NGW;
#pragma unroll
            for (int j = 0; j < 4; ++j) wv3[ci][j] = *(const u32x4*)(WT + (size_t)(c < NIN ? c : 0) * DM + (size_t)(lane + 64 * j) * 8); }
#pragma unroll
        for (int ci = 0; ci < 3; ++ci) { const int c = gw + ci * NGW; if (c >= NIN) break;
            float acc5[5] = {0.f, 0.f, 0.f, 0.f, 0.f};
#pragma unroll
            for (int j = 0; j < 4; ++j) { float wf[8]; unpack8(wv3[ci][j], wf);
#pragma unroll
                for (int b = 0; b < 5; ++b) { const f32x4 s0 = *(const LAS f32x4*)(shl + b * DM + (lane + 64 * j) * 8), s1 = *(const LAS f32x4*)(shl + b * DM + (lane + 64 * j) * 8 + 4);
                    acc5[b] += ((wf[0] * s0[0] + wf[1] * s0[1]) + (wf[2] * s0[2] + wf[3] * s0[3])) + ((wf[4] * s1[0] + wf[5] * s1[1]) + (wf[6] * s1[2] + wf[7] * s1[3])); } }
#pragma unroll
            for (int b = 0; b < 5; ++b) { const float t = wave_sum(acc5[b]); if (lane == 0) BI[(size_t)b * NIN + c] = t; } }
        __syncthreads();
    } else {
        const float* mods = WSP(float, WS_MODS) + (size_t)l * 5 * 6144;
        const float* nw = F_IN(4) + (size_t)l * DM;
        const float* src_ctx = F_IN(2);
        const float* part = WSP(float, WS_Q); const float* gate_c0 = WSP(float, WS_MODS) + (size_t)4 * 6144 + 4096;
        bf16_t* XB = WSP(bf16_t, WS_KV); float* RS = WSP(float, WS_RS);
        if ((gw & 1) == 0) { const int row = gw >> 1;
            if (row < MCTX) {
                f32x4 v[8], p0[8], p1[8], p2[8], p3[8], g4[8];
#pragma unroll
                for (int j = 0; j < 8; ++j) { const int c0 = 4 * (lane + 64 * j); const size_t po = (size_t)row * DM + c0;
                    v[j] = *(const f32x4*)(src_ctx + po); p0[j] = *(const f32x4*)(part + po); p1[j] = *(const f32x4*)(part + (size_t)MCTX * DM + po);
                    p2[j] = *(const f32x4*)(part + (size_t)2 * MCTX * DM + po); p3[j] = *(const f32x4*)(part + (size_t)3 * MCTX * DM + po); g4[j] = *(const f32x4*)(gate_c0 + c0); }
                float s8 = 0.f;
#pragma unroll
                for (int j = 0; j < 8; ++j) { v[j] = v[j] + g4[j] * ((p0[j] + p1[j]) + (p2[j] + p3[j]));
                    s8 += (v[j][0] * v[j][0] + v[j][1] * v[j][1]) + (v[j][2] * v[j][2] + v[j][3] * v[j][3]); }
                const float ssq = wave_sum(s8);
                if (lane == 0) RS[MLAT + row] = 1.0f / sqrtf(ssq * (1.f / DM) + EPS);
                const float* scp = mods + (size_t)4 * 6144 + 2048;
                u32x2* o8 = (u32x2*)(XB + (size_t)(MLAT + row) * DM) + lane;
#pragma unroll
                for (int j = 0; j < 8; ++j) { const int c0 = 4 * (lane + 64 * j); const f32x4 w4 = *(const f32x4*)(nw + c0), sc4 = *(const f32x4*)(scp + c0); f32x4 hv;
#pragma unroll
                    for (int e = 0; e < 4; ++e) hv[e] = (v[j][e] * w4[e]) * (1.f + sc4[e]);
                    u32x2 w; w.x = pk2(hv[0], hv[1]); w.y = pk2(hv[2], hv[3]); o8[64 * j] = w; }
            }
        } else {
            const float* SS = WSP(float, WS_SS);
            for (int r = (gw >> 1) * 64 + lane; r < MLAT; r += (NGW >> 1) * 64) { f32x4 a[8];
#pragma unroll
                for (int j = 0; j < 8; ++j)
#pragma unroll
                    for (int e = 0; e < 4; ++e) a[j][e] = SS[(size_t)(4 * j + e) * MLAT + r];
                float t = 0.f;
#pragma unroll
                for (int j = 0; j < 8; ++j) t += (a[j][0] + a[j][1]) + (a[j][2] + a[j][3]);
                RS[r] = 1.0f / sqrtf(t * (1.f / DM) + EPS); }
        }
    }
}

__device__ __forceinline__ void dft_gen(Frame& F, int l, int wg, int nwg) {
    FRESH_TID(tidl_); const int tidl = tidl_;
    unsigned char* ws = F_WS;
    bf16_t* Dc = (l == 0) ? (bf16_t*)F_OUT : WSP(bf16_t, WS_WIN); bf16_t* Ds = Dc + (size_t)2048 * KFOLD;
    for (int idx = wg * 512 + tidl; idx < 2048 * (KFOLD / 8); idx += nwg * 512) { const int k = idx / (KFOLD / 8), n0 = (idx - k * (KFOLD / 8)) * 8;
        float cv[8], sv[8];
#pragma unroll
        for (int e = 0; e < 8; ++e) { const float ph = (float)((k * (n0 + e)) & 4095) * (1.f / 4096.f);
            cv[e] = __builtin_amdgcn_cosf(ph) * 0.015625f; sv[e] = -__builtin_amdgcn_sinf(ph) * 0.015625f; }
        *(u32x4*)(Dc + (size_t)k * KFOLD + n0) = pack8(cv); *(u32x4*)(Ds + (size_t)k * KFOLD + n0) = pack8(sv); }
}

__device__ __forceinline__ void phase_heads_pool(Frame& F, int l, bool inplace) {
    FRESH_TID(tidl_); const int tidl = tidl_, lane = tidl & 63;
    const int npost = (l == 0) ? 136 : 128;
    const int nshare = (F.bx < npost) ? 1 : 2, vwg0 = (F.bx < npost) ? F.bx : npost + 2 * (F.bx - npost), NVWG = npost + 2 * (F.G - npost);
    unsigned char* ws = F_WS;
    const bf16_t* P = WSP(bf16_t, WS_P); bf16_t* KH = WSP(bf16_t, WS_KH);
    const float* rope = WSP(float, WS_ROPE);
    const float* kw = F_IN(16) + (size_t)l * DQK;
    const int h = lane >> 3, sub = lane & 7;
    const float sgn = (sub & 2) ? 1.f : -1.f;
    float kwr[8];
#pragma unroll
    for (int e = 0; e < 8; ++e) kwr[e] = kw[128 + sub * 8 + e];
    const float* RHp = WSP(float, WS_RH);
    for (int rf = 0; rf < ((REP_F & 1) ? 2 : 1); ++rf)
    for (int sh = 0; sh < nshare; ++sh)
    for (int row0 = (vwg0 + sh) * NWAVES + F.wave; row0 < MT; row0 += 4 * NVWG * NWAVES) {
        u32x4 l_kr[4]; float l_rh[4]; f32x4 rt[4][4];
#pragma unroll
        for (int k = 0; k < 4; ++k) { const int row = row0 + k * NVWG * NWAVES; const int rc = row < MT ? row : row0;
            l_kr[k] = *(const u32x4*)(P + (size_t)rc * NIN + OFF_KROPE + sub * 8); l_rh[k] = RHp[(size_t)rc * 8 + h];
            const int t = rc & (SEQ - 1); const int pos = (sub < 4) ? (t >> 6) : (t & 63);
            const f32x4* rp = (const f32x4*)(rope + (size_t)(pos * 16 + (sub & 1) * 8) * 2);
#pragma unroll
            for (int q4 = 0; q4 < 4; ++q4) rt[k][q4] = rp[q4]; }
        asm volatile("" ::: "memory");
#pragma unroll
        for (int k = 0; k < 4; ++k) { const int row = row0 + k * NVWG * NWAVES;
            if (row < MT) { const bool lat = row < MLAT;
                float r8[8], y[8]; unpack8(l_kr[k], r8);
#pragma unroll
                for (int e = 0; e < 8; ++e) { const float cs = lat ? rt[k][e >> 1][2 * (e & 1)] : 1.f, sn = lat ? rt[k][e >> 1][2 * (e & 1) + 1] : 0.f;
                    const float yy = r8[e] * l_rh[k] * kwr[e]; const float pr = lane_xor<2>(yy); y[e] = yy * cs + sgn * pr * sn; }
                *(u32x4*)(KH + (size_t)row * NQ + h * DQK + 128 + sub * 8) = pack8(y); } }
    }
    {
        bf16_t* mix = WSP(bf16_t, WS_HMIX);
        const int nrows = (l == 0) ? MT : MLAT;
        for (int rf = 0; rf < ((REP_F & 2) ? 2 : 1); ++rf)
        for (int sh = 0; sh < nshare; ++sh)
        for (int idx = (vwg0 + sh) * 512 + tidl; idx < nrows * 64; idx += NVWG * 512) { const int row = idx >> 6, cc = idx & 63, g = cc >> 4;
            const int w = 2 << g, lo = w >> 1, hi = w - lo - 1;
            const bool lat = row < MLAT; const int rr = lat ? row : row - MLAT;
            const int n = lat ? SEQ : CTX, t = rr & (n - 1), base = row - t;
            const int a = (t - lo) < 0 ? 0 : (t - lo), e = (t + hi) > (n - 1) ? (n - 1) : (t + hi);
            float s[8];
#pragma unroll
            for (int q = 0; q < 8; ++q) s[q] = 0.f;
            u32x4 wv[16]; const int cnt = e - a + 1;
#pragma unroll
            for (int k = 0; k < 16; ++k) wv[k] = (k < cnt) ? *(const u32x4*)(P + (size_t)(base + a + k) * NIN + OFF_POOL + cc * 8) : (u32x4){0u, 0u, 0u, 0u};
#pragma unroll
            for (int k = 0; k < 16; ++k) { float f[8]; unpack8(wv[k], f);
#pragma unroll
                for (int q = 0; q < 8; ++q) s[q] += f[q]; }
            float self[8], gt8[8]; unpack8(*(const u32x4*)(P + (size_t)row * NIN + OFF_POOL + cc * 8), self); unpack8(*(const u32x4*)(P + (size_t)row * NIN + OFF_PGATE + cc * 8), gt8);
            const float inv = 1.f / (float)(e - a + 1);
#pragma unroll
            for (int q = 0; q < 8; ++q) s[q] = siluf(gt8[q]) * (s[q] * inv - self[q]);
            *(u32x4*)(mix + (size_t)row * DM + cc * 8) = pack8(s); }
    }
}

__global__ void __launch_bounds__(NWAVES * 64, 2) fwd_kernel(Args args) {
    extern __shared__ __attribute__((aligned(16))) unsigned char lds[];
    Frame F;
    F.lds = lds;
    const int tid0 = threadIdx.x; F.wave = __builtin_amdgcn_readfirstlane(tid0 >> 6);
    F.G = NCU; F.bx = blockIdx.x; F.vcu = (F.bx % 8) * (NCU / 8) + F.bx / 8;
    LAS unsigned char* lds3 = (LAS unsigned char*)lds; F.lds3 = lds3;
    volatile LAS unsigned* MISC = (volatile LAS unsigned*)(lds3 + MISC_OFF);
    for (int u = tid0; u < (LDS_BYTES - LDSCTL_OFF) / 4; u += NWAVES * 64) ((LAS unsigned*)(lds3 + LDSCTL_OFF))[u] = 0u;
    __syncthreads();
    unsigned char* ws = F_WS;
    unsigned* ctl = (unsigned*)(ws + WS_CTL);
    XcdBarrier bar; bar.bar = ctl + CW_BAR; bar.x = 0; bar.st = nullptr;
    const int lo = MK_ONE_LAUNCH ? 0 : args.ph_lo, hi = MK_ONE_LAUNCH ? (1 + 6 * NL) : args.ph_hi;
    const bool multi = (hi - lo) > 1;
    if (multi) bar = xcd_barrier_post(ctl + CW_BAR, MISC + 8, tid0);
#ifndef PHM
#define PHM 0xff
#endif
#ifndef REP_MASK
#define REP_MASK 0
#endif
#define NREP(bit) ((REP_MASK & (bit)) ? 2 : 1)

    for (int ph = lo; ph < hi; ++ph) {
        const int l = (ph > 6) ? 1 : 0, kind = (ph == 0) ? 0 : ph - 6 * l;
        unsigned char* ws = F_WS;
        if ((PHM & 1) && kind == 0) { for (int rep = 0; rep < NREP(1); ++rep) { phase_prep(F, 0, F.vcu, F.G); __syncthreads(); } }
        if ((PHM & 2) && kind == 1) for (int rep = 0; rep < NREP(2); ++rep) phase_norm(F, l);
        if ((PHM & 4) && kind == 2) for (int rep = 0; rep < NREP(4); ++rep) {
            pg8::Gemm g{l == 0 ? WSP(bf16_t, WS_HMIX) : WSP(bf16_t, WS_KV), WSP(bf16_t, WS_WIN) + (size_t)l * NIN * DM, DM, DM, DM, 1 << 20, 0};
            pg8::StaticOrder S; S.init(MT / 256, NIN / 256, F.G, F.bx);
            pg8::Epi E{}; E.kind = 0; E.O = WSP(bf16_t, WS_P); E.ldc = NIN; E.rowoff = 0; E.cmul = 256; E.cadd = 0; E.csplit = 1 << 20; E.cadd2 = 0;
            E.xt_lat = WSP(bf16_t, WS_XTC); E.xt_ctx = WSP(bf16_t, WS_XTCC);
            if (l != 0) { E.rs = WSP(float, WS_RS); E.bias = WSP(float, WS_BIAS); }
            E.sqo = WSP(float, WS_SQ);
            for (int rc = 0; rc < ((REP_P & 16) ? 2 : 1); ++rc)
            pg8::gemm_phase<pg8::Epi, pg8::StaticOrder, true, true>(lds3, g, S, E, F.wave);
            { const int nfull = (MT / 256) * (NIN / 256) % F.G; const bool sub = nfull > 0 && nfull < F.G;
              if (!sub || F.bx >= nfull) { const int wgi = sub ? F.bx - nfull : F.bx, nwgi = sub ? F.G - nfull : F.G;
                  dft_gen(F, l, wgi, nwgi); __syncthreads(); phase_prep(F, l == 0 ? 1 : 2, wgi, nwgi); } }
        }
        if ((PHM & 16) && kind == 3) for (int rep = 0; rep < NREP(16); ++rep) {
            constexpr int split = 72;
            const int nrest = F.G - split;
            if (rep == 0) {
                FRESH_TID(tz_); const int lz = tz_ & 63; const int gwz = F.vcu * NWAVES + F.wave, NGWZ = F.G * NWAVES;
                bf16_t* XC = WSP(bf16_t, WS_XTC); bf16_t* PC = WSP(bf16_t, WS_PCS) + (size_t)2048 * PCSW;
                for (int r = gwz; r < 1040 + 1024; r += NGWZ) {
                    const bool cosr = r < 1040;
                    bf16_t* xr = XC + (size_t)(cosr ? r : r + 240) * DPITCH;
                    u32x4 lo[4], hi[4]; unsigned short f0[4];
#pragma unroll
                    for (int i = 0; i < 4; ++i) { const int c = i * 64 + lz;
                        lo[i] = *(const u32x4*)(xr + 8 * c); hi[i] = *(const u32x4*)(xr + 8 * (511 - c)); f0[i] = *(const unsigned short*)(xr + 4096 - 8 * c); }
                    asm volatile("s_waitcnt vmcnt(0)" ::: "memory");
                    float a = 0.f; const float sg = cosr ? 1.f : -1.f;
#pragma unroll
                    for (int i = 0; i < 4; ++i) { const int c = i * 64 + lz;
                        float L[8], H[8], f[8]; unpack8(lo[i], L); unpack8(hi[i], H);
                        f[0] = (c == 0) ? L[0] : L[0] + sg * bf2f(f0[i]);
#pragma unroll
                        for (int q = 1; q < 8; ++q) f[q] = L[q] + sg * H[8 - q];
                        a += ((f[0] - f[1]) + (f[2] - f[3])) + ((f[4] - f[5]) + (f[6] - f[7]));
                        *(u32x4*)(xr + 8 * c) = pack8(f); }
                    unsigned zz = 0u; asm volatile("" : "+v"(zz));
                    if (lz == 63) { a += bf2f((unsigned short)(hi[3].x & 0xffffu)); u32x4 z; z.x = hi[3].x & 0xffffu; z.y = zz; z.z = zz; z.w = zz; *(u32x4*)(xr + 2048) = z; }
                    if (lz < 15) { u32x4 z; z.x = zz; z.y = zz; z.z = zz; z.w = zz; *(u32x4*)(xr + 2056 + 8 * lz) = z; }
                    a = wave_sum(a) * 0.015625f;
                    if (cosr) { const int col = (r < 1024) ? ((r >> 8) * 512 + (r & 255)) : (2048 + (r - 1024)); if (lz == 0) PC[col] = (bf16_t)f2bf(a); }
                    else { const int q = r - 1040; if (lz == 0) PC[(q >> 8) * 512 + 256 + (q & 255)] = 0; }
                }
                asm volatile("s_waitcnt vmcnt(0)" ::: "memory");
                __syncthreads();
                if (tz_ == 0) { __builtin_amdgcn_fence(__ATOMIC_RELEASE, "agent"); asm volatile("s_waitcnt vmcnt(0)" ::: "memory"); (void)xb_add(WSP(unsigned, WS_CTL) + CW_FOLD + 64 * l, 1u); }
            }
            for (int jj = 0; jj < 7; ++jj) { const int job = (jj == 0) ? 5 : (jj < 6 ? jj - 1 : 6);
                pg8::Gemm g{}; pg8::RangeOrder S; pg8::Epi E{}; E.kind = 0; E.rowoff = 0; E.cmul = 256; E.cadd = 0; E.csplit = 1 << 20; E.cadd2 = 0; E.xt_lat = nullptr; E.xt_ctx = nullptr; E.mirror = 0;
                if (job == 0) {
                    if (F.bx < split) {
                        FRESH_TID(tw_);
                        if (tw_ == 0) { unsigned* cw = WSP(unsigned, WS_CTL); XB_SPIN(xb_ld(cw + CW_FOLD + 64 * l) < (unsigned)F.G, cw + CW_BAR); __builtin_amdgcn_fence(__ATOMIC_ACQUIRE, "agent"); asm volatile("s_waitcnt vmcnt(0)" ::: "memory"); }
                        __syncthreads(); }
                    g = pg8::Gemm{(l == 0) ? (const bf16_t*)F_OUT : WSP(bf16_t, WS_WIN), WSP(bf16_t, WS_XTC), KFOLD, DPITCH, KFOLD, 1 << 20, 0};
                    S.init(8, 5, 40, F.bx);
                    E.O = WSP(bf16_t, WS_PCS); E.ldc = PCSW; E.cmul = 512; E.csplit = 4; E.cadd2 = 2048; E.mirror = 1;
                } else if (job == 1) {
                    g = pg8::Gemm{((l == 0) ? (const bf16_t*)F_OUT : WSP(bf16_t, WS_WIN)) + (size_t)2048 * KFOLD, WSP(bf16_t, WS_XTS), KFOLD, DPITCH, KFOLD, 1 << 20, 0};
                    S.init(8, 4, 32, F.bx - 40);
                    E.O = WSP(bf16_t, WS_PCS); E.ldc = PCSW; E.cmul = 512; E.cadd = 256; E.mirror = -1;
                } else if (job == 2) {
                    if (l != 0) continue;
                    g = pg8::Gemm{WSP(bf16_t, WS_DCTX), WSP(bf16_t, WS_XTCC), 256, 256, 256, 1 << 20, 0};
                    S.init(1, 5, 5, F.bx - split - 72);
                    E.O = WSP(bf16_t, WS_PCSC); E.ldc = PCSW; E.cmul = 512; E.csplit = 4; E.cadd2 = 2048;
                } else if (job == 3) {
                    if (l != 0) continue;
                    g = pg8::Gemm{WSP(bf16_t, WS_DCTX) + 65536, WSP(bf16_t, WS_XTSC), 256, 256, 256, 1 << 20, 0};
                    S.init(1, 4, 4, F.bx - split - 77);
                    E.O = WSP(bf16_t, WS_PCSC); E.ldc = PCSW; E.cmul = 512; E.cadd = 256;
                } else if (job == 4) {
                    g = pg8::Gemm{WSP(bf16_t, WS_P) + OFF_CQ, WSP(bf16_t, WS_WUQ) + (size_t)l * NQ * 512, NIN, 512, 512, 1 << 20, 0};
                    S.init(l == 0 ? MT / 256 : MLAT / 256, NQ / 256, nrest, F.bx - split);
                    E.O = WSP(bf16_t, WS_Q); E.ldc = NQ; E.sq8 = WSP(float, WS_SQ);
                } else {
                    g = pg8::Gemm{WSP(bf16_t, WS_P) + OFF_CKV, WSP(bf16_t, WS_WUKV) + (size_t)l * NKV * 512, NIN, 512, 512, 1 << 20, 0};
                    if (job == 5) S.init_range(MT / 256, NKV / 256, 0, 2 * split, split, F.bx);
                    else S.init_range(MT / 256, NKV / 256, 2 * split, (MT / 256) * (NKV / 256), nrest, F.bx >= split ? (F.bx - split + 144) % nrest : -1);
                    E.O = (l == 0) ? WSP(bf16_t, WS_KV) : (bf16_t*)F_OUT; E.ldc = NKV; E.sq8 = WSP(float, WS_SQ) + (size_t)8 * MT;
                    E.kind = 4; E.kr2 = WSP(float, WS_SQ) + (size_t)16 * MT; E.kh = WSP(bf16_t, WS_KH); E.rh = WSP(float, WS_RH); E.kw = F_IN(16) + (size_t)l * DQK; E.qwk = F_IN(15) + (size_t)l * DQK;
                    E.part = (LAS float*)(lds3 + 132096);
                }
                if (job >= 5) { pg8::Epi4 E4{E}; pg8::gemm_phase<pg8::Epi4, pg8::RangeOrder, true, true>(lds3, g, S, E4, F.wave); }
                else
                for (int rj = 0; rj < (((REP_EJ >> job) & 1) ? 2 : 1); ++rj)
                pg8::gemm_phase<pg8::Epi, pg8::RangeOrder, true, true>(lds3, g, S, E, F.wave);
            }
        }
        if ((PHM & 32) && kind == 4) for (int rep = 0; rep < NREP(32); ++rep) {
            phase_heads_pool(F, l, rep == 0);
            __syncthreads();
            for (int job = 0; job < 2; ++job) {
                if (job == 1 && l != 0) continue;
                pg8::Gemm g{}; pg8::RangeOrder S; pg8::Epi E{}; E.kind = 1; E.O = WSP(bf16_t, WS_HMIX); E.ldc = DM; E.P = WSP(bf16_t, WS_P);
                E.fw = F_IN(10) + (size_t)l * 4 * 128 * 128;
                if (job == 0) { g = pg8::Gemm{WSP(bf16_t, WS_PCS), WSP(bf16_t, WS_FWAB) + (size_t)l * 512 * 512, PCSW, 512, 512, 16, 512};
                    S.init(64, 2, F.G, F.bx); E.rowoff = 0; E.NY = WSP(bf16_t, WS_PCS); E.nseq = SEQ; E.lgseq = 12; }
                else { g = pg8::Gemm{WSP(bf16_t, WS_PCSC), WSP(bf16_t, WS_FWAB) + (size_t)l * 512 * 512, PCSW, 512, 512, 1, 512};
                    S.init_range(4, 2, 0, 8, 8, F.bx - 128); E.rowoff = MLAT; E.NY = WSP(bf16_t, WS_PCSC); E.nseq = CTX; E.lgseq = 8; }
                for (int rf = 0; rf < ((REP_F & 4) ? 2 : 1); ++rf)
                pg8::gemm_phase<pg8::Epi, pg8::RangeOrder, true, true>(lds3, g, S, E, F.wave);
            }
        }
        if ((PHM & 64) && kind == 5) for (int rep = 0; rep < NREP(64); ++rep) {
            const bf16_t* Qg = WSP(bf16_t, WS_Q); const bf16_t* KHg = WSP(bf16_t, WS_KH); const bf16_t* KVg = (l == 0) ? WSP(bf16_t, WS_KV) : (const bf16_t*)F_OUT; const bf16_t* Pg = WSP(bf16_t, WS_P); bf16_t* mix = WSP(bf16_t, WS_HMIX);
            const float* qhw = F_IN(15) + (size_t)l * DQK; const float* ropet = WSP(float, WS_ROPE);
            const float negMC = __builtin_bit_cast(float, __builtin_amdgcn_readfirstlane(__builtin_bit_cast(int, WSP(float, WS_SMB)[l])));
            for (int u = F.vcu; u < NB * NH * 16; u += F.G) {
                const int bh = u >> 4, qb = u & 15, b = bh >> 3, h = bh & 7;
                att::attn_unit(Qg, KHg, KVg, Pg, mix, qhw, ropet, h, b * SEQ + qb * 256, MLAT + b * CTX, b * SEQ, 4, 68, negMC, (char*)lds, F.wave);
            }
            if (l == 0) for (int u = F.vcu; u < NB * NH; u += F.G) {
                const int b = u >> 3, h = u & 7;
                att::attn_unit(Qg, KHg, KVg, Pg, mix, qhw, ropet, h, MLAT + b * CTX, MLAT + b * CTX, 0, 4, 4, negMC, (char*)lds, F.wave);
            }
        }
        if ((PHM & 128) && kind == 6) for (int rep = 0; rep < (l == 0 ? NREP(128) : 1); ++rep) {
            if (l == 0) for (int kq = 0; kq < 4; ++kq) {
                pg8::Gemm g{WSP(bf16_t, WS_HMIX) + (size_t)MLAT * DM + kq * 512, WSP(bf16_t, WS_WOUT) + kq * 512, DM, DM, 512, 1 << 20, 0};
                pg8::RangeOrder S; if (F.G >= 128) S.init(MCTX / 256, DM / 256, 32, F.bx - kq * 32); else S.init(MCTX / 256, DM / 256, F.G, F.bx);
                pg8::Epi E{}; E.kind = 3; E.out_ctx = WSP(float, WS_Q) + (size_t)kq * MCTX * DM;
                pg8::gemm_phase<pg8::Epi, pg8::RangeOrder, true, true>(lds3, g, S, E, F.wave);
            }
            { pg8::Gemm g{WSP(bf16_t, WS_HMIX), WSP(bf16_t, WS_WOUT) + (size_t)l * DM * DM, DM, DM, DM, 1 << 20, 0};
              pg8::StaticOrder S; S.init(MLAT / 256, DM / 256, F.G, F.bx);
              pg8::Epi E{}; E.kind = 2; E.mods = WSP(float, WS_MODS) + (size_t)l * 5 * 6144;
              E.xin_lat = (l == 0) ? F_IN(0) : (const float*)F_OUT; E.xin_ctx = nullptr; E.out_lat = F_OUT; E.out_ctx = nullptr;
              E.nw1 = F_IN(4) + DM; E.sc1 = WSP(float, WS_MODS) + (size_t)5 * 6144 + 2048;
              if (l == 0) { E.xb = WSP(bf16_t, WS_KV); E.ss = WSP(float, WS_SS); } else E.xbr = WSP(bf16_t, WS_KV);
              pg8::gemm_phase<pg8::Epi, pg8::StaticOrder, true, true>(lds3, g, S, E, F.wave); }
        }
        if (ph + 1 < hi) { FRESH_TID(tb_); xcd_barrier(bar, tb_); }
    }
}

constexpr int N_PHASES = 1 + 6 * NL;
extern "C" void kernel_launch(void* const* d_in, const int* in_sizes, int n_in, void* d_out, int out_size, void* d_ws, size_t ws_size, hipStream_t stream) {
    static int grid = 0;
    if (grid == 0) {
        if (n_in != 18 || out_size != MLAT * DM || ws_size < WS_END) { fprintf(stderr, "kernel_launch: unexpected shapes (n_in %d out %d ws %zu need %zu)\n", n_in, out_size, ws_size, (size_t)WS_END); grid = -1; return; }
        int dev = 0, cus = 0;
        if (hipGetDevice(&dev) != hipSuccess || hipDeviceGetAttribute(&cus, hipDeviceAttributeMultiprocessorCount, dev) != hipSuccess) { grid = -1; return; }
        if (hipFuncSetAttribute((const void*)fwd_kernel, hipFuncAttributeMaxDynamicSharedMemorySize, LDS_BYTES) != hipSuccess) { fprintf(stderr, "kernel_launch: hipFuncSetAttribute failed\n"); grid = -1; return; }
        if (cus != NCU) fprintf(stderr, "kernel_launch: built for %d CUs, device reports %d\n", NCU, cus);
        grid = NCU;
    }
    if (grid < 0) return;
    (void)hipMemsetAsync((char*)d_ws + WS_CTL, 0, 65536, stream);
    Args a{};
    for (int i = 0; i < 18; ++i) a.in[i] = d_in[i];
    a.out = (float*)d_out; a.ws = (unsigned char*)d_ws;
#if MK_ONE_LAUNCH
    a.ph_lo = 0; a.ph_hi = N_PHASES;
    hipLaunchKernelGGL(fwd_kernel, dim3(grid), dim3(NWAVES * 64), LDS_BYTES, stream, a);
#else
    for (int p = 0; p < N_PHASES; ++p) { a.ph_lo = p; a.ph_hi = p + 1; hipLaunchKernelGGL(fwd_kernel, dim3(grid), dim3(NWAVES * 64), LDS_BYTES, stream, a); }
#endif
}
```

```cpp
#include <hip/hip_runtime.h>
#include <hip/hip_bf16.h>
#include <cstdio>
#include <cstdint>
#include <cmath>

#ifndef MK_ONE_LAUNCH
#define MK_ONE_LAUNCH 1
#endif
#ifndef REP_EJ
#define REP_EJ 0
#endif
#ifndef REP_F
#define REP_F 0
#endif
#ifndef REP_P
#define REP_P 0
#endif

constexpr int DM = 2048, NB = 4, SEQ = 4096, NL = 2, CTX = 256;
constexpr int MLAT = NB * SEQ, MCTX = NB * CTX, MT = MLAT + MCTX;
constexpr int DIN = 4160, NIN = 4352;
constexpr int OFF_POOL = 0, OFF_PGATE = 512, OFF_FNET = 1024, OFF_FGATE = 1536, OFF_CQ = 2048, OFF_CKV = 2560, OFF_KROPE = 3072, OFF_MGATE = 3136;
constexpr int NH = 8, DQK = 192, NQ = NH * DQK, NKV = NH * 256;
constexpr int PCSW = 2304;
constexpr int DPITCH = SEQ + 64;
constexpr float EPS = 1e-6f;

constexpr size_t al256(size_t x) { return (x + 255) / 256 * 256; }
constexpr size_t WS_CTL = 0, CTL_BYTES = 1u << 20;
constexpr size_t WS_MODS = WS_CTL + CTL_BYTES;
constexpr size_t WS_ROPE = WS_MODS + al256((size_t)NL * 5 * 6144 * 4);
constexpr size_t WS_SMB = WS_ROPE + al256(64 * 16 * 2 * 4);
constexpr size_t WS_WIN = WS_SMB + 256;
constexpr size_t WS_WUQ = WS_WIN + (size_t)NL * NIN * DM * 2;
constexpr size_t WS_WUKV = WS_WUQ + (size_t)NL * NQ * 512 * 2;
constexpr size_t WS_WOUT = WS_WUKV + (size_t)NL * NKV * 512 * 2;
constexpr size_t WS_FWAB = WS_WOUT + (size_t)NL * DM * DM * 2;
constexpr size_t WS_DCTX = WS_FWAB + (size_t)NL * 512 * 512 * 2;
constexpr size_t WS_HMIX = WS_DCTX + 2 * 256 * 256 * 2;
constexpr size_t WS_P = WS_HMIX + (size_t)MT * DM * 2;
constexpr size_t WS_Q = WS_P + (size_t)MT * NIN * 2;
constexpr size_t WS_KV = WS_Q + (size_t)MT * NQ * 2;
constexpr size_t WS_XTC = WS_KV + (size_t)MT * NKV * 2;
constexpr size_t WS_XTS = WS_XTC + (size_t)1280 * DPITCH * 2;
constexpr size_t WS_XTCC = WS_XTS + (size_t)1024 * DPITCH * 2;
constexpr size_t WS_XTSC = WS_XTCC + (size_t)1280 * 256 * 2;
constexpr size_t WS_PCS = WS_XTSC + (size_t)1024 * 256 * 2;
constexpr size_t WS_PCSC = WS_PCS + (size_t)4096 * PCSW * 2;
constexpr size_t WS_CTXN = WS_PCSC + (size_t)256 * PCSW * 2;
constexpr size_t WS_KH = WS_CTXN + (size_t)MCTX * DM * 4;
constexpr size_t WS_SS = WS_KH + (size_t)MT * NQ * 2;
constexpr size_t WS_RS = WS_SS + (size_t)MLAT * 32 * 4;
constexpr size_t WS_BIAS = WS_RS + al256((size_t)MT * 4);
constexpr size_t WS_SQ = WS_BIAS + al256((size_t)5 * NIN * 4);
constexpr size_t WS_RH = WS_SQ + (size_t)18 * MT * 4;
constexpr size_t WS_END = WS_RH + (size_t)MT * 8 * 4;
static_assert((size_t)2 * 2048 * 2176 * 2 <= (size_t)NIN * DM * 2, "layer-1 DFT matrices fit layer 0's WinT");
static_assert(WS_END <= (size_t)512 * 1024 * 1024, "workspace map exceeds 512 MiB");

#define LAS __attribute__((address_space(3)))
typedef unsigned short bf16_t;
typedef short bf16x8 __attribute__((ext_vector_type(8)));
typedef short s16x4 __attribute__((ext_vector_type(4)));
typedef float f32x4 __attribute__((ext_vector_type(4)));
typedef float f32x2 __attribute__((ext_vector_type(2)));
typedef float f32x16 __attribute__((ext_vector_type(16)));
typedef unsigned u32x4 __attribute__((ext_vector_type(4)));
typedef unsigned u32x2 __attribute__((ext_vector_type(2)));
#define RLX_AGENT __ATOMIC_RELAXED, __HIP_MEMORY_SCOPE_AGENT

__device__ __forceinline__ int lane_id() { int r; asm volatile("v_mbcnt_lo_u32_b32 %0, -1, 0\n\tv_mbcnt_hi_u32_b32 %0, -1, %0" : "=v"(r)); return r; }
__device__ __forceinline__ unsigned f2bf(float f) { unsigned u = __builtin_bit_cast(unsigned, f); return (u + 0x7fffu + ((u >> 16) & 1u)) >> 16; }
__device__ __forceinline__ unsigned pk2(float lo, float hi) { return f2bf(lo) | (f2bf(hi) << 16); }
__device__ __forceinline__ float bf2f(unsigned short h) { return __builtin_bit_cast(float, (unsigned)h << 16); }
__device__ __forceinline__ float bflo(unsigned w) { return __builtin_bit_cast(float, w << 16); }
__device__ __forceinline__ float bfhi(unsigned w) { return __builtin_bit_cast(float, w & 0xffff0000u); }
__device__ __forceinline__ float siluf(float v) { return v * __builtin_amdgcn_rcpf(1.f + __builtin_amdgcn_exp2f(-1.4426950408889634f * v)); }
template <int O> __device__ __forceinline__ float lane_xor(float v) {
    return __builtin_bit_cast(float, __builtin_amdgcn_ds_swizzle(__builtin_bit_cast(int, v), (O << 10) | 0x1f));
}
__device__ __forceinline__ float wave_sum(float v) {
    v += lane_xor<1>(v); v += lane_xor<2>(v); v += lane_xor<4>(v); v += lane_xor<8>(v); v += lane_xor<16>(v);
    auto rr = __builtin_amdgcn_permlane32_swap(__float_as_uint(v), __float_as_uint(v), false, false);
    return __uint_as_float(rr[0]) + __uint_as_float(rr[1]);
}
__device__ __forceinline__ float wave_max(float v) {
    v = fmaxf(v, lane_xor<1>(v)); v = fmaxf(v, lane_xor<2>(v)); v = fmaxf(v, lane_xor<4>(v)); v = fmaxf(v, lane_xor<8>(v)); v = fmaxf(v, lane_xor<16>(v));
    auto rr = __builtin_amdgcn_permlane32_swap(__float_as_uint(v), __float_as_uint(v), false, false);
    return fmaxf(__uint_as_float(rr[0]), __uint_as_float(rr[1]));
}
__device__ __forceinline__ void unpack8(const u32x4 w, float* f) {
    f[0] = bflo(w.x); f[1] = bfhi(w.x); f[2] = bflo(w.y); f[3] = bfhi(w.y); f[4] = bflo(w.z); f[5] = bfhi(w.z); f[6] = bflo(w.w); f[7] = bfhi(w.w);
}
__device__ __forceinline__ u32x4 pack8(const float* f) { u32x4 w; w.x = pk2(f[0], f[1]); w.y = pk2(f[2], f[3]); w.z = pk2(f[4], f[5]); w.w = pk2(f[6], f[7]); return w; }

namespace pg8 {
#define PG8_LAS __attribute__((address_space(3)))
constexpr int BM = 256, BK = 64, HALF = 128, HTB = HALF * BK * 2, STAGE_BYTES = 8 * HTB, NXCD = 8, WGM = 8;
__host__ __device__ __forceinline__ int lds_byte(int r, int c) { const int st = (r >> 4) * 2 + (c >> 5), rr = r & 15, cc = c & 31, ob = rr * 64 + cc * 2; return st * 1024 + (ob ^ (((ob >> 9) & 1) << 5)); }
__host__ __device__ __forceinline__ void stage_rc(int b, int& R, int& C) { const int st = b / 1024, sb = b % 1024, swz = sb ^ (((sb >> 9) & 1) << 5); R = (st >> 1) * 16 + swz / 64; C = (st & 1) * 32 + (swz % 64) / 2; }
__host__ __device__ __forceinline__ int perm32(int rho) { const int n = rho >> 4, i = rho & 15; return 8 * (i >> 2) + 4 * n + (i & 3); }

struct Unit { int pm, pn; };
struct Gemm { const bf16_t* A; const bf16_t* Bt; int lda, ldb, K, mper; long abatch; };

template <int WG_M> struct StaticOrderT {
    int nM, nN, nwg, G, c;
    __device__ void init(int nM_, int nN_, int G_, int c_) { nM = nM_; nN = nN_; nwg = nM * nN; G = G_; c = c_; }
    __device__ bool next(int i, Unit& u) const {
        const long L = (long)i * G + c; if (c < 0 || L >= nwg) return false;
        int wgid = (int)L; { const int q = nwg / NXCD, r = nwg % NXCD, xcd = wgid % NXCD, off = wgid / NXCD; wgid = (xcd < r ? xcd * (q + 1) : r * (q + 1) + (xcd - r) * q) + off; }
        const int nig = WG_M * nN, gid = wgid / nig, fm = gid * WG_M, rem = wgid - gid * nig;
        u.pm = fm + (rem % WG_M); u.pn = rem / WG_M; return true;
    }
};
typedef StaticOrderT<4> StaticOrder;
struct RangeOrder {
    int nM, nN, first, last, G, c;
    __device__ void init(int nM_, int nN_, int G_, int c_) { nM = nM_; nN = nN_; first = 0; last = nM_ * nN_; G = G_; c = (c_ >= 0 && c_ < G_) ? c_ : -1; }
    __device__ void init_range(int nM_, int nN_, int first_, int last_, int G_, int c_) { nM = nM_; nN = nN_; first = first_; last = last_; G = G_; c = (c_ >= 0 && c_ < G_) ? c_ : -1; }
    __device__ bool next(int i, Unit& u) const {
        if (c < 0) return false; const long L = (long)first + (long)i * G + c; if (L >= last) return false;
        u.pm = (int)(L % nM); u.pn = (int)(L / nM); return true;
    }
};

__device__ __forceinline__ unsigned cvt_pk_bf16(float lo, float hi) { unsigned r; asm volatile("v_cvt_pk_bf16_f32 %0, %1, %2" : "=v"(r) : "v"(lo), "v"(hi)); return r; }

struct Epi {
    static constexpr bool PERM = true, AFTER_DRAIN = false;
    int kind;
    bf16_t* O; int ldc; int rowoff; int cmul, cadd, csplit, cadd2;
    int mirror;
    bf16_t* xt_lat; bf16_t* xt_ctx;
    const float* kr2; bf16_t* kh; float* rh; const float* kw; const float* qwk; PG8_LAS float* part;
    const float* sq8; float* sqo;
    const float* rs; const float* bias;
    const bf16_t* P; const bf16_t* NY; const float* fw; int nseq, lgseq;
    const float* xin_lat; const float* xin_ctx; float* out_lat; float* out_ctx; const float* mods;
    const bf16_t* xbr;
    bf16_t* xb; const float* nw1; const float* sc1; float* ss;
    __device__ __forceinline__ void k4(f32x4 (&acc)[2][2][4][2], const Unit& u, int wr, int wc, int fr, int fq) const {
        const int row0 = u.pm * BM + wr * 64 + fr;
        const int cl0 = wc * 32 + 8 * fq;
        {
            const int h = u.pn, rowl0 = wr * 64 + fr;
#pragma unroll
            for (int ai = 0; ai < 2; ++ai) {
                float t[4][8], rr4[4];
#pragma unroll
                for (int m = 0; m < 4; ++m)
#pragma unroll
                    for (int k = 0; k < 8; ++k) t[m][k] = sq8[(size_t)k * MT + (row0 + ai * HALF + m * 16)];
#pragma unroll
                for (int m = 0; m < 4; ++m) rr4[m] = 1.0f / sqrtf((((t[m][0] + t[m][1]) + (t[m][2] + t[m][3])) + ((t[m][4] + t[m][5]) + (t[m][6] + t[m][7]))) * (1.f / 512.f) + EPS);
#pragma unroll
                for (int m = 0; m < 4; ++m) { const int rk = row0 + ai * HALF + m * 16; const float rr = rr4[m];
                    { const f32x4 v0 = acc[ai][1][m][0] * rr, v1 = acc[ai][1][m][1] * rr;
                      u32x4 w; w.x = cvt_pk_bf16(v0[0], v0[1]); w.y = cvt_pk_bf16(v0[2], v0[3]); w.z = cvt_pk_bf16(v1[0], v1[1]); w.w = cvt_pk_bf16(v1[2], v1[3]);
                      *(u32x4*)(O + (size_t)rk * ldc + h * 256 + HALF + cl0) = w; }
                    acc[ai][0][m][0] = acc[ai][0][m][0] * rr; acc[ai][0][m][1] = acc[ai][0][m][1] * rr;
                    const f32x4 k0 = acc[ai][0][m][0], k1 = acc[ai][0][m][1];
                    float sq = ((k0[0] * k0[0] + k0[1] * k0[1]) + (k0[2] * k0[2] + k0[3] * k0[3])) + ((k1[0] * k1[0] + k1[1] * k1[1]) + (k1[2] * k1[2] + k1[3] * k1[3]));
                    sq += lane_xor<16>(sq);
                    { auto pr = __builtin_amdgcn_permlane32_swap(__float_as_uint(sq), __float_as_uint(sq), false, false); sq = __uint_as_float(pr[0]) + __uint_as_float(pr[1]); }
                    if (fq == 0) part[wc * 256 + rowl0 + ai * HALF + m * 16] = sq; }
            }
            float krs[2][4];
#pragma unroll
            for (int ai = 0; ai < 2; ++ai)
#pragma unroll
                for (int m = 0; m < 4; ++m) { const int rk = row0 + ai * HALF + m * 16; typedef const __attribute__((address_space(1))) float* gfp;
                    krs[ai][m] = ((gfp)kr2)[rk] + ((gfp)kr2)[(size_t)MT + rk]; }
            asm volatile("s_waitcnt lgkmcnt(0)" ::: "memory");
            __builtin_amdgcn_s_barrier();
            const f32x4 kw0 = *(const f32x4*)(kw + cl0) * *(const f32x4*)(qwk + cl0), kw1 = *(const f32x4*)(kw + cl0 + 4) * *(const f32x4*)(qwk + cl0 + 4);
#pragma unroll
            for (int ai = 0; ai < 2; ++ai)
#pragma unroll
                for (int m = 0; m < 4; ++m) { const int rk = row0 + ai * HALF + m * 16, rl = rowl0 + ai * HALF + m * 16;
                    const float tot = ((part[rl] + part[256 + rl]) + (part[512 + rl] + part[768 + rl])) + krs[ai][m];
                    const float rhv = 1.0f / sqrtf(tot * (1.f / 192.f) + EPS);
                    if (wc == 0 && fq == 0) rh[(size_t)rk * 8 + h] = rhv;
                    const f32x4 k0 = acc[ai][0][m][0] * rhv * kw0, k1 = acc[ai][0][m][1] * rhv * kw1;
                    u32x4 w; w.x = cvt_pk_bf16(k0[0], k0[1]); w.y = cvt_pk_bf16(k0[2], k0[3]); w.z = cvt_pk_bf16(k1[0], k1[1]); w.w = cvt_pk_bf16(k1[2], k1[3]);
                    *(u32x4*)(kh + (size_t)rk * (8 * 192) + h * 192 + cl0) = w; }
        }
    }
    __device__ __forceinline__ void operator()(f32x4 (&acc)[2][2][4][2], const Unit& u, int wr, int wc, int fr, int fq) const {
        const int row0 = u.pm * BM + wr * 64 + fr;
        const int cl0 = wc * 32 + 8 * fq;
        if (kind == 0 && xt_lat && (u.pn == 4 || u.pn == 5)) {
            const bool lat = u.pm < MLAT / 256;
            const int b = lat ? (u.pm >> 4) : (u.pm - MLAT / 256);
            const int nseq = lat ? DPITCH : CTX;
            bf16_t* XC = lat ? xt_lat : xt_ctx; bf16_t* XS = XC + (size_t)1280 * nseq;
            const int tok0 = (lat ? (u.pm & 15) * 256 : 0) + wr * 64 + fr;
            float rv[2][4];
#pragma unroll
            for (int ai = 0; ai < 2; ++ai)
#pragma unroll
                for (int m = 0; m < 4; ++m) rv[ai][m] = rs ? rs[row0 + ai * HALF + m * 16] : 1.f;
#pragma unroll
            for (int bj = 0; bj < 2; ++bj) {
                const int n0 = (u.pn - 4) * BM + bj * HALF + cl0, g = n0 >> 7, j0 = n0 & 127;
                f32x4 bz[2]; bz[0] = (f32x4){0.f, 0.f, 0.f, 0.f}; bz[1] = bz[0];
                if (rs) { const float* bp = bias + (size_t)(lat ? b : 4) * NIN + u.pn * BM + bj * HALF + cl0; bz[0] = *(const f32x4*)bp; bz[1] = *(const f32x4*)(bp + 4); }
                bf16_t* base = (j0 < 64 ? XC + (size_t)(b * 256 + g * 64 + j0) * nseq : XS + (size_t)(b * 256 + g * 64 + (j0 - 64)) * nseq) + tok0;
                bf16_t* nyq = XC + (size_t)(1024 + b * 4 + g) * nseq + tok0;
#pragma unroll
                for (int ai = 0; ai < 2; ++ai)
#pragma unroll
                    for (int m = 0; m < 4; ++m) { const int to = ai * HALF + m * 16;
#pragma unroll
                        for (int n = 0; n < 2; ++n)
#pragma unroll
                            for (int e = 0; e < 4; ++e) base[(size_t)(4 * n + e) * nseq + to] = (bf16_t)f2bf(acc[ai][bj][m][n][e] * rv[ai][m] + bz[n][e]);
                        if (j0 == 64) nyq[to] = (bf16_t)f2bf(acc[ai][bj][m][0][0] * rv[ai][m] + bz[0][0]); }
            }
        } else if (kind == 0) {
            const int dcol = (u.pn < csplit ? u.pn * cmul + cadd : cadd2) + cl0;
            f32x4 bz[2][2];
#pragma unroll
            for (int bj = 0; bj < 2; ++bj) { bz[bj][0] = (f32x4){0.f, 0.f, 0.f, 0.f}; bz[bj][1] = bz[bj][0]; }
            if (rs) { const float* bp = bias + (size_t)(row0 < MLAT ? (row0 >> 12) : 4) * NIN + dcol;
#pragma unroll
                for (int bj = 0; bj < 2; ++bj) { bz[bj][0] = *(const f32x4*)(bp + bj * HALF); bz[bj][1] = *(const f32x4*)(bp + bj * HALF + 4); } }
            const bool wsq = sqo != nullptr && ((u.pn >= 8 && u.pn < 12) || (u.pn == 12 && wc < 2));
#pragma unroll
            for (int ai = 0; ai < 2; ++ai) {
                float rr4[4];
                if (sq8) {
                    float t[4][8];
#pragma unroll
                    for (int m = 0; m < 4; ++m)
#pragma unroll
                        for (int k = 0; k < 8; ++k) t[m][k] = sq8[(size_t)k * MT + (rowoff + row0 + ai * HALF + m * 16)];
#pragma unroll
                    for (int m = 0; m < 4; ++m) rr4[m] = 1.0f / sqrtf((((t[m][0] + t[m][1]) + (t[m][2] + t[m][3])) + ((t[m][4] + t[m][5]) + (t[m][6] + t[m][7]))) * (1.f / 512.f) + EPS);
                } else {
#pragma unroll
                    for (int m = 0; m < 4; ++m) rr4[m] = rs ? rs[rowoff + row0 + ai * HALF + m * 16] : 1.f;
                }
#pragma unroll
                for (int m = 0; m < 4; ++m) { const int rk = rowoff + row0 + ai * HALF + m * 16; bf16_t* rowp = O + (size_t)rk * ldc + dcol;
                    bf16_t* mirp = O + (size_t)(SEQ - rk) * ldc + dcol; const unsigned sx = (mirror < 0) ? 0x80008000u : 0u;
                    const float rr = rr4[m]; float sq = 0.f;
#pragma unroll
                    for (int bj = 0; bj < 2; ++bj) { const f32x4 v0 = acc[ai][bj][m][0] * rr + bz[bj][0], v1 = acc[ai][bj][m][1] * rr + bz[bj][1];
                        u32x4 w; w.x = cvt_pk_bf16(v0[0], v0[1]); w.y = cvt_pk_bf16(v0[2], v0[3]); w.z = cvt_pk_bf16(v1[0], v1[1]); w.w = cvt_pk_bf16(v1[2], v1[3]);
                        const bool st = dcol + bj * HALF < DIN && !(mirror > 0 && u.pn >= csplit && cl0 + bj * HALF >= 16);
                        if (st) *(u32x4*)(rowp + bj * HALF) = w;
                        if (st && mirror != 0 && rk > 0) { u32x4 wm; wm.x = w.x ^ sx; wm.y = w.y ^ sx; wm.z = w.z ^ sx; wm.w = w.w ^ sx; *(u32x4*)(mirp + bj * HALF) = wm; }
                        if (wsq && (u.pn != 12 || bj == 0)) sq += ((v0[0] * v0[0] + v0[1] * v0[1]) + (v0[2] * v0[2] + v0[3] * v0[3])) + ((v1[0] * v1[0] + v1[1] * v1[1]) + (v1[2] * v1[2] + v1[3] * v1[3])); }
                    if (wsq) { sq += lane_xor<16>(sq);
                        { auto pr = __builtin_amdgcn_permlane32_swap(__float_as_uint(sq), __float_as_uint(sq), false, false); sq = __uint_as_float(pr[0]) + __uint_as_float(pr[1]); }
                        if (fq == 0) sqo[(size_t)((u.pn - 8) * 4 + wc) * MT + rk] = sq; } }
            }
        } else if (kind == 1) {
#pragma unroll
            for (int bj = 0; bj < 2; ++bj) {
                const int n0 = u.pn * BM + bj * HALF + cl0;
                const int g = n0 >> 7, d0 = n0 & 127;
                const f32x4 f0 = *(const f32x4*)(fw + (size_t)(g * 128 + 64) * 128 + d0), f1 = *(const f32x4*)(fw + (size_t)(g * 128 + 64) * 128 + d0 + 4);
                u32x4 gw[2][4]; unsigned short nyb[2][4];
#pragma unroll
                for (int ai = 0; ai < 2; ++ai)
#pragma unroll
                    for (int m = 0; m < 4; ++m) { const int rl = row0 + ai * HALF + m * 16; const int b = rl >> lgseq, k = rl & (nseq - 1);
                        nyb[ai][m] = NY[(size_t)k * PCSW + 2048 + b * 4 + g]; gw[ai][m] = *(const u32x4*)(P + ((size_t)rowoff + rl) * NIN + OFF_FGATE + n0); }
                asm volatile("" ::: "memory");
#pragma unroll
                for (int ai = 0; ai < 2; ++ai)
#pragma unroll
                    for (int m = 0; m < 4; ++m) {
                        const size_t R = (size_t)rowoff + row0 + ai * HALF + m * 16;
                        const float ny = bf2f(nyb[ai][m]);
                        float gt[8]; unpack8(gw[ai][m], gt);
                        const f32x4 v0 = acc[ai][bj][m][0], v1 = acc[ai][bj][m][1];
                        float o[8];
#pragma unroll
                        for (int e = 0; e < 4; ++e) { o[e] = (v0[e] + ny * f0[e]) * siluf(gt[e]); o[4 + e] = (v1[e] + ny * f1[e]) * siluf(gt[4 + e]); }
                        u32x4 w; w.x = cvt_pk_bf16(o[0], o[1]); w.y = cvt_pk_bf16(o[2], o[3]); w.z = cvt_pk_bf16(o[4], o[5]); w.w = cvt_pk_bf16(o[6], o[7]);
                        *(u32x4*)(O + R * ldc + 512 + n0) = w;
                    }
                asm volatile("" ::: "memory");
            }
        } else if (kind == 3) {
#pragma unroll
            for (int ai = 0; ai < 2; ++ai)
#pragma unroll
                for (int m = 0; m < 4; ++m) { float* xo = out_ctx + (size_t)(row0 + ai * HALF + m * 16) * DM + u.pn * BM + cl0;
#pragma unroll
                    for (int bj = 0; bj < 2; ++bj)
#pragma unroll
                        for (int n = 0; n < 2; ++n) *(f32x4*)(xo + bj * HALF + 4 * n) = acc[ai][bj][m][n]; }
        } else {
            const int R0 = row0;
            const bool lat = R0 < MLAT;
            const int mr = lat ? (R0 >> 12) : 4;
            const float* xi0 = (lat ? xin_lat + (size_t)R0 * DM : xin_ctx + (size_t)(R0 - MLAT) * DM) + u.pn * BM + cl0;
            float* xo0 = (lat ? out_lat + (size_t)R0 * DM : out_ctx + (size_t)(R0 - MLAT) * DM) + u.pn * BM + cl0;
            const float* gp = mods + (size_t)mr * 6144 + 4096 + u.pn * BM + cl0;
            f32x4 gv[2][2], cf[2][2];
#pragma unroll
            for (int bj = 0; bj < 2; ++bj)
#pragma unroll
                for (int n = 0; n < 2; ++n) { gv[bj][n] = *(const f32x4*)(gp + bj * HALF + 4 * n); cf[bj][n] = gv[bj][n]; }
            if (xb || xbr) { const float* n1 = nw1 + u.pn * BM + cl0; const float* s1 = sc1 + (size_t)mr * 6144 + u.pn * BM + cl0;
#pragma unroll
                for (int bj = 0; bj < 2; ++bj)
#pragma unroll
                    for (int n = 0; n < 2; ++n) cf[bj][n] = *(const f32x4*)(n1 + bj * HALF + 4 * n) * (*(const f32x4*)(s1 + bj * HALF + 4 * n) + 1.f); }
            if (xb) {
#pragma unroll
                for (int ch = 0; ch < 3; ++ch) {
                    constexpr int NCH = 3;
                    f32x4 xv[NCH][2][2];
#pragma unroll
                    for (int mm = 0; mm < NCH; ++mm) { const int q = ch * NCH + mm; if (q < 8) { const int ai = q >> 2, m = q & 3;
#pragma unroll
                            for (int bj = 0; bj < 2; ++bj)
#pragma unroll
                                for (int n = 0; n < 2; ++n) xv[mm][bj][n] = *(const f32x4*)(xi0 + (size_t)(ai * HALF + m * 16) * DM + bj * HALF + 4 * n); } }
                    asm volatile("" ::: "memory");
#pragma unroll
                    for (int mm = 0; mm < NCH; ++mm) { const int q = ch * NCH + mm; if (q < 8) { const int ai = q >> 2, m = q & 3; const size_t R = (size_t)(R0 + ai * HALF + m * 16); float sq = 0.f;
#pragma unroll
                            for (int bj = 0; bj < 2; ++bj) { const f32x4 o0 = xv[mm][bj][0] + gv[bj][0] * acc[ai][bj][m][0], o1 = xv[mm][bj][1] + gv[bj][1] * acc[ai][bj][m][1];
                                sq += ((o0[0] * o0[0] + o0[1] * o0[1]) + (o0[2] * o0[2] + o0[3] * o0[3])) + ((o1[0] * o1[0] + o1[1] * o1[1]) + (o1[2] * o1[2] + o1[3] * o1[3]));
                                const f32x4 h0 = o0 * cf[bj][0], h1 = o1 * cf[bj][1];
                                u32x4 w; w.x = cvt_pk_bf16(h0[0], h0[1]); w.y = cvt_pk_bf16(h0[2], h0[3]); w.z = cvt_pk_bf16(h1[0], h1[1]); w.w = cvt_pk_bf16(h1[2], h1[3]);
                                *(u32x4*)(xb + R * DM + u.pn * BM + cl0 + bj * HALF) = w; }
                            sq += lane_xor<16>(sq);
                            { auto pr = __builtin_amdgcn_permlane32_swap(__float_as_uint(sq), __float_as_uint(sq), false, false); sq = __uint_as_float(pr[0]) + __uint_as_float(pr[1]); }
                            if (fq == 0) ss[(size_t)(u.pn * 4 + wc) * MLAT + R] = sq; } }
                    asm volatile("" ::: "memory");
                }
            } else {
                f32x4 rcf[2][2];
#pragma unroll
                for (int bj = 0; bj < 2; ++bj)
#pragma unroll
                    for (int n = 0; n < 2; ++n)
#pragma unroll
                        for (int e = 0; e < 4; ++e) rcf[bj][n][e] = cf[bj][n][e] != 0.f ? __builtin_amdgcn_rcpf(cf[bj][n][e]) : 0.f;
                const bf16_t* xr0 = xbr + (size_t)R0 * DM + u.pn * BM + cl0;
#pragma unroll
            for (int ai = 0; ai < 2; ++ai) {
                u32x4 xw[4][2];
#pragma unroll
                for (int m = 0; m < 4; ++m)
#pragma unroll
                    for (int bj = 0; bj < 2; ++bj) xw[m][bj] = *(const u32x4*)(xr0 + (size_t)(ai * HALF + m * 16) * DM + bj * HALF);
                asm volatile("" ::: "memory");
#pragma unroll
                for (int m = 0; m < 4; ++m)
#pragma unroll
                    for (int bj = 0; bj < 2; ++bj) { float xf[8]; unpack8(xw[m][bj], xf);
                        const f32x4 x0 = {xf[0], xf[1], xf[2], xf[3]}, x1 = {xf[4], xf[5], xf[6], xf[7]};
                        *(f32x4*)(xo0 + (size_t)(ai * HALF + m * 16) * DM + bj * HALF) = x0 * rcf[bj][0] + gv[bj][0] * acc[ai][bj][m][0];
                        *(f32x4*)(xo0 + (size_t)(ai * HALF + m * 16) * DM + bj * HALF + 4) = x1 * rcf[bj][1] + gv[bj][1] * acc[ai][bj][m][1]; }
                asm volatile("" ::: "memory");
            }
            }
        }
    }
};

struct Epi4 {
    static constexpr bool PERM = true, AFTER_DRAIN = false;
    Epi e;
    __device__ __forceinline__ void prefetch(const Unit&, int, PG8_LAS unsigned char*) const {}
    __device__ __forceinline__ void operator()(f32x4 (&acc)[2][2][4][2], const Unit& u, int wr, int wc, int fr, int fq) const { e.k4(acc, u, wr, wc, fr, fq); }
};

template <class Epi, class Sched, bool ALIGN_EPI = false, bool SP2 = false>
__device__ __forceinline__ void gemm_phase(PG8_LAS unsigned char* lds, const Gemm g, const Sched& S, const Epi& E, int wave_) {
    int tid_ = wave_ * 64 + lane_id(); asm volatile("" : "+v"(tid_));
    const int tid = tid_, wid = __builtin_amdgcn_readfirstlane(tid >> 6), lane = tid & 63, wr = wid >> 2, wc = wid & 3, fr = lane & 15, fq = lane >> 4;
    const int K = g.K, nt = K / BK;
    unsigned voffA[2], voffB[2];
#pragma unroll
    for (int i = 0; i < 2; ++i) { int R, C; stage_rc(tid * 16 + i * 8192, R, C); const int Rb = Epi::PERM ? ((R & ~31) + perm32(R & 31)) : R;
        voffA[i] = (unsigned)(R * g.lda + C) * 2u; voffB[i] = (unsigned)(Rb * g.ldb + C) * 2u; }
    const size_t kstep = (size_t)(BK * 2);
    const size_t hA = (size_t)HALF * g.lda * 2, hB = (size_t)HALF * g.ldb * 2;
    const unsigned ldsw = (unsigned)wid * 1024u;
    const int aoff = lds_byte(wr * 64 + fr, fq * 8), boff = lds_byte(wc * 32 + fr, fq * 8);
#define PG8_TA(pm) ((const char*)g.A + ((size_t)((pm) % g.mper) * 2 * hA + (size_t)((pm) / g.mper) * (size_t)g.abatch * 2))
#define PG8_TB(pn) ((const char*)g.Bt + (size_t)(pn) * 2 * hB)
#define PG8_SA(b, h) (((b) * 2 + (h)) * HTB)
#define PG8_SB(b, h) ((4 + (b) * 2 + (h)) * HTB)
#define PG8_STAGE(bufoff, gbase, voff) do { _Pragma("unroll") for (int _i = 0; _i < 2; ++_i) \
        __builtin_amdgcn_global_load_lds((const unsigned*)((const char*)(gbase) + (voff)[_i]), (PG8_LAS unsigned*)(lds + (bufoff) + ldsw + _i * 8192), 16, 0, 0); } while (0)
#define PG8_LDA(dst, b, h) do { _Pragma("unroll") for (int m = 0; m < 4; ++m) _Pragma("unroll") for (int k = 0; k < 2; ++k) dst[m][k] = *(const PG8_LAS bf16x8*)(lds + PG8_SA(b, h) + aoff + m * 2048 + k * 1024); } while (0)
#define PG8_LDB(dst, b, h) do { _Pragma("unroll") for (int n = 0; n < 2; ++n) _Pragma("unroll") for (int k = 0; k < 2; ++k) dst[n][k] = *(const PG8_LAS bf16x8*)(lds + PG8_SB(b, h) + boff + n * 2048 + k * 1024); } while (0)
#define PG8_MMA(ai, bj, At, Bt) do { __builtin_amdgcn_s_setprio(1); _Pragma("unroll") for (int m = 0; m < 4; ++m) _Pragma("unroll") for (int n = 0; n < 2; ++n) _Pragma("unroll") for (int k = 0; k < 2; ++k) \
        acc[ai][bj][m][n] = __builtin_amdgcn_mfma_f32_16x16x32_bf16(Bt[n][k], At[m][k], acc[ai][bj][m][n], 0, 0, 0); __builtin_amdgcn_s_setprio(0); } while (0)
#define PG8_WAIT_V(n) asm volatile("s_waitcnt vmcnt(" #n ")" ::: "memory")
#define PG8_WAIT_L(n) asm volatile("s_waitcnt lgkmcnt(" #n ")" ::: "memory")
#define PG8_BAR __builtin_amdgcn_s_barrier()
#define PG8_SCHED __builtin_amdgcn_sched_barrier(0)
    Unit cur, nxt; int ui = 0;
    if (!S.next(0, cur)) return;
    f32x4 acc[2][2][4][2];
#pragma unroll
    for (int a = 0; a < 2; ++a)
#pragma unroll
        for (int b = 0; b < 2; ++b)
#pragma unroll
            for (int m = 0; m < 4; ++m)
#pragma unroll
                for (int n = 0; n < 2; ++n) acc[a][b][m][n] = (f32x4){0.f, 0.f, 0.f, 0.f};
    bf16x8 At[4][2], B0[2][2], B1[2][2];
    const char* cA = PG8_TA(cur.pm); const char* cB = PG8_TB(cur.pn);
    if constexpr (SP2) {
        PG8_STAGE(PG8_SB(0, 0), cB, voffB); PG8_STAGE(PG8_SB(0, 1), cB + hB, voffB); PG8_STAGE(PG8_SA(0, 0), cA, voffA); PG8_STAGE(PG8_SA(0, 1), cA + hA, voffA);
        if (wr == 1) PG8_BAR;
        PG8_WAIT_V(2); PG8_BAR;
        PG8_STAGE(PG8_SB(1, 0), cB + kstep, voffB); PG8_STAGE(PG8_SA(1, 0), cA + kstep, voffA); PG8_STAGE(PG8_SB(1, 1), cB + hB + kstep, voffB);
        PG8_WAIT_V(6); PG8_BAR;
    } else {
        PG8_STAGE(PG8_SB(0, 0), cB, voffB); PG8_STAGE(PG8_SA(0, 0), cA, voffA); PG8_STAGE(PG8_SB(0, 1), cB + hB, voffB); PG8_STAGE(PG8_SA(0, 1), cA + hA, voffA);
        if (wr == 1) PG8_BAR;
        PG8_WAIT_V(4); PG8_BAR;
        PG8_STAGE(PG8_SB(1, 0), cB + kstep, voffB); PG8_STAGE(PG8_SA(1, 0), cA + kstep, voffA); PG8_STAGE(PG8_SB(1, 1), cB + hB + kstep, voffB);
        PG8_WAIT_V(6); PG8_BAR;
    }
    for (;;) {
        const bool has_next = S.next(ui + 1, nxt);
        const char* nA = has_next ? PG8_TA(nxt.pm) : cA; const char* nB = has_next ? PG8_TB(nxt.pn) : cB;
        for (int t = 0; t < nt; t += 2) {
            const bool last = (t == nt - 2);
            const char* a1 = cA + (size_t)(t + 1) * kstep;
            const char* a2 = last ? nA : cA + (size_t)(t + 2) * kstep; const char* b2 = last ? nB : cB + (size_t)(t + 2) * kstep;
            const char* a3 = a2 + kstep; const char* b3 = b2 + kstep;
            if constexpr (SP2) {
            PG8_LDB(B0, 0, 0); PG8_LDB(B1, 0, 1); PG8_SCHED; PG8_LDA(At, 0, 0); PG8_STAGE(PG8_SA(1, 1), a1 + hA, voffA);
            PG8_WAIT_V(8); PG8_WAIT_L(0); PG8_BAR; PG8_MMA(0, 0, At, B0); PG8_MMA(0, 1, At, B1); PG8_BAR; PG8_SCHED;
            PG8_LDA(At, 0, 1); PG8_STAGE(PG8_SB(0, 0), b2, voffB); PG8_STAGE(PG8_SB(0, 1), b2 + hB, voffB); PG8_STAGE(PG8_SA(0, 0), a2, voffA);
            PG8_WAIT_V(8); PG8_WAIT_L(0); PG8_BAR; PG8_MMA(1, 0, At, B0); PG8_MMA(1, 1, At, B1); PG8_BAR; PG8_SCHED;
            PG8_LDB(B0, 1, 0); PG8_LDB(B1, 1, 1); PG8_SCHED; PG8_LDA(At, 1, 0); PG8_STAGE(PG8_SA(0, 1), a2 + hA, voffA);
            PG8_WAIT_V(8); PG8_WAIT_L(0); PG8_BAR; PG8_MMA(0, 0, At, B0); PG8_MMA(0, 1, At, B1); PG8_BAR; PG8_SCHED;
            PG8_LDA(At, 1, 1); PG8_STAGE(PG8_SB(1, 0), b3, voffB); PG8_STAGE(PG8_SB(1, 1), b3 + hB, voffB); PG8_STAGE(PG8_SA(1, 0), a3, voffA);
            PG8_WAIT_V(8); PG8_WAIT_L(0); PG8_BAR; PG8_MMA(1, 0, At, B0); PG8_MMA(1, 1, At, B1); PG8_BAR; PG8_SCHED;
            } else {
            PG8_LDB(B0, 0, 0); PG8_SCHED; PG8_LDA(At, 0, 0); PG8_STAGE(PG8_SA(1, 1), a1 + hA, voffA);
            PG8_WAIT_L(8); PG8_BAR; PG8_WAIT_L(0); PG8_MMA(0, 0, At, B0); PG8_BAR; PG8_SCHED;
            PG8_LDB(B1, 0, 1); PG8_STAGE(PG8_SB(0, 0), b2, voffB);
            PG8_BAR; PG8_WAIT_L(0); PG8_MMA(0, 1, At, B1); PG8_BAR;
            PG8_LDA(At, 0, 1); PG8_STAGE(PG8_SA(0, 0), a2, voffA);
            PG8_BAR; PG8_WAIT_L(0); PG8_MMA(1, 0, At, B0); PG8_BAR; PG8_SCHED;
            PG8_STAGE(PG8_SB(0, 1), b2 + hB, voffB);
            PG8_WAIT_V(6); PG8_BAR; PG8_MMA(1, 1, At, B1); PG8_BAR;
            PG8_LDB(B0, 1, 0); PG8_SCHED; PG8_LDA(At, 1, 0); PG8_STAGE(PG8_SA(0, 1), a2 + hA, voffA);
            PG8_WAIT_L(8); PG8_BAR; PG8_WAIT_L(0); PG8_MMA(0, 0, At, B0); PG8_BAR; PG8_SCHED;
            PG8_LDB(B1, 1, 1); PG8_STAGE(PG8_SB(1, 0), b3, voffB);
            PG8_BAR; PG8_WAIT_L(0); PG8_MMA(0, 1, At, B1); PG8_BAR;
            PG8_LDA(At, 1, 1); PG8_STAGE(PG8_SA(1, 0), a3, voffA);
            PG8_BAR; PG8_WAIT_L(0); PG8_MMA(1, 0, At, B0); PG8_BAR; PG8_SCHED;
            PG8_STAGE(PG8_SB(1, 1), b3 + hB, voffB);
            PG8_WAIT_V(6); PG8_BAR; PG8_MMA(1, 1, At, B1); PG8_BAR;
            }
        }
        if constexpr (ALIGN_EPI) { if (wr == 0) PG8_BAR; }
        { int te_ = wave_ * 64 + lane_id(); asm volatile("" : "+v"(te_));
          E(acc, cur, wr, wc, te_ & 15, (te_ & 63) >> 4); }
        if (!has_next) break;
#pragma unroll
        for (int a = 0; a < 2; ++a)
#pragma unroll
            for (int b = 0; b < 2; ++b)
#pragma unroll
                for (int m = 0; m < 4; ++m)
#pragma unroll
                    for (int n = 0; n < 2; ++n) acc[a][b][m][n] = (f32x4){0.f, 0.f, 0.f, 0.f};
        cur = nxt; cA = nA; cB = nB; ++ui;
        if constexpr (ALIGN_EPI) { if (wr == 1) PG8_BAR; }
    }
    PG8_WAIT_V(0);
    if constexpr (!ALIGN_EPI) { if (wr == 0) PG8_BAR; }
    PG8_BAR;
#undef PG8_TA
#undef PG8_TB
#undef PG8_SA
#undef PG8_SB
#undef PG8_STAGE
#undef PG8_LDA
#undef PG8_LDB
#undef PG8_MMA
#undef PG8_WAIT_V
#undef PG8_WAIT_L
#undef PG8_BAR
#undef PG8_SCHED
}
}

namespace att {
constexpr int NW = 8, QBLK = 32, KVBLK = 64;
constexpr float SCALE = 0.07216878364870322f;
#ifndef ATT_SDEPTH
#define ATT_SDEPTH 1
#endif
constexpr int SDEPTH = ATT_SDEPTH;
#ifndef ATT_QKT_GRP
#define ATT_QKT_GRP 4
#endif
constexpr int QKT_GRP = ATT_QKT_GRP;
constexpr int LDQ = NQ, LDKK = NQ, LDV = NKV;
constexpr int KPITCH = 400;
constexpr int SHM_V = KVBLK * 128 * 2, SHM_K = KVBLK * KPITCH;
constexpr int SHM_QR = 2 * SHM_V + 2 * SHM_K + NW * 64 * 4;
#ifndef ATT_NQR
#define ATT_NQR 6
#endif
constexpr int NQR = ATT_NQR, QLB = (12 - NQR) * 1024;
constexpr int SHM_ATTN = SHM_QR + NW * QLB;
#define KSWZ(row, colB) ((row) * KPITCH + (colB))
#define SBAR() __builtin_amdgcn_sched_barrier(0)
__device__ __forceinline__ int crow(int r, int hi) { return (r & 3) + 8 * (r >> 2) + 4 * hi; }
__device__ __forceinline__ unsigned cvtpk(float lo, float hi) { unsigned r; asm volatile("v_cvt_pk_bf16_f32 %0, %1, %2" : "=v"(r) : "v"(lo), "v"(hi)); return r; }

__device__ __forceinline__ void partialSM(f32x16& p0, f32x16& p1, float) {
#pragma unroll
    for (int r = 0; r < 16; ++r) p0[r] = __builtin_amdgcn_exp2f(p0[r]);
}
__device__ __forceinline__ void finishSM(f32x16& p0, f32x16& p1, float& l_reg, bf16x8& pa0, bf16x8& pa1, bf16x8& pa2, bf16x8& pa3) {
#pragma unroll
    for (int r = 0; r < 16; ++r) p1[r] = __builtin_amdgcn_exp2f(p1[r]);
    float s0 = p0[0] + p1[0], s1 = p0[1] + p1[1], s2 = p0[2] + p1[2], s3 = p0[3] + p1[3];
#pragma unroll
    for (int r = 4; r < 16; r += 4) { s0 += p0[r] + p1[r]; s1 += p0[r + 1] + p1[r + 1]; s2 += p0[r + 2] + p1[r + 2]; s3 += p0[r + 3] + p1[r + 3]; }
    l_reg += (s0 + s1) + (s2 + s3);
#define PK4(P, BASE, OUT) do { unsigned a0 = cvtpk(P[BASE + 0], P[BASE + 1]), a1 = cvtpk(P[BASE + 2], P[BASE + 3]);   \
    unsigned b0 = cvtpk(P[BASE + 4], P[BASE + 5]), b1 = cvtpk(P[BASE + 6], P[BASE + 7]);                              \
    auto r0 = __builtin_amdgcn_permlane32_swap(a0, b0, false, false); auto r1 = __builtin_amdgcn_permlane32_swap(a1, b1, false, false); \
    u32x4 w = {r0[0], r1[0], r0[1], r1[1]}; OUT = *reinterpret_cast<bf16x8*>(&w); } while (0)
    PK4(p0, 0, pa0); PK4(p0, 8, pa1); PK4(p1, 0, pa2); PK4(p1, 8, pa3);
#undef PK4
}
template <int OFF> __device__ __forceinline__ void lds_rd128(bf16x8& d, unsigned a) { asm volatile("ds_read_b128 %0, %1 offset:%2" : "=v"(d) : "v"(a), "i"(OFF) : "memory"); }
template <int N> __device__ __forceinline__ void lds_wait2(bf16x8& a, bf16x8& b) { asm volatile("s_waitcnt lgkmcnt(%2)" : "+v"(a), "+v"(b) : "i"(N) : "memory"); }
template <int N> __device__ __forceinline__ void lds_wait3(bf16x8& a, bf16x8& b, bf16x8& c) { asm volatile("s_waitcnt lgkmcnt(%3)" : "+v"(a), "+v"(b), "+v"(c) : "i"(N) : "memory"); }
constexpr int qkt_cnt(int d0) { return (d0 > 11) ? 0 : ((d0 >= NQR) ? 3 : 2); }
template <int KOFF, int D0> struct QktStep {
    static __device__ __forceinline__ void load(bf16x8& k0, bf16x8& k1, bf16x8& q, unsigned kad, unsigned qa) {
        lds_rd128<KOFF + D0 * 32>(k0, kad); lds_rd128<KOFF + 32 * KPITCH + D0 * 32>(k1, kad);
        if constexpr (D0 >= NQR) lds_rd128<(D0 - NQR) * 1024>(q, qa);
    }
};
struct DmaPlan { const char* kb; const char* vb; LAS unsigned char* kdst; LAS unsigned char* vdst; unsigned koff0, koff1, koff2, voff0, voff1; int wave; bool dok, dov; };
template <int I> __device__ __forceinline__ void dma_piece(const DmaPlan& d) {
    if constexpr (I < 3) { if (d.dok) __builtin_amdgcn_global_load_lds((const unsigned*)(d.kb + (I == 0 ? d.koff0 : I == 1 ? d.koff1 : d.koff2)), (LAS unsigned*)(d.kdst + (d.wave + 8 * I) * 1024), 16, 0, 0); }
    else if constexpr (I == 3) { if (d.dok && d.wave == 0) { const int p_ = 24 * 64 + lane_id(), r_ = p_ / 25, c_ = p_ - r_ * 25;
            __builtin_amdgcn_global_load_lds((const unsigned*)(d.kb + (unsigned)(r_ * LDKK * 2 + c_ * 16)), (LAS unsigned*)(d.kdst + 24 * 1024), 16, 0, 0); } }
    else { if (d.dov) __builtin_amdgcn_global_load_lds((const unsigned*)(d.vb + (I == 4 ? d.voff0 : d.voff1)), (LAS unsigned*)(d.vdst + (d.wave * 2 + (I - 4)) * 1024), 16, 0, 0); }
}
template <int KOFF, bool FIN, bool DMA> __device__ __forceinline__ void qkt(f32x16& p0, f32x16& p1, const bf16x8* qr, unsigned kad, unsigned qa_in, float negMC,
                                                              f32x16& x0, f32x16& x1, float& l_reg, bf16x8& pa0, bf16x8& pa1, bf16x8& pa2, bf16x8& pa3, const DmaPlan& dm) {
    p0 = f32x16{}; p1 = f32x16{};
    unsigned qa = qa_in; asm volatile("" : "+v"(qa));
    bf16x8 ka[2], kb[2], qf[2];
    float s0 = 0.f, s1 = 0.f, s2 = 0.f, s3 = 0.f;
#define QL(S, D) QktStep<KOFF, D>::load(ka[S], kb[S], qf[S], kad, qa)
#define QM(S, D) do { if constexpr (D >= NQR) lds_wait3<qkt_cnt(D + 1)>(ka[S], kb[S], qf[S]); else lds_wait2<qkt_cnt(D + 1)>(ka[S], kb[S]); \
        const bf16x8 qq = (D < NQR) ? qr[D < NQR ? D : 0] : qf[S]; \
        p0 = __builtin_amdgcn_mfma_f32_32x32x16_bf16(ka[S], qq, p0, 0, 0, 0); p1 = __builtin_amdgcn_mfma_f32_32x32x16_bf16(kb[S], qq, p1, 0, 0, 0); } while (0)
#define PK4(P, BASE, OUT) do { if constexpr (FIN) { unsigned a0 = cvtpk(P[BASE + 0], P[BASE + 1]), a1 = cvtpk(P[BASE + 2], P[BASE + 3]);   \
    unsigned b0 = cvtpk(P[BASE + 4], P[BASE + 5]), b1 = cvtpk(P[BASE + 6], P[BASE + 7]);                              \
    auto r0 = __builtin_amdgcn_permlane32_swap(a0, b0, false, false); auto r1 = __builtin_amdgcn_permlane32_swap(a1, b1, false, false); \
    u32x4 w = {r0[0], r1[0], r0[1], r1[1]}; OUT = *reinterpret_cast<bf16x8*>(&w); } } while (0)
#define EX4(B) do { if constexpr (FIN) { x1[B] = __builtin_amdgcn_exp2f(x1[B]); x1[B + 1] = __builtin_amdgcn_exp2f(x1[B + 1]); x1[B + 2] = __builtin_amdgcn_exp2f(x1[B + 2]); x1[B + 3] = __builtin_amdgcn_exp2f(x1[B + 3]); } } while (0)
#define SUM8(X, B) do { if constexpr (FIN) { s0 += X[B] + X[B + 4]; s1 += X[B + 1] + X[B + 5]; s2 += X[B + 2] + X[B + 6]; s3 += X[B + 3] + X[B + 7]; } } while (0)
    QL(0, 0); QL(1, 1);
    QM(0, 0); QL(0, 2);                            if constexpr (DMA) dma_piece<0>(dm);
    QM(1, 1); QL(1, 3);                            if constexpr (DMA) dma_piece<1>(dm);
    QM(0, 2); QL(0, 4);  EX4(0); SUM8(x0, 0);      if constexpr (DMA) dma_piece<2>(dm);
    QM(1, 3); QL(1, 5);  EX4(4); SUM8(x0, 8);      if constexpr (DMA) dma_piece<3>(dm);
    QM(0, 4); QL(0, 6);  EX4(8); SUM8(x1, 0);      if constexpr (DMA) dma_piece<4>(dm);
    QM(1, 5); QL(1, 7);  EX4(12);                  if constexpr (DMA) dma_piece<5>(dm);
    QM(0, 6); QL(0, 8);  SUM8(x1, 8); PK4(x0, 0, pa0);
    QM(1, 7); QL(1, 9);  PK4(x0, 8, pa1);
    QM(0, 8); QL(0, 10); PK4(x1, 0, pa2);
    QM(1, 9); QL(1, 11); PK4(x1, 8, pa3);
    QM(0, 10); if constexpr (FIN) l_reg += (s0 + s1) + (s2 + s3);
    QM(1, 11);
#undef QL
#undef QM
#undef PK4
#undef EX4
#undef SUM8
}
__device__ __forceinline__ int v_st(int k, int c) { const int kk = (k & ~0xC) | ((k & 4) << 1) | ((k & 8) >> 1); return ((kk >> 3) * 4 + (c >> 5)) * 512 + ((kk & 7) * 32 + (c & 31)) * 2; }
__device__ __forceinline__ int v_rd_base(int lane) { return ((lane & 3) << 3) | (((lane >> 2) & 3) << 6) | (((lane >> 4) & 1) << 5) | (((lane >> 5) & 1) << 8); }
constexpr int v_rd_off(int d0, int ks, int half) { return d0 * 512 + ks * 4096 + half * 2048; }
template <int OFF> __device__ __forceinline__ s16x4 tr_read(int vb) {
    s16x4 r; asm volatile("ds_read_b64_tr_b16 %0, %1 offset:%2" : "=&v"(r) : "v"(vb), "i"(OFF) : "memory"); return r;
}
template <int D0> __device__ __forceinline__ void pv_one(f32x16& od, int vb, bf16x8 pa0, bf16x8 pa1, bf16x8 pa2, bf16x8 pa3) {
    const s16x4 l0 = tr_read<v_rd_off(D0, 0, 0)>(vb), h0 = tr_read<v_rd_off(D0, 0, 1)>(vb), l1 = tr_read<v_rd_off(D0, 1, 0)>(vb), h1 = tr_read<v_rd_off(D0, 1, 1)>(vb);
    const s16x4 l2 = tr_read<v_rd_off(D0, 2, 0)>(vb), h2 = tr_read<v_rd_off(D0, 2, 1)>(vb), l3 = tr_read<v_rd_off(D0, 3, 0)>(vb), h3 = tr_read<v_rd_off(D0, 3, 1)>(vb);
    asm volatile("s_waitcnt lgkmcnt(0)" ::: "memory"); SBAR();
#define PK(L, H) (bf16x8){L[0], L[1], L[2], L[3], H[0], H[1], H[2], H[3]}
    od = __builtin_amdgcn_mfma_f32_32x32x16_bf16(pa0, PK(l0, h0), od, 0, 0, 0);
    od = __builtin_amdgcn_mfma_f32_32x32x16_bf16(pa1, PK(l1, h1), od, 0, 0, 0);
    od = __builtin_amdgcn_mfma_f32_32x32x16_bf16(pa2, PK(l2, h2), od, 0, 0, 0);
    od = __builtin_amdgcn_mfma_f32_32x32x16_bf16(pa3, PK(l3, h3), od, 0, 0, 0);
#undef PK
}
__device__ __forceinline__ void pv_d0(f32x16* o, int vb, bf16x8 pa0, bf16x8 pa1, bf16x8 pa2, bf16x8 pa3) {
    pv_one<0>(o[0], vb, pa0, pa1, pa2, pa3); pv_one<1>(o[1], vb, pa0, pa1, pa2, pa3); pv_one<2>(o[2], vb, pa0, pa1, pa2, pa3); pv_one<3>(o[3], vb, pa0, pa1, pa2, pa3);
}
struct VFrag { s16x4 l0, h0, l1, h1, l2, h2, l3, h3; };
template <int D0> __device__ __forceinline__ void v_reads(VFrag& f, int vb) {
    f.l0 = tr_read<v_rd_off(D0, 0, 0)>(vb); f.h0 = tr_read<v_rd_off(D0, 0, 1)>(vb); f.l1 = tr_read<v_rd_off(D0, 1, 0)>(vb); f.h1 = tr_read<v_rd_off(D0, 1, 1)>(vb);
    f.l2 = tr_read<v_rd_off(D0, 2, 0)>(vb); f.h2 = tr_read<v_rd_off(D0, 2, 1)>(vb); f.l3 = tr_read<v_rd_off(D0, 3, 0)>(vb); f.h3 = tr_read<v_rd_off(D0, 3, 1)>(vb);
}
template <int N> __device__ __forceinline__ void v_wait(VFrag& f) {
    asm volatile("s_waitcnt lgkmcnt(%8)" : "+v"(f.l0), "+v"(f.h0), "+v"(f.l1), "+v"(f.h1), "+v"(f.l2), "+v"(f.h2), "+v"(f.l3), "+v"(f.h3) : "i"(N) : "memory");
}
__device__ __forceinline__ void v_mfmas(f32x16& od, const VFrag& f, bf16x8 pa0, bf16x8 pa1, bf16x8 pa2, bf16x8 pa3) {
#define PK(L, H) (bf16x8){L[0], L[1], L[2], L[3], H[0], H[1], H[2], H[3]}
    od = __builtin_amdgcn_mfma_f32_32x32x16_bf16(pa0, PK(f.l0, f.h0), od, 0, 0, 0);
    od = __builtin_amdgcn_mfma_f32_32x32x16_bf16(pa1, PK(f.l1, f.h1), od, 0, 0, 0);
    od = __builtin_amdgcn_mfma_f32_32x32x16_bf16(pa2, PK(f.l2, f.h2), od, 0, 0, 0);
    od = __builtin_amdgcn_mfma_f32_32x32x16_bf16(pa3, PK(f.l3, f.h3), od, 0, 0, 0);
#undef PK
}
template <bool EXP> __device__ __forceinline__ void pv_exp(f32x16* o, int vb, bf16x8 pa0, bf16x8 pa1, bf16x8 pa2, bf16x8 pa3, f32x16& x0) {
#define EX4(B) do { if constexpr (EXP) { x0[B] = __builtin_amdgcn_exp2f(x0[B]); x0[B + 1] = __builtin_amdgcn_exp2f(x0[B + 1]); x0[B + 2] = __builtin_amdgcn_exp2f(x0[B + 2]); x0[B + 3] = __builtin_amdgcn_exp2f(x0[B + 3]); } } while (0)
    VFrag fa, fb;
    v_reads<0>(fa, vb); v_reads<1>(fb, vb);
    v_wait<8>(fa); v_mfmas(o[0], fa, pa0, pa1, pa2, pa3); EX4(0);
    v_reads<2>(fa, vb);
    v_wait<8>(fb); v_mfmas(o[1], fb, pa0, pa1, pa2, pa3); EX4(4);
    v_reads<3>(fb, vb);
    v_wait<8>(fa); v_mfmas(o[2], fa, pa0, pa1, pa2, pa3); EX4(8);
    v_wait<0>(fb); v_mfmas(o[3], fb, pa0, pa1, pa2, pa3); EX4(12);
#undef EX4
}

__device__ __forceinline__ void attn_unit(const bf16_t* __restrict__ Qg, const bf16_t* __restrict__ KHg, const bf16_t* __restrict__ KVg, const bf16_t* __restrict__ Pg, bf16_t* __restrict__ mix,
                                          const float* __restrict__ qhw, const float* __restrict__ ropet,
                                          int h, int qrow0, int kc0, int kl0, int nct, int NT, float negMC, char* lds, int wave_) {
    int tid_ = wave_ * 64 + lane_id(); asm volatile("" : "+v"(tid_));
    const int tid = tid_, wid = tid >> 6, lane = tid & 63, r32 = lane & 31, hi = lane >> 5;
    char* V_lds = lds; char* K_lds = lds + 2 * SHM_V;
    bf16x8 qr[NQR];
    const bf16_t* Qw = Qg + (size_t)(qrow0 + wid * QBLK + r32) * LDQ + h * DQK + hi * 8;
    const unsigned qa = (unsigned)(uintptr_t)(lds + SHM_QR) + wid * QLB + lane * 16;
    {
        u32x4 qx[12]; f32x4 wr[4][2], rt[2][4];
        const bool latq = qrow0 < 16384; const int trow = (qrow0 + wid * QBLK + r32) & 4095;
#pragma unroll
        for (int d0 = 0; d0 < 12; ++d0) qx[d0] = *reinterpret_cast<const u32x4*>(Qw + d0 * 16);
#pragma unroll
        for (int i = 0; i < 4; ++i) { wr[i][0] = *(const f32x4*)(qhw + 128 + 16 * i + 8 * hi); wr[i][1] = *(const f32x4*)(qhw + 128 + 16 * i + 8 * hi + 4); }
#pragma unroll
        for (int pp = 0; pp < 2; ++pp) { const int pos = latq ? (pp == 0 ? (trow >> 6) : (trow & 63)) : 0;
            const f32x4* rp = (const f32x4*)(ropet + (size_t)(pos * 16 + 8 * hi) * 2);
#pragma unroll
            for (int q4 = 0; q4 < 4; ++q4) rt[pp][q4] = rp[q4]; }
        float ssq = 0.f;
#pragma unroll
        for (int d0 = 0; d0 < 12; ++d0) { float f[8]; unpack8(qx[d0], f);
#pragma unroll
            for (int e = 0; e < 8; ++e) ssq += f[e] * f[e]; }
        { auto pr = __builtin_amdgcn_permlane32_swap(__float_as_uint(ssq), __float_as_uint(ssq), false, false); ssq = __uint_as_float(pr[0]) + __uint_as_float(pr[1]); }
        const float rhq = (SCALE * 1.4426950408889634f) / sqrtf(ssq * (1.f / 192.f) + 1e-6f);
#pragma unroll
        for (int d0 = 0; d0 < 8; ++d0) { float f[8]; unpack8(qx[d0], f);
#pragma unroll
            for (int e = 0; e < 8; ++e) f[e] *= rhq;
            qx[d0] = pack8(f); }
#pragma unroll
        for (int pp = 0; pp < 2; ++pp) { float fa[8], fb[8]; unpack8(qx[8 + 2 * pp], fa); unpack8(qx[9 + 2 * pp], fb);
#pragma unroll
            for (int e = 0; e < 4; ++e) { fa[e] = fa[e] * rhq * wr[2 * pp][0][e]; fa[4 + e] = fa[4 + e] * rhq * wr[2 * pp][1][e]; fb[e] = fb[e] * rhq * wr[2 * pp + 1][0][e]; fb[4 + e] = fb[4 + e] * rhq * wr[2 * pp + 1][1][e]; }
            if (latq) {
#pragma unroll
                for (int q4 = 0; q4 < 4; ++q4) { const f32x4 v = rt[pp][q4];
#pragma unroll
                    for (int t2 = 0; t2 < 2; ++t2) { const int e = 2 * q4 + t2; const float cs = v[2 * t2], sn = v[2 * t2 + 1]; const float ya = fa[e], yb = fb[e];
                        fa[e] = ya * cs - yb * sn; fb[e] = yb * cs + ya * sn; } } }
            qx[8 + 2 * pp] = pack8(fa); qx[9 + 2 * pp] = pack8(fb); }
#pragma unroll
        for (int d0 = 0; d0 < NQR; ++d0) qr[d0] = __builtin_bit_cast(bf16x8, qx[d0]);
#pragma unroll
        for (int d0 = NQR; d0 < 12; ++d0) *(LAS u32x4*)(uintptr_t)(qa + (d0 - NQR) * 1024) = qx[d0];
    }
    float l_reg = 0; f32x16 o[4] = {};
    const int vb0 = (int)(uintptr_t)V_lds + v_rd_base(lane);
    const unsigned kad = (unsigned)(uintptr_t)K_lds + (unsigned)(r32 * KPITCH + hi * 16);
    const bf16_t* Kbase = KHg + h * DQK; const bf16_t* Vbase = KVg + h * 256 + 128;
    unsigned koff[3], voff[2];
#pragma unroll
    for (int i = 0; i < 3; ++i) { const int p = (wid + 8 * i) * 64 + lane, r = p / 25, c = p - r * 25; koff[i] = (unsigned)(r * LDKK * 2 + c * 16); }
#pragma unroll
    for (int i = 0; i < 2; ++i) { const int o = (wid * 2 + i) * 1024 + lane * 16, sub = o >> 9, kk = (sub >> 2) * 8 + ((o & 511) >> 6), k = (kk & ~0xC) | ((kk & 4) << 1) | ((kk & 8) >> 1), c = (sub & 3) * 32 + ((o & 63) >> 1);
        voff[i] = (unsigned)(k * LDV * 2 + c * 2); }
    LAS unsigned char* K3 = (LAS unsigned char*)(uintptr_t)(unsigned)(uintptr_t)K_lds; LAS unsigned char* V3 = (LAS unsigned char*)(uintptr_t)(unsigned)(uintptr_t)V_lds;
#define TROW(j) ((j) < nct ? kc0 + (j) * KVBLK : kl0 + ((j) - nct) * KVBLK)
#define DMA_K(j, slot) do { const char* kb_ = (const char*)Kbase + (size_t)TROW(j) * (LDKK * 2); _Pragma("unroll") for (int i_ = 0; i_ < 3; ++i_) \
    __builtin_amdgcn_global_load_lds((const unsigned*)(kb_ + koff[i_]), (LAS unsigned*)(K3 + (slot) * SHM_K + (wave_ + 8 * i_) * 1024), 16, 0, 0); \
    if (wave_ == 0) { int l4_ = lane_id(); const int p_ = 24 * 64 + l4_, r_ = p_ / 25, c_ = p_ - r_ * 25; \
        __builtin_amdgcn_global_load_lds((const unsigned*)(kb_ + (unsigned)(r_ * LDKK * 2 + c_ * 16)), (LAS unsigned*)(K3 + (slot) * SHM_K + 24 * 1024), 16, 0, 0); } } while (0)
#define DMA_V(j, slot) do { const char* vb_ = (const char*)Vbase + (size_t)TROW(j) * (LDV * 2); _Pragma("unroll") for (int i_ = 0; i_ < 2; ++i_) \
    __builtin_amdgcn_global_load_lds((const unsigned*)(vb_ + voff[i_]), (LAS unsigned*)(V3 + (slot) * SHM_V + (wave_ * 2 + i_) * 1024), 16, 0, 0); } while (0)
#define WAITBAR() do { asm volatile("s_waitcnt vmcnt(0)" ::: "memory"); __syncthreads(); } while (0)
    f32x16 pA0, pA1, pB0, pB1; bf16x8 pa0, pa1, pa2, pa3;
    DMA_K(0, 0); DMA_V(0, 0); DMA_K(1, 1);
    WAITBAR();
    const DmaPlan none0{nullptr, nullptr, K3, V3, 0u, 0u, 0u, 0u, 0u, wave_, false, false};
#define PLAN(tk, sk_, tv, sv_) DmaPlan{(const char*)Kbase + (size_t)TROW((tk) < NT ? (tk) : 0) * (LDKK * 2), (const char*)Vbase + (size_t)TROW((tv) < NT ? (tv) : 0) * (LDV * 2), \
        K3 + (sk_) * SHM_K, V3 + (sv_) * SHM_V, koff[0], koff[1], koff[2], voff[0], voff[1], wave_, (tk) < NT, (tv) < NT}
    if (wave_ < 4) {
#define STEPA(jj, ks, vs, PN0, PN1, PP0, PP1) do { const DmaPlan dp = PLAN((jj) + 1, 1 - (ks), (jj), 1 - (vs)); \
        qkt<0, true, true>(PN0, PN1, qr, kad + (ks) * SHM_K, qa, negMC, PP0, PP1, l_reg, pa0, pa1, pa2, pa3, dp); \
        pv_exp<true>(o, vb0 + (vs) * SHM_V, pa0, pa1, pa2, pa3, PN0); WAITBAR(); } while (0)
        qkt<0, false, false>(pA0, pA1, qr, kad, qa, negMC, pA0, pA1, l_reg, pa0, pa1, pa2, pa3, none0); partialSM(pA0, pA1, negMC);
        WAITBAR();
        for (int j = 1; j + 1 < NT; j += 2) { STEPA(j, 1, 0, pB0, pB1, pA0, pA1); STEPA(j + 1, 0, 1, pA0, pA1, pB0, pB1); }
        STEPA(NT - 1, 1, 0, pB0, pB1, pA0, pA1);
        finishSM(pB0, pB1, l_reg, pa0, pa1, pa2, pa3); SBAR();
        pv_d0(o, vb0 + SHM_V, pa0, pa1, pa2, pa3);
#undef STEPA
    } else {
#define STEPB(jj, ks, vs) do { const DmaPlan dp = PLAN((jj) + 1, 1 - (ks), (jj), 1 - (vs)); \
        pv_exp<false>(o, vb0 + (vs) * SHM_V, pa0, pa1, pa2, pa3, pA0); \
        qkt<0, false, true>(pA0, pA1, qr, kad + (ks) * SHM_K, qa, negMC, pA0, pA1, l_reg, pa0, pa1, pa2, pa3, dp); \
        partialSM(pA0, pA1, negMC); finishSM(pA0, pA1, l_reg, pa0, pa1, pa2, pa3); WAITBAR(); } while (0)
        qkt<0, false, false>(pA0, pA1, qr, kad, qa, negMC, pA0, pA1, l_reg, pa0, pa1, pa2, pa3, none0); partialSM(pA0, pA1, negMC);
        finishSM(pA0, pA1, l_reg, pa0, pa1, pa2, pa3);
        WAITBAR();
        for (int j = 1; j + 1 < NT; j += 2) { STEPB(j, 1, 0); STEPB(j + 1, 0, 1); }
        STEPB(NT - 1, 1, 0);
        pv_d0(o, vb0 + SHM_V, pa0, pa1, pa2, pa3);
#undef STEPB
    }
    {
        int te_ = wave_ * 64 + lane_id(); asm volatile("" : "+v"(te_));
        const int ewid = te_ >> 6, elane = te_ & 63, er32 = elane & 31, ehi = elane >> 5;
        float* eli = (float*)(lds + 2 * SHM_V + 2 * SHM_K) + ewid * 64;
        { auto rr = __builtin_amdgcn_permlane32_swap(__float_as_uint(l_reg), __float_as_uint(l_reg), false, false); l_reg = __uint_as_float(rr[0]) + __uint_as_float(rr[1]); }
        if (ehi == 0) eli[er32] = l_reg; asm volatile("s_waitcnt lgkmcnt(0)" ::: "memory");
        const size_t Rw = (size_t)(qrow0 + ewid * QBLK);
        unsigned short gtb[16][4];
#pragma unroll
        for (int r = 0; r < 16; ++r)
#pragma unroll
            for (int d0 = 0; d0 < 4; ++d0) gtb[r][d0] = Pg[(Rw + crow(r, ehi)) * NIN + OFF_MGATE + h * 128 + d0 * 32 + er32];
        asm volatile("" ::: "memory");
#pragma unroll
        for (int r = 0; r < 16; ++r) { const size_t R = Rw + crow(r, ehi); const float rl = __builtin_amdgcn_rcpf(eli[crow(r, ehi)]);
#pragma unroll
            for (int d0 = 0; d0 < 4; ++d0) { const int d = h * 128 + d0 * 32 + er32;
                mix[R * DM + 1024 + d] = (bf16_t)f2bf(o[d0][r] * rl * siluf(bf2f(gtb[r][d0]))); } }
    }
    __syncthreads();
#undef TROW
#undef DMA_K
#undef DMA_V
#undef WAITBAR
#undef PLAN
}
#undef SBAR
}

constexpr int CW_BAR = 4096, CW_FOLD = 8192;
constexpr int KFOLD = 2176;
#define XB_TMO      128
#define XB_XCNT(j)  (256  + 64 * (j))
#define XB_XSUB(j)  (1280 + 64 * (j))
#define XB_XGEN(j)  (2304 + 64 * (j))
#define XB_TOP      3328
#define XB_TOPGEN   3392
#define XCD_BAR_WORDS 3456
#define XB_SPIN_CAP (1u << 18)
__device__ __forceinline__ unsigned xb_ld(unsigned* p)              { return __hip_atomic_load(p, __ATOMIC_RELAXED, __HIP_MEMORY_SCOPE_AGENT); }
__device__ __forceinline__ unsigned xb_add(unsigned* p, unsigned v) { return __hip_atomic_fetch_add(p, v, __ATOMIC_RELAXED, __HIP_MEMORY_SCOPE_AGENT); }
__device__ __forceinline__ unsigned xb_xcc_id() { return (unsigned)__builtin_amdgcn_s_getreg((3 << 11) | 20) & 0xFu; }
#define XB_SPIN(cond, bar) do { unsigned _sp = 0; while (cond) { __builtin_amdgcn_s_sleep(1); \
    if ((++_sp & 255u) == 0u) { if (xb_ld(&(bar)[XB_TMO])) break; if (_sp > XB_SPIN_CAP) { atomicAdd(&(bar)[XB_TMO], 1u); break; } } } } while (0)
struct XcdBarrier { unsigned* bar; unsigned x; volatile LAS unsigned* st; };
__device__ __forceinline__ XcdBarrier xcd_barrier_post(unsigned* bar, volatile LAS unsigned* st, int tid) {
    XcdBarrier b; b.bar = bar; b.x = xb_xcc_id(); b.st = st;
    if (tid == 0) (void)xb_add(&bar[XB_XCNT(b.x)], 1u);
    return b;
}
__device__ __forceinline__ void xcd_barrier_complete(unsigned* bar, unsigned x, unsigned& nloc, unsigned& nx) {
    const unsigned G = gridDim.x * gridDim.y * gridDim.z;
    unsigned sum, cnt, mine, sp = 0u;
    for (;;) {
        sum = 0u; cnt = 0u; mine = 0u;
#pragma unroll
        for (unsigned j = 0; j < 16; ++j) { const unsigned c = xb_ld(&bar[XB_XCNT(j)]); sum += c; cnt += (c > 0u) ? 1u : 0u; mine = (j == x) ? c : mine; }
        if (sum == G) break;
        __builtin_amdgcn_s_sleep(1);
        if ((++sp & 255u) == 0u) { if (xb_ld(&bar[XB_TMO])) break; if (sp > XB_SPIN_CAP) { atomicAdd(&bar[XB_TMO], 1u); break; } }
    }
    nloc = mine > 0u ? mine : 1u; nx = cnt > 0u ? cnt : 1u;
}
__device__ __forceinline__ void xcd_barrier(const XcdBarrier& b, int tid) {
    asm volatile("s_waitcnt vmcnt(0)" ::: "memory");
    __syncthreads();
    if (tid == 0) {
        unsigned* bar = b.bar;
        __builtin_amdgcn_s_waitcnt(0);
        unsigned nloc = b.st[0], nx = b.st[1];
        if (nloc == 0u) { xcd_barrier_complete(bar, b.x, nloc, nx); b.st[0] = nloc; b.st[1] = nx; }
        const unsigned old = xb_add(&bar[XB_XSUB(b.x)], 1u);
        const unsigned gen = old / nloc;
        if (old + 1u == (gen + 1u) * nloc) {
            __builtin_amdgcn_fence(__ATOMIC_RELEASE, "agent");
            asm volatile("s_waitcnt vmcnt(0)" ::: "memory");
            const unsigned og = xb_add(&bar[XB_TOP], 1u);
            const unsigned tg = og / nx;
            if (og + 1u == (tg + 1u) * nx) xb_add(&bar[XB_TOPGEN], 1u);
            else XB_SPIN(xb_ld(&bar[XB_TOPGEN]) == tg, bar);
            __builtin_amdgcn_fence(__ATOMIC_ACQUIRE, "agent");
            xb_add(&bar[XB_XGEN(b.x)], 1u);
            asm volatile("s_waitcnt vmcnt(0)" ::: "memory");
        } else {
            XB_SPIN(xb_ld(&bar[XB_XGEN(b.x)]) == gen, bar);
            __builtin_amdgcn_fence(__ATOMIC_ACQUIRE, "agent");
            asm volatile("s_waitcnt vmcnt(0)" ::: "memory");
        }
    }
    __syncthreads();
}

constexpr int NWAVES = 8, NCU = 256;
constexpr int RING_BYTES = 150528, LDSCTL_OFF = RING_BYTES, MISC_OFF = LDSCTL_OFF + 320, LDS_BYTES = 151552;
static_assert(att::SHM_ATTN <= RING_BYTES && pg8::STAGE_BYTES <= RING_BYTES, "phase scratch fits the ring");

struct Args { const void* in[18]; float* out; unsigned char* ws; int ph_lo, ph_hi; };

struct Frame {
    unsigned char* lds;
    LAS unsigned char* lds3;
    int wave, vcu, G, bx;
};
__device__ __forceinline__ const void* ldptr(LAS unsigned char*, int i) {
    typedef __attribute__((address_space(4))) const unsigned long long* kaptr_t;
    kaptr_t ka = (kaptr_t)__builtin_amdgcn_kernarg_segment_ptr();
    asm volatile("" : "+s"(ka));
    return (const void*)ka[i];
}
#define FRESH_TID(name) int name = F.wave * 64 + lane_id(); asm volatile("" : "+v"(name))
#define F_IN(i) ((const float*)ldptr(F.lds3, (i)))
#define F_OUT ((float*)ldptr(F.lds3, 18))
#define F_WS ((unsigned char*)ldptr(F.lds3, 19))
#define WSP(T, off) ((T*)(ws + (off)))

__device__ __forceinline__ void transpose_item(const float* W, int K, int N, bf16_t* WT, int row_off, float* scr, int item, int lane, const float* kscale = nullptr) {
    const int nblk = N / 32, kb = item / nblk, nb = item % nblk, k0 = 64 * kb, n0 = 32 * nb;
    float wv[32];
#pragma unroll
    for (int i = 0; i < 32; ++i) { const int kk = 2 * i + (lane >> 5); wv[i] = W[(size_t)(k0 + kk) * N + n0 + (lane & 31)]; }
    if (kscale) {
#pragma unroll
        for (int i = 0; i < 32; ++i) wv[i] *= kscale[k0 + 2 * i + (lane >> 5)]; }
#pragma unroll
    for (int i = 0; i < 32; ++i) { const int kk = 2 * i + (lane >> 5); scr[kk * 33 + (lane & 31)] = wv[i]; }
    asm volatile("s_waitcnt lgkmcnt(0)" ::: "memory");
    const int c = lane & 7;
#pragma unroll
    for (int j = 0; j < 4; ++j) { const int n = (lane >> 3) + 8 * j; const float* s = scr + (8 * c) * 33 + n;
        u32x4 o; o.x = pk2(s[0 * 33], s[1 * 33]); o.y = pk2(s[2 * 33], s[3 * 33]); o.z = pk2(s[4 * 33], s[5 * 33]); o.w = pk2(s[6 * 33], s[7 * 33]);
        *(u32x4*)(WT + (size_t)(row_off + n0 + n) * K + k0 + 8 * c) = o; }
    asm volatile("s_waitcnt lgkmcnt(0)" ::: "memory");
}

__device__ __forceinline__ void phase_prep(Frame& F, int part, int wg, int nwg) {
    float* ldsf = (float*)F.lds;
    FRESH_TID(tid_); const int tid = tid_, lane = tid & 63, wave = F.wave;
    unsigned char* ws = F_WS;
    const float* in_win = F_IN(7);
    if (part == 0) {
        const float* in_c = F_IN(1); const float* in_cctx = F_IN(3); const float* in_wada = F_IN(5); const float* in_bada = F_IN(6);
        float* s_c = ldsf;
        float* red = ldsf + 5 * 2048;
        for (int idx = tid; idx < 5 * 2048; idx += 512) { const int r = idx >> 11, k = idx & 2047; const float v = (r < 4) ? in_c[r * 2048 + k] : in_cctx[k]; s_c[idx] = siluf(v); }
        __syncthreads();
        float* mods = WSP(float, WS_MODS);
        for (int rp = 0; rp < ((REP_P & 1) ? 2 : 1); ++rp)
        for (int item = wg; item < 192; item += nwg) {
            const int l = item / 96, nb = item % 96, col = nb * 64 + lane;
            const float* w = in_wada + (size_t)l * 2048 * 6144 + col;
            float a0 = 0.f, a1 = 0.f, a2 = 0.f, a3 = 0.f, a4 = 0.f;
            const int kb = wave * 256;
            for (int k0 = 0; k0 < 256; k0 += 32) { float wv[32];
#pragma unroll
                for (int k = 0; k < 32; ++k) wv[k] = w[(size_t)(kb + k0 + k) * 6144];
#pragma unroll
                for (int k = 0; k < 32; ++k) { const int kk = kb + k0 + k;
                    a0 += s_c[kk] * wv[k]; a1 += s_c[2048 + kk] * wv[k]; a2 += s_c[4096 + kk] * wv[k]; a3 += s_c[6144 + kk] * wv[k]; a4 += s_c[8192 + kk] * wv[k]; } }
            red[(wave * 5 + 0) * 64 + lane] = a0; red[(wave * 5 + 1) * 64 + lane] = a1; red[(wave * 5 + 2) * 64 + lane] = a2; red[(wave * 5 + 3) * 64 + lane] = a3; red[(wave * 5 + 4) * 64 + lane] = a4;
            __syncthreads();
            if (tid < 320) { const int r = tid >> 6, ln = tid & 63; float s = 0.f;
#pragma unroll
                for (int w8 = 0; w8 < 8; ++w8) s += red[(w8 * 5 + r) * 64 + ln];
                mods[((size_t)l * 5 + r) * 6144 + nb * 64 + ln] = s + in_bada[(size_t)l * 6144 + nb * 64 + ln]; }
            __syncthreads();
        }
    }
    if (part == 0) {
        const float* in_poolw = F_IN(8); const float* in_pools = F_IN(9);
        float* Ml = ldsf;
        float* Wt = ldsf + 128 * 128;
        for (int rp = 0; rp < ((REP_P & 2) ? 2 : 1); ++rp)
        for (int item = wg; item < 512; item += nwg) {
            const int l = item >> 8, kind = (item >> 7) & 1, g = (item >> 5) & 3, kb = item & 31;
            __syncthreads();
            for (int idx = tid; idx < 128 * 128; idx += 512) { const int j = idx >> 7, n = idx & 127; float v;
                if (kind == 0) v = in_poolw[(((size_t)l * 4 + g) * 128 + j) * 128 + n] * in_pools[(size_t)l * 512 + g * 128 + n];
                else { const float sc = 0.08838834764831845f;
                    if (n <= 64) v = __builtin_amdgcn_cosf((float)((j * n) & 127) * (1.f / 128.f)) * sc;
                    else v = __builtin_amdgcn_sinf((float)((j * (n - 64)) & 127) * (1.f / 128.f)) * sc; }
                Ml[idx] = v; }
            const int colbase = (kind == 0 ? OFF_POOL : OFF_FNET) + g * 128;
            { float wv[16];
#pragma unroll
              for (int q = 0; q < 16; ++q) { const int idx = tid + q * 512, kk = idx >> 7, jj = idx & 127; wv[q] = in_win[((size_t)l * DM + kb * 64 + kk) * DIN + colbase + jj]; }
#pragma unroll
              for (int q = 0; q < 16; ++q) { const int idx = tid + q * 512, kk = idx >> 7, jj = idx & 127; Wt[jj * 68 + kk] = wv[q]; } }
            __syncthreads();
            const int n4 = (tid & 31) * 4, k4 = (tid >> 5) * 4;
            f32x4 acc4[4];
#pragma unroll
            for (int i = 0; i < 4; ++i) acc4[i] = (f32x4){0.f, 0.f, 0.f, 0.f};
#pragma unroll 8
            for (int j = 0; j < 128; ++j) { const f32x4 mv = *(const f32x4*)(Ml + j * 128 + n4), wq = *(const f32x4*)(Wt + j * 68 + k4);
#pragma unroll
                for (int i = 0; i < 4; ++i) acc4[i] += mv * wq[i]; }
            bf16_t* dst = WSP(bf16_t, WS_WIN) + ((size_t)l * NIN + colbase + n4) * DM + kb * 64 + k4;
#pragma unroll
            for (int e = 0; e < 4; ++e) { u32x2 w; w.x = pk2(acc4[0][e], acc4[1][e]); w.y = pk2(acc4[2][e], acc4[3][e]); *(u32x2*)(dst + (size_t)e * DM) = w; }
        }
        __syncthreads();
    }
    {
        const float* in_wuq = F_IN(12); const float* in_wukv = F_IN(14); const float* in_wout = F_IN(17); const float* in_qnw = F_IN(11); const float* in_kvnw = F_IN(13);
        float* scr = ldsf + wave * (64 * 33 + 16);
        const int gw = wg * NWAVES + wave, NGW = nwg * NWAVES;
        constexpr int I_IN = 32 * 130, I_UQ = 8 * 48, I_UKV = 8 * 64, I_OUT = 32 * 64, I_REST = I_UQ + I_UKV + I_OUT;
        const int ntot = (part == 0) ? 2 * I_IN : I_REST;
        for (int rp = 0; rp < ((REP_P & 4) ? 2 : 1); ++rp)
        for (int it = gw; it < ntot; it += NGW) {
            int r = it;
            if (part == 0) { const int l = r / I_IN; r -= l * I_IN; const int nb = r % 130; if (nb < 16 || (nb >= 32 && nb < 48)) continue;
                transpose_item(in_win + (size_t)l * DM * DIN, DM, DIN, WSP(bf16_t, WS_WIN) + (size_t)l * NIN * DM, 0, scr, r, lane); continue; }
            const int l = part - 1;
            if (r < I_UQ) { transpose_item(in_wuq + (size_t)l * 512 * NQ, 512, NQ, WSP(bf16_t, WS_WUQ) + (size_t)l * NQ * 512, 0, scr, r, lane, in_qnw + (size_t)l * 512); continue; } r -= I_UQ;
            if (r < I_UKV) { transpose_item(in_wukv + (size_t)l * 512 * NKV, 512, NKV, WSP(bf16_t, WS_WUKV) + (size_t)l * NKV * 512, 0, scr, r, lane, in_kvnw + (size_t)l * 512); continue; } r -= I_UKV;
            transpose_item(in_wout + (size_t)l * DM * DM, DM, DM, WSP(bf16_t, WS_WOUT) + (size_t)l * DM * DM, 0, scr, r, lane);
        }
    }
    {
        const int gt = wg * 512 + tid, NGT = nwg * 512;
        if (part == 1) {
            const float* in_fnetw = F_IN(10);
            for (int idx = gt; idx < NL * 512 * 512; idx += NGT) { const int l = idx >> 18, n = (idx >> 9) & 511, kidx = idx & 511;
                const int g = n >> 7, d = n & 127; const int g2 = (kidx & 255) >> 6, s = kidx & 63; float v = 0.f;
                if (g2 == g) { const float* fw = in_fnetw + (((size_t)l * 4 + g) * 128) * 128 + d;
                    if (kidx < 256) v = (s == 0) ? fw[0] : fw[(size_t)s * 128] + fw[(size_t)(128 - s) * 128];
                    else v = (s == 0) ? 0.f : fw[(size_t)s * 128] - fw[(size_t)(128 - s) * 128]; }
                WSP(bf16_t, WS_FWAB)[idx] = (bf16_t)f2bf(v); }
        }
        if (part == 0) {
            const float* in_qhw = F_IN(15); const float* in_khw = F_IN(16);
            for (int idx = gt; idx < 256 * 256; idx += NGT) { const int k = idx >> 8, n = idx & 255; const float ph = (float)((k * n) & 255) * (1.f / 256.f);
                WSP(bf16_t, WS_DCTX)[idx] = (bf16_t)f2bf(__builtin_amdgcn_cosf(ph) * 0.0625f);
                WSP(bf16_t, WS_DCTX)[65536 + idx] = (bf16_t)f2bf(-__builtin_amdgcn_sinf(ph) * 0.0625f); }
            if (wg == 0 && F.wave == 0) { for (int l = 0; l < NL; ++l) { float mq = 0.f, mk = 0.f;
                    for (int i = lane; i < DQK; i += 64) { mq = fmaxf(mq, fabsf(in_qhw[l * DQK + i])); mk = fmaxf(mk, fabsf(in_khw[l * DQK + i])); }
                    mq = wave_max(mq); mk = wave_max(mk);
                    if (lane == 0) WSP(float, WS_SMB)[l] = -(att::SCALE * (float)DQK * mq * mk) * 1.4426950408889634f; } }
            for (int idx = gt; idx < 1024; idx += NGT) { const int p = idx >> 4, i = idx & 15; const float inv = powf(10000.f, -(float)i / 16.f); const float ang = (float)p * inv;
                WSP(float, WS_ROPE)[2 * idx] = cosf(ang); WSP(float, WS_ROPE)[2 * idx + 1] = sinf(ang); }
        }
    }
}

__device__ __forceinline__ void phase_norm(Frame& F, int l) {
    FRESH_TID(tid_); const int lane = tid_ & 63;
    const int gw = F.vcu * NWAVES + F.wave, NGW = F.G * NWAVES;
    unsigned char* ws = F_WS;
    if (l == 0) {
        const float* mods = WSP(float, WS_MODS);
        const float* nw = F_IN(4);
        const float* src_lat = F_IN(0); const float* src_ctx = F_IN(2);
        bf16_t* H = WSP(bf16_t, WS_HMIX);
        for (int it = gw; it < MT / 2; it += NGW) {
            const int rowa = 2 * it;
            const bool lat = rowa < MLAT; const int rr = lat ? rowa : rowa - MLAT; const int mr = lat ? (rowa >> 12) : 4;
            const float* shp = mods + (size_t)mr * 6144; const float* scp = shp + 2048;
            f32x4 v[2][8], w4[8], sc4[8], sh4[8];
#pragma unroll
            for (int q = 0; q < 2; ++q) { const f32x4* xr = (const f32x4*)((lat ? src_lat : src_ctx) + (size_t)(rr + q) * DM) + lane;
#pragma unroll
                for (int j = 0; j < 8; ++j) v[q][j] = xr[64 * j]; }
#pragma unroll
            for (int j = 0; j < 8; ++j) { const int c0 = 4 * (lane + 64 * j); w4[j] = *(const f32x4*)(nw + c0); sc4[j] = *(const f32x4*)(scp + c0); sh4[j] = *(const f32x4*)(shp + c0); }
            float ssq[2];
#pragma unroll
            for (int q = 0; q < 2; ++q) { float s8 = 0.f;
#pragma unroll
                for (int j = 0; j < 8; ++j) s8 += (v[q][j][0] * v[q][j][0] + v[q][j][1] * v[q][j][1]) + (v[q][j][2] * v[q][j][2] + v[q][j][3] * v[q][j][3]);
                ssq[q] = wave_sum(s8); }
#pragma unroll
            for (int q = 0; q < 2; ++q) { const float rstd = 1.0f / sqrtf(ssq[q] * (1.f / DM) + EPS);
                u32x2* o8 = (u32x2*)(H + (size_t)(rowa + q) * DM) + lane;
#pragma unroll
                for (int j = 0; j < 8; ++j) { f32x4 hv;
#pragma unroll
                    for (int e = 0; e < 4; ++e) hv[e] = (v[q][j][e] * rstd * w4[j][e]) * (1.f + sc4[j][e]) + sh4[j][e];
                    u32x2 w; w.x = pk2(hv[0], hv[1]); w.y = pk2(hv[2], hv[3]); o8[64 * j] = w; } }
        }
        const float* mods1 = mods + (size_t)5 * 6144;
        LAS float* shl = (LAS float*)F.lds3;
        { float sv[20];
#pragma unroll
          for (int i = 0; i < 20; ++i) { const int e = tid_ + i * NWAVES * 64; sv[i] = mods1[(size_t)(e >> 11) * 6144 + (e & 2047)]; }
#pragma unroll
          for (int i = 0; i < 20; ++i) shl[tid_ + i * NWAVES * 64] = sv[i]; }
        __syncthreads();
        const bf16_t* WT = WSP(bf16_t, WS_WIN) + (size_t)NIN * DM; float* BI = WSP(float, WS_BIAS);
        u32x4 wv3[3][4];
#pragma unroll
        for (int ci = 0; ci < 3; ++ci) { const int c = gw + ci * NGW;
#pragma unroll
            for (int j = 0; j < 4; ++j) wv3[ci][j] = *(const u32x4*)(WT + (size_t)(c < NIN ? c : 0) * DM + (size_t)(lane + 64 * j) * 8); }
#pragma unroll
        for (int ci = 0; ci < 3; ++ci) { const int c = gw + ci * NGW; if (c >= NIN) break;
            float acc5[5] = {0.f, 0.f, 0.f, 0.f, 0.f};
#pragma unroll
            for (int j = 0; j < 4; ++j) { float wf[8]; unpack8(wv3[ci][j], wf);
#pragma unroll
                for (int b = 0; b < 5; ++b) { const f32x4 s0 = *(const LAS f32x4*)(shl + b * DM + (lane + 64 * j) * 8), s1 = *(const LAS f32x4*)(shl + b * DM + (lane + 64 * j) * 8 + 4);
                    acc5[b] += ((wf[0] * s0[0] + wf[1] * s0[1]) + (wf[2] * s0[2] + wf[3] * s0[3])) + ((wf[4] * s1[0] + wf[5] * s1[1]) + (wf[6] * s1[2] + wf[7] * s1[3])); } }
#pragma unroll
            for (int b = 0; b < 5; ++b) { const float t = wave_sum(acc5[b]); if (lane == 0) BI[(size_t)b * NIN + c] = t; } }
        __syncthreads();
    } else {
        const float* mods = WSP(float, WS_MODS) + (size_t)l * 5 * 6144;
        const float* nw = F_IN(4) + (size_t)l * DM;
        const float* src_ctx = F_IN(2);
        const float* part = WSP(float, WS_Q); const float* gate_c0 = WSP(float, WS_MODS) + (size_t)4 * 6144 + 4096;
        bf16_t* XB = WSP(bf16_t, WS_KV); float* RS = WSP(float, WS_RS);
        if ((gw & 1) == 0) { const int row = gw >> 1;
            if (row < MCTX) {
                f32x4 v[8], p0[8], p1[8], p2[8], p3[8], g4[8];
#pragma unroll
                for (int j = 0; j < 8; ++j) { const int c0 = 4 * (lane + 64 * j); const size_t po = (size_t)row * DM + c0;
                    v[j] = *(const f32x4*)(src_ctx + po); p0[j] = *(const f32x4*)(part + po); p1[j] = *(const f32x4*)(part + (size_t)MCTX * DM + po);
                    p2[j] = *(const f32x4*)(part + (size_t)2 * MCTX * DM + po); p3[j] = *(const f32x4*)(part + (size_t)3 * MCTX * DM + po); g4[j] = *(const f32x4*)(gate_c0 + c0); }
                float s8 = 0.f;
#pragma unroll
                for (int j = 0; j < 8; ++j) { v[j] = v[j] + g4[j] * ((p0[j] + p1[j]) + (p2[j] + p3[j]));
                    s8 += (v[j][0] * v[j][0] + v[j][1] * v[j][1]) + (v[j][2] * v[j][2] + v[j][3] * v[j][3]); }
                const float ssq = wave_sum(s8);
                if (lane == 0) RS[MLAT + row] = 1.0f / sqrtf(ssq * (1.f / DM) + EPS);
                const float* scp = mods + (size_t)4 * 6144 + 2048;
                u32x2* o8 = (u32x2*)(XB + (size_t)(MLAT + row) * DM) + lane;
#pragma unroll
                for (int j = 0; j < 8; ++j) { const int c0 = 4 * (lane + 64 * j); const f32x4 w4 = *(const f32x4*)(nw + c0), sc4 = *(const f32x4*)(scp + c0); f32x4 hv;
#pragma unroll
                    for (int e = 0; e < 4; ++e) hv[e] = (v[j][e] * w4[e]) * (1.f + sc4[e]);
                    u32x2 w; w.x = pk2(hv[0], hv[1]); w.y = pk2(hv[2], hv[3]); o8[64 * j] = w; }
            }
        } else {
            const float* SS = WSP(float, WS_SS);
            for (int r = (gw >> 1) * 64 + lane; r < MLAT; r += (NGW >> 1) * 64) { f32x4 a[8];
#pragma unroll
                for (int j = 0; j < 8; ++j)
#pragma unroll
                    for (int e = 0; e < 4; ++e) a[j][e] = SS[(size_t)(4 * j + e) * MLAT + r];
                float t = 0.f;
#pragma unroll
                for (int j = 0; j < 8; ++j) t += (a[j][0] + a[j][1]) + (a[j][2] + a[j][3]);
                RS[r] = 1.0f / sqrtf(t * (1.f / DM) + EPS); }
        }
    }
}

__device__ __forceinline__ void dft_gen(Frame& F, int l, int wg, int nwg) {
    FRESH_TID(tidl_); const int tidl = tidl_;
    unsigned char* ws = F_WS;
    bf16_t* Dc = (l == 0) ? (bf16_t*)F_OUT : WSP(bf16_t, WS_WIN); bf16_t* Ds = Dc + (size_t)2048 * KFOLD;
    for (int idx = wg * 512 + tidl; idx < 2048 * (KFOLD / 8); idx += nwg * 512) { const int k = idx / (KFOLD / 8), n0 = (idx - k * (KFOLD / 8)) * 8;
        float cv[8], sv[8];
#pragma unroll
        for (int e = 0; e < 8; ++e) { const float ph = (float)((k * (n0 + e)) & 4095) * (1.f / 4096.f);
            cv[e] = __builtin_amdgcn_cosf(ph) * 0.015625f; sv[e] = -__builtin_amdgcn_sinf(ph) * 0.015625f; }
        *(u32x4*)(Dc + (size_t)k * KFOLD + n0) = pack8(cv); *(u32x4*)(Ds + (size_t)k * KFOLD + n0) = pack8(sv); }
}

__device__ __forceinline__ void phase_heads_pool(Frame& F, int l, bool inplace) {
    FRESH_TID(tidl_); const int tidl = tidl_, lane = tidl & 63;
    const int npost = (l == 0) ? 136 : 128;
    const int nshare = (F.bx < npost) ? 1 : 2, vwg0 = (F.bx < npost) ? F.bx : npost + 2 * (F.bx - npost), NVWG = npost + 2 * (F.G - npost);
    unsigned char* ws = F_WS;
    const bf16_t* P = WSP(bf16_t, WS_P); bf16_t* KH = WSP(bf16_t, WS_KH);
    const float* rope = WSP(float, WS_ROPE);
    const float* kw = F_IN(16) + (size_t)l * DQK;
    const int h = lane >> 3, sub = lane & 7;
    const float sgn = (sub & 2) ? 1.f : -1.f;
    float kwr[8];
#pragma unroll
    for (int e = 0; e < 8; ++e) kwr[e] = kw[128 + sub * 8 + e];
    const float* RHp = WSP(float, WS_RH);
    for (int rf = 0; rf < ((REP_F & 1) ? 2 : 1); ++rf)
    for (int sh = 0; sh < nshare; ++sh)
    for (int row0 = (vwg0 + sh) * NWAVES + F.wave; row0 < MT; row0 += 4 * NVWG * NWAVES) {
        u32x4 l_kr[4]; float l_rh[4]; f32x4 rt[4][4];
#pragma unroll
        for (int k = 0; k < 4; ++k) { const int row = row0 + k * NVWG * NWAVES; const int rc = row < MT ? row : row0;
            l_kr[k] = *(const u32x4*)(P + (size_t)rc * NIN + OFF_KROPE + sub * 8); l_rh[k] = RHp[(size_t)rc * 8 + h];
            const int t = rc & (SEQ - 1); const int pos = (sub < 4) ? (t >> 6) : (t & 63);
            const f32x4* rp = (const f32x4*)(rope + (size_t)(pos * 16 + (sub & 1) * 8) * 2);
#pragma unroll
            for (int q4 = 0; q4 < 4; ++q4) rt[k][q4] = rp[q4]; }
        asm volatile("" ::: "memory");
#pragma unroll
        for (int k = 0; k < 4; ++k) { const int row = row0 + k * NVWG * NWAVES;
            if (row < MT) { const bool lat = row < MLAT;
                float r8[8], y[8]; unpack8(l_kr[k], r8);
#pragma unroll
                for (int e = 0; e < 8; ++e) { const float cs = lat ? rt[k][e >> 1][2 * (e & 1)] : 1.f, sn = lat ? rt[k][e >> 1][2 * (e & 1) + 1] : 0.f;
                    const float yy = r8[e] * l_rh[k] * kwr[e]; const float pr = lane_xor<2>(yy); y[e] = yy * cs + sgn * pr * sn; }
                *(u32x4*)(KH + (size_t)row * NQ + h * DQK + 128 + sub * 8) = pack8(y); } }
    }
    {
        bf16_t* mix = WSP(bf16_t, WS_HMIX);
        const int nrows = (l == 0) ? MT : MLAT;
        for (int rf = 0; rf < ((REP_F & 2) ? 2 : 1); ++rf)
        for (int sh = 0; sh < nshare; ++sh)
        for (int idx = (vwg0 + sh) * 512 + tidl; idx < nrows * 64; idx += NVWG * 512) { const int row = idx >> 6, cc = idx & 63, g = cc >> 4;
            const int w = 2 << g, lo = w >> 1, hi = w - lo - 1;
            const bool lat = row < MLAT; const int rr = lat ? row : row - MLAT;
            const int n = lat ? SEQ : CTX, t = rr & (n - 1), base = row - t;
            const int a = (t - lo) < 0 ? 0 : (t - lo), e = (t + hi) > (n - 1) ? (n - 1) : (t + hi);
            float s[8];
#pragma unroll
            for (int q = 0; q < 8; ++q) s[q] = 0.f;
            u32x4 wv[16]; const int cnt = e - a + 1;
#pragma unroll
            for (int k = 0; k < 16; ++k) wv[k] = (k < cnt) ? *(const u32x4*)(P + (size_t)(base + a + k) * NIN + OFF_POOL + cc * 8) : (u32x4){0u, 0u, 0u, 0u};
#pragma unroll
            for (int k = 0; k < 16; ++k) { float f[8]; unpack8(wv[k], f);
#pragma unroll
                for (int q = 0; q < 8; ++q) s[q] += f[q]; }
            float self[8], gt8[8]; unpack8(*(const u32x4*)(P + (size_t)row * NIN + OFF_POOL + cc * 8), self); unpack8(*(const u32x4*)(P + (size_t)row * NIN + OFF_PGATE + cc * 8), gt8);
            const float inv = 1.f / (float)(e - a + 1);
#pragma unroll
            for (int q = 0; q < 8; ++q) s[q] = siluf(gt8[q]) * (s[q] * inv - self[q]);
            *(u32x4*)(mix + (size_t)row * DM + cc * 8) = pack8(s); }
    }
}

__global__ void __launch_bounds__(NWAVES * 64, 2) fwd_kernel(Args args) {
    extern __shared__ __attribute__((aligned(16))) unsigned char lds[];
    Frame F;
    F.lds = lds;
    const int tid0 = threadIdx.x; F.wave = __builtin_amdgcn_readfirstlane(tid0 >> 6);
    F.G = NCU; F.bx = blockIdx.x; F.vcu = (F.bx % 8) * (NCU / 8) + F.bx / 8;
    LAS unsigned char* lds3 = (LAS unsigned char*)lds; F.lds3 = lds3;
    volatile LAS unsigned* MISC = (volatile LAS unsigned*)(lds3 + MISC_OFF);
    for (int u = tid0; u < (LDS_BYTES - LDSCTL_OFF) / 4; u += NWAVES * 64) ((LAS unsigned*)(lds3 + LDSCTL_OFF))[u] = 0u;
    __syncthreads();
    unsigned char* ws = F_WS;
    unsigned* ctl = (unsigned*)(ws + WS_CTL);
    XcdBarrier bar; bar.bar = ctl + CW_BAR; bar.x = 0; bar.st = nullptr;
    const int lo = MK_ONE_LAUNCH ? 0 : args.ph_lo, hi = MK_ONE_LAUNCH ? (1 + 6 * NL) : args.ph_hi;
    const bool multi = (hi - lo) > 1;
    if (multi) bar = xcd_barrier_post(ctl + CW_BAR, MISC + 8, tid0);
#ifndef PHM
#define PHM 0xff
#endif
#ifndef REP_MASK
#define REP_MASK 0
#endif
#define NREP(bit) ((REP_MASK & (bit)) ? 2 : 1)

    for (int ph = lo; ph < hi; ++ph) {
        const int l = (ph > 6) ? 1 : 0, kind = (ph == 0) ? 0 : ph - 6 * l;
        unsigned char* ws = F_WS;
        if ((PHM & 1) && kind == 0) { for (int rep = 0; rep < NREP(1); ++rep) { phase_prep(F, 0, F.vcu, F.G); __syncthreads(); } }
        if ((PHM & 2) && kind == 1) for (int rep = 0; rep < NREP(2); ++rep) phase_norm(F, l);
        if ((PHM & 4) && kind == 2) for (int rep = 0; rep < NREP(4); ++rep) {
            pg8::Gemm g{l == 0 ? WSP(bf16_t, WS_HMIX) : WSP(bf16_t, WS_KV), WSP(bf16_t, WS_WIN) + (size_t)l * NIN * DM, DM, DM, DM, 1 << 20, 0};
            pg8::StaticOrder S; S.init(MT / 256, NIN / 256, F.G, F.bx);
            pg8::Epi E{}; E.kind = 0; E.O = WSP(bf16_t, WS_P); E.ldc = NIN; E.rowoff = 0; E.cmul = 256; E.cadd = 0; E.csplit = 1 << 20; E.cadd2 = 0;
            E.xt_lat = WSP(bf16_t, WS_XTC); E.xt_ctx = WSP(bf16_t, WS_XTCC);
            if (l != 0) { E.rs = WSP(float, WS_RS); E.bias = WSP(float, WS_BIAS); }
            E.sqo = WSP(float, WS_SQ);
            for (int rc = 0; rc < ((REP_P & 16) ? 2 : 1); ++rc)
            pg8::gemm_phase<pg8::Epi, pg8::StaticOrder, true, true>(lds3, g, S, E, F.wave);
            { const int nfull = (MT / 256) * (NIN / 256) % F.G; const bool sub = nfull > 0 && nfull < F.G;
              if (!sub || F.bx >= nfull) { const int wgi = sub ? F.bx - nfull : F.bx, nwgi = sub ? F.G - nfull : F.G;
                  dft_gen(F, l, wgi, nwgi); __syncthreads(); phase_prep(F, l == 0 ? 1 : 2, wgi, nwgi); } }
        }
        if ((PHM & 16) && kind == 3) for (int rep = 0; rep < NREP(16); ++rep) {
            constexpr int split = 72;
            const int nrest = F.G - split;
            if (rep == 0) {
                FRESH_TID(tz_); const int lz = tz_ & 63; const int gwz = F.vcu * NWAVES + F.wave, NGWZ = F.G * NWAVES;
                bf16_t* XC = WSP(bf16_t, WS_XTC); bf16_t* PC = WSP(bf16_t, WS_PCS) + (size_t)2048 * PCSW;
                for (int r = gwz; r < 1040 + 1024; r += NGWZ) {
                    const bool cosr = r < 1040;
                    bf16_t* xr = XC + (size_t)(cosr ? r : r + 240) * DPITCH;
                    u32x4 lo[4], hi[4]; unsigned short f0[4];
#pragma unroll
                    for (int i = 0; i < 4; ++i) { const int c = i * 64 + lz;
                        lo[i] = *(const u32x4*)(xr + 8 * c); hi[i] = *(const u32x4*)(xr + 8 * (511 - c)); f0[i] = *(const unsigned short*)(xr + 4096 - 8 * c); }
                    asm volatile("s_waitcnt vmcnt(0)" ::: "memory");
                    float a = 0.f; const float sg = cosr ? 1.f : -1.f;
#pragma unroll
                    for (int i = 0; i < 4; ++i) { const int c = i * 64 + lz;
                        float L[8], H[8], f[8]; unpack8(lo[i], L); unpack8(hi[i], H);
                        f[0] = (c == 0) ? L[0] : L[0] + sg * bf2f(f0[i]);
#pragma unroll
                        for (int q = 1; q < 8; ++q) f[q] = L[q] + sg * H[8 - q];
                        a += ((f[0] - f[1]) + (f[2] - f[3])) + ((f[4] - f[5]) + (f[6] - f[7]));
                        *(u32x4*)(xr + 8 * c) = pack8(f); }
                    unsigned zz = 0u; asm volatile("" : "+v"(zz));
                    if (lz == 63) { a += bf2f((unsigned short)(hi[3].x & 0xffffu)); u32x4 z; z.x = hi[3].x & 0xffffu; z.y = zz; z.z = zz; z.w = zz; *(u32x4*)(xr + 2048) = z; }
                    if (lz < 15) { u32x4 z; z.x = zz; z.y = zz; z.z = zz; z.w = zz; *(u32x4*)(xr + 2056 + 8 * lz) = z; }
                    a = wave_sum(a) * 0.015625f;
                    if (cosr) { const int col = (r < 1024) ? ((r >> 8) * 512 + (r & 255)) : (2048 + (r - 1024)); if (lz == 0) PC[col] = (bf16_t)f2bf(a); }
                    else { const int q = r - 1040; if (lz == 0) PC[(q >> 8) * 512 + 256 + (q & 255)] = 0; }
                }
                asm volatile("s_waitcnt vmcnt(0)" ::: "memory");
                __syncthreads();
                if (tz_ == 0) { __builtin_amdgcn_fence(__ATOMIC_RELEASE, "agent"); asm volatile("s_waitcnt vmcnt(0)" ::: "memory"); (void)xb_add(WSP(unsigned, WS_CTL) + CW_FOLD + 64 * l, 1u); }
            }
            for (int jj = 0; jj < 7; ++jj) { const int job = (jj == 0) ? 5 : (jj < 6 ? jj - 1 : 6);
                pg8::Gemm g{}; pg8::RangeOrder S; pg8::Epi E{}; E.kind = 0; E.rowoff = 0; E.cmul = 256; E.cadd = 0; E.csplit = 1 << 20; E.cadd2 = 0; E.xt_lat = nullptr; E.xt_ctx = nullptr; E.mirror = 0;
                if (job == 0) {
                    if (F.bx < split) {
                        FRESH_TID(tw_);
                        if (tw_ == 0) { unsigned* cw = WSP(unsigned, WS_CTL); XB_SPIN(xb_ld(cw + CW_FOLD + 64 * l) < (unsigned)F.G, cw + CW_BAR); __builtin_amdgcn_fence(__ATOMIC_ACQUIRE, "agent"); asm volatile("s_waitcnt vmcnt(0)" ::: "memory"); }
                        __syncthreads(); }
                    g = pg8::Gemm{(l == 0) ? (const bf16_t*)F_OUT : WSP(bf16_t, WS_WIN), WSP(bf16_t, WS_XTC), KFOLD, DPITCH, KFOLD, 1 << 20, 0};
                    S.init(8, 5, 40, F.bx);
                    E.O = WSP(bf16_t, WS_PCS); E.ldc = PCSW; E.cmul = 512; E.csplit = 4; E.cadd2 = 2048; E.mirror = 1;
                } else if (job == 1) {
                    g = pg8::Gemm{((l == 0) ? (const bf16_t*)F_OUT : WSP(bf16_t, WS_WIN)) + (size_t)2048 * KFOLD, WSP(bf16_t, WS_XTS), KFOLD, DPITCH, KFOLD, 1 << 20, 0};
                    S.init(8, 4, 32, F.bx - 40);
                    E.O = WSP(bf16_t, WS_PCS); E.ldc = PCSW; E.cmul = 512; E.cadd = 256; E.mirror = -1;
                } else if (job == 2) {
                    if (l != 0) continue;
                    g = pg8::Gemm{WSP(bf16_t, WS_DCTX), WSP(bf16_t, WS_XTCC), 256, 256, 256, 1 << 20, 0};
                    S.init(1, 5, 5, F.bx - split - 72);
                    E.O = WSP(bf16_t, WS_PCSC); E.ldc = PCSW; E.cmul = 512; E.csplit = 4; E.cadd2 = 2048;
                } else if (job == 3) {
                    if (l != 0) continue;
                    g = pg8::Gemm{WSP(bf16_t, WS_DCTX) + 65536, WSP(bf16_t, WS_XTSC), 256, 256, 256, 1 << 20, 0};
                    S.init(1, 4, 4, F.bx - split - 77);
                    E.O = WSP(bf16_t, WS_PCSC); E.ldc = PCSW; E.cmul = 512; E.cadd = 256;
                } else if (job == 4) {
                    g = pg8::Gemm{WSP(bf16_t, WS_P) + OFF_CQ, WSP(bf16_t, WS_WUQ) + (size_t)l * NQ * 512, NIN, 512, 512, 1 << 20, 0};
                    S.init(l == 0 ? MT / 256 : MLAT / 256, NQ / 256, nrest, F.bx - split);
                    E.O = WSP(bf16_t, WS_Q); E.ldc = NQ; E.sq8 = WSP(float, WS_SQ);
                } else {
                    g = pg8::Gemm{WSP(bf16_t, WS_P) + OFF_CKV, WSP(bf16_t, WS_WUKV) + (size_t)l * NKV * 512, NIN, 512, 512, 1 << 20, 0};
                    if (job == 5) S.init_range(MT / 256, NKV / 256, 0, 2 * split, split, F.bx);
                    else S.init_range(MT / 256, NKV / 256, 2 * split, (MT / 256) * (NKV / 256), nrest, F.bx >= split ? (F.bx - split + 144) % nrest : -1);
                    E.O = (l == 0) ? WSP(bf16_t, WS_KV) : (bf16_t*)F_OUT; E.ldc = NKV; E.sq8 = WSP(float, WS_SQ) + (size_t)8 * MT;
                    E.kind = 4; E.kr2 = WSP(float, WS_SQ) + (size_t)16 * MT; E.kh = WSP(bf16_t, WS_KH); E.rh = WSP(float, WS_RH); E.kw = F_IN(16) + (size_t)l * DQK; E.qwk = F_IN(15) + (size_t)l * DQK;
                    E.part = (LAS float*)(lds3 + 132096);
                }
                if (job >= 5) { pg8::Epi4 E4{E}; pg8::gemm_phase<pg8::Epi4, pg8::RangeOrder, true, true>(lds3, g, S, E4, F.wave); }
                else
                for (int rj = 0; rj < (((REP_EJ >> job) & 1) ? 2 : 1); ++rj)
                pg8::gemm_phase<pg8::Epi, pg8::RangeOrder, true, true>(lds3, g, S, E, F.wave);
            }
        }
        if ((PHM & 32) && kind == 4) for (int rep = 0; rep < NREP(32); ++rep) {
            for (int job = 0; job < 2; ++job) {
                if (job == 1 && l != 0) continue;
                pg8::Gemm g{}; pg8::RangeOrder S; pg8::Epi E{}; E.kind = 1; E.O = WSP(bf16_t, WS_HMIX); E.ldc = DM; E.P = WSP(bf16_t, WS_P);
                E.fw = F_IN(10) + (size_t)l * 4 * 128 * 128;
                if (job == 0) { g = pg8::Gemm{WSP(bf16_t, WS_PCS), WSP(bf16_t, WS_FWAB) + (size_t)l * 512 * 512, PCSW, 512, 512, 16, 512};
                    S.init(64, 2, F.G, F.bx); E.rowoff = 0; E.NY = WSP(bf16_t, WS_PCS); E.nseq = SEQ; E.lgseq = 12; }
                else { g = pg8::Gemm{WSP(bf16_t, WS_PCSC), WSP(bf16_t, WS_FWAB) + (size_t)l * 512 * 512, PCSW, 512, 512, 1, 512};
                    S.init_range(4, 2, 0, 8, 8, F.bx - 128); E.rowoff = MLAT; E.NY = WSP(bf16_t, WS_PCSC); E.nseq = CTX; E.lgseq = 8; }
                for (int rf = 0; rf < ((REP_F & 4) ? 2 : 1); ++rf)
                pg8::gemm_phase<pg8::Epi, pg8::RangeOrder, true, true>(lds3, g, S, E, F.wave);
            }
            __syncthreads();
            phase_heads_pool(F, l, rep == 0);
        }
        if ((PHM & 64) && kind == 5) for (int rep = 0; rep < NREP(64); ++rep) {
            const bf16_t* Qg = WSP(bf16_t, WS_Q); const bf16_t* KHg = WSP(bf16_t, WS_KH); const bf16_t* KVg = (l == 0) ? WSP(bf16_t, WS_KV) : (const bf16_t*)F_OUT; const bf16_t* Pg = WSP(bf16_t, WS_P); bf16_t* mix = WSP(bf16_t, WS_HMIX);
            const float* qhw = F_IN(15) + (size_t)l * DQK; const float* ropet = WSP(float, WS_ROPE);
            const float negMC = __builtin_bit_cast(float, __builtin_amdgcn_readfirstlane(__builtin_bit_cast(int, WSP(float, WS_SMB)[l])));
            for (int u = F.vcu; u < NB * NH * 16; u += F.G) {
                const int bh = u >> 4, qb = u & 15, b = bh >> 3, h = bh & 7;
                att::attn_unit(Qg, KHg, KVg, Pg, mix, qhw, ropet, h, b * SEQ + qb * 256, MLAT + b * CTX, b * SEQ, 4, 68, negMC, (char*)lds, F.wave);
            }
            if (l == 0) for (int u = F.vcu; u < NB * NH; u += F.G) {
                const int b = u >> 3, h = u & 7;
                att::attn_unit(Qg, KHg, KVg, Pg, mix, qhw, ropet, h, MLAT + b * CTX, MLAT + b * CTX, 0, 4, 4, negMC, (char*)lds, F.wave);
            }
        }
        if ((PHM & 128) && kind == 6) for (int rep = 0; rep < (l == 0 ? NREP(128) : 1); ++rep) {
            if (l == 0) for (int kq = 0; kq < 4; ++kq) {
                pg8::Gemm g{WSP(bf16_t, WS_HMIX) + (size_t)MLAT * DM + kq * 512, WSP(bf16_t, WS_WOUT) + kq * 512, DM, DM, 512, 1 << 20, 0};
                pg8::RangeOrder S; if (F.G >= 128) S.init(MCTX / 256, DM / 256, 32, F.bx - kq * 32); else S.init(MCTX / 256, DM / 256, F.G, F.bx);
                pg8::Epi E{}; E.kind = 3; E.out_ctx = WSP(float, WS_Q) + (size_t)kq * MCTX * DM;
                pg8::gemm_phase<pg8::Epi, pg8::RangeOrder, true, true>(lds3, g, S, E, F.wave);
            }
            { pg8::Gemm g{WSP(bf16_t, WS_HMIX), WSP(bf16_t, WS_WOUT) + (size_t)l * DM * DM, DM, DM, DM, 1 << 20, 0};
              pg8::StaticOrder S; S.init(MLAT / 256, DM / 256, F.G, F.bx);
              pg8::Epi E{}; E.kind = 2; E.mods = WSP(float, WS_MODS) + (size_t)l * 5 * 6144;
              E.xin_lat = (l == 0) ? F_IN(0) : (const float*)F_OUT; E.xin_ctx = nullptr; E.out_lat = F_OUT; E.out_ctx = nullptr;
              E.nw1 = F_IN(4) + DM; E.sc1 = WSP(float, WS_MODS) + (size_t)5 * 6144 + 2048;
              if (l == 0) { E.xb = WSP(bf16_t, WS_KV); E.ss = WSP(float, WS_SS); } else E.xbr = WSP(bf16_t, WS_KV);
              pg8::gemm_phase<pg8::Epi, pg8::StaticOrder, true, true>(lds3, g, S, E, F.wave); }
        }
        if (ph + 1 < hi) { FRESH_TID(tb_); xcd_barrier(bar, tb_); }
    }
}

constexpr int N_PHASES = 1 + 6 * NL;
extern "C" void kernel_launch(void* const* d_in, const int* in_sizes, int n_in, void* d_out, int out_size, void* d_ws, size_t ws_size, hipStream_t stream) {
    static int grid = 0;
    if (grid == 0) {
        if (n_in != 18 || out_size != MLAT * DM || ws_size < WS_END) { fprintf(stderr, "kernel_launch: unexpected shapes (n_in %d out %d ws %zu need %zu)\n", n_in, out_size, ws_size, (size_t)WS_END); grid = -1; return; }
        int dev = 0, cus = 0;
        if (hipGetDevice(&dev) != hipSuccess || hipDeviceGetAttribute(&cus, hipDeviceAttributeMultiprocessorCount, dev) != hipSuccess) { grid = -1; return; }
        if (hipFuncSetAttribute((const void*)fwd_kernel, hipFuncAttributeMaxDynamicSharedMemorySize, LDS_BYTES) != hipSuccess) { fprintf(stderr, "kernel_launch: hipFuncSetAttribute failed\n"); grid = -1; return; }
        if (cus != NCU) fprintf(stderr, "kernel_launch: built for %d CUs, device reports %d\n", NCU, cus);
        grid = NCU;
    }
    if (grid < 0) return;
    (void)hipMemsetAsync((char*)d_ws + WS_CTL, 0, 65536, stream);
    Args a{};
    for (int i = 0; i < 18; ++i) a.in[i] = d_in[i];
    a.out = (float*)d_out; a.ws = (unsigned char*)d_ws;
#if MK_ONE_LAUNCH
    a.ph_lo = 0; a.ph_hi = N_PHASES;
    hipLaunchKernelGGL(fwd_kernel, dim3(grid), dim3(NWAVES * 64), LDS_BYTES, stream, a);
#else
    for (int p = 0; p < N_PHASES; ++p) { a.ph_lo = p; a.ph_hi = p + 1; hipLaunchKernelGGL(fwd_kernel, dim3(grid), dim3(NWAVES * 64), LDS_BYTES, stream, a); }
#endif
}
```

```cpp
#include <hip/hip_runtime.h>
#include <hip/hip_bf16.h>
#include <cstdio>
#include <cstdint>
#include <cmath>

#ifndef MK_ONE_LAUNCH
#define MK_ONE_LAUNCH 1
#endif
#ifndef REP_EJ
#define REP_EJ 0
#endif
#ifndef REP_F
#define REP_F 0
#endif
#ifndef REP_P
#define REP_P 0
#endif

constexpr int DM = 2048, NB = 4, SEQ = 4096, NL = 2, CTX = 256;
constexpr int MLAT = NB * SEQ, MCTX = NB * CTX, MT = MLAT + MCTX;
constexpr int DIN = 4160, NIN = 4352;
constexpr int OFF_POOL = 0, OFF_PGATE = 512, OFF_FNET = 1024, OFF_FGATE = 1536, OFF_CQ = 2048, OFF_CKV = 2560, OFF_KROPE = 3072, OFF_MGATE = 3136;
constexpr int NH = 8, DQK = 192, NQ = NH * DQK, NKV = NH * 256;
constexpr int PCSW = 2304;
constexpr int DPITCH = SEQ + 64;
constexpr float EPS = 1e-6f;

constexpr size_t al256(size_t x) { return (x + 255) / 256 * 256; }
constexpr size_t WS_CTL = 0, CTL_BYTES = 1u << 20;
constexpr size_t WS_MODS = WS_CTL + CTL_BYTES;
constexpr size_t WS_ROPE = WS_MODS + al256((size_t)NL * 5 * 6144 * 4);
constexpr size_t WS_SMB = WS_ROPE + al256(64 * 16 * 2 * 4);
constexpr size_t WS_WIN = WS_SMB + 256;
constexpr size_t WS_WUQ = WS_WIN + (size_t)NL * NIN * DM * 2;
constexpr size_t WS_WUKV = WS_WUQ + (size_t)NL * NQ * 512 * 2;
constexpr size_t WS_WOUT = WS_WUKV + (size_t)NL * NKV * 512 * 2;
constexpr size_t WS_FWAB = WS_WOUT + (size_t)NL * DM * DM * 2;
constexpr size_t WS_DCTX = WS_FWAB + (size_t)NL * 512 * 512 * 2;
constexpr size_t WS_HMIX = WS_DCTX + 2 * 256 * 256 * 2;
constexpr size_t WS_P = WS_HMIX + (size_t)MT * DM * 2;
constexpr size_t WS_Q = WS_P + (size_t)MT * NIN * 2;
constexpr size_t WS_KV = WS_Q + (size_t)MT * NQ * 2;
constexpr size_t WS_XTC = WS_KV + (size_t)MT * NKV * 2;
constexpr size_t WS_XTS = WS_XTC + (size_t)1280 * DPITCH * 2;
constexpr size_t WS_XTCC = WS_XTS + (size_t)1024 * DPITCH * 2;
constexpr size_t WS_XTSC = WS_XTCC + (size_t)1280 * 256 * 2;
constexpr size_t WS_PCS = WS_XTSC + (size_t)1024 * 256 * 2;
constexpr size_t WS_PCSC = WS_PCS + (size_t)4096 * PCSW * 2;
constexpr size_t WS_CTXN = WS_PCSC + (size_t)256 * PCSW * 2;
constexpr size_t WS_KH = WS_CTXN + (size_t)MCTX * DM * 4;
constexpr size_t WS_SS = WS_KH + (size_t)MT * NQ * 2;
constexpr size_t WS_RS = WS_SS + (size_t)MLAT * 32 * 4;
constexpr size_t WS_BIAS = WS_RS + al256((size_t)MT * 4);
constexpr size_t WS_SQ = WS_BIAS + al256((size_t)5 * NIN * 4);
constexpr size_t WS_RH = WS_SQ + (size_t)18 * MT * 4;
constexpr size_t WS_END = WS_RH + (size_t)MT * 8 * 4;
static_assert((size_t)2 * 2048 * 2176 * 2 <= (size_t)NIN * DM * 2, "layer-1 DFT matrices fit layer 0's WinT");
static_assert(WS_END <= (size_t)512 * 1024 * 1024, "workspace map exceeds 512 MiB");

#define LAS __attribute__((address_space(3)))
typedef unsigned short bf16_t;
typedef short bf16x8 __attribute__((ext_vector_type(8)));
typedef short s16x4 __attribute__((ext_vector_type(4)));
typedef float f32x4 __attribute__((ext_vector_type(4)));
typedef float f32x2 __attribute__((ext_vector_type(2)));
typedef float f32x16 __attribute__((ext_vector_type(16)));
typedef unsigned u32x4 __attribute__((ext_vector_type(4)));
typedef unsigned u32x2 __attribute__((ext_vector_type(2)));
#define RLX_AGENT __ATOMIC_RELAXED, __HIP_MEMORY_SCOPE_AGENT

__device__ __forceinline__ int lane_id() { int r; asm volatile("v_mbcnt_lo_u32_b32 %0, -1, 0\n\tv_mbcnt_hi_u32_b32 %0, -1, %0" : "=v"(r)); return r; }
__device__ __forceinline__ unsigned f2bf(float f) { unsigned u = __builtin_bit_cast(unsigned, f); return (u + 0x7fffu + ((u >> 16) & 1u)) >> 16; }
__device__ __forceinline__ unsigned pk2(float lo, float hi) { return f2bf(lo) | (f2bf(hi) << 16); }
__device__ __forceinline__ float bf2f(unsigned short h) { return __builtin_bit_cast(float, (unsigned)h << 16); }
__device__ __forceinline__ float bflo(unsigned w) { return __builtin_bit_cast(float, w << 16); }
__device__ __forceinline__ float bfhi(unsigned w) { return __builtin_bit_cast(float, w & 0xffff0000u); }
__device__ __forceinline__ float siluf(float v) { return v * __builtin_amdgcn_rcpf(1.f + __builtin_amdgcn_exp2f(-1.4426950408889634f * v)); }
template <int O> __device__ __forceinline__ float lane_xor(float v) {
    return __builtin_bit_cast(float, __builtin_amdgcn_ds_swizzle(__builtin_bit_cast(int, v), (O << 10) | 0x1f));
}
__device__ __forceinline__ float wave_sum(float v) {
    v += lane_xor<1>(v); v += lane_xor<2>(v); v += lane_xor<4>(v); v += lane_xor<8>(v); v += lane_xor<16>(v);
    auto rr = __builtin_amdgcn_permlane32_swap(__float_as_uint(v), __float_as_uint(v), false, false);
    return __uint_as_float(rr[0]) + __uint_as_float(rr[1]);
}
__device__ __forceinline__ float wave_max(float v) {
    v = fmaxf(v, lane_xor<1>(v)); v = fmaxf(v, lane_xor<2>(v)); v = fmaxf(v, lane_xor<4>(v)); v = fmaxf(v, lane_xor<8>(v)); v = fmaxf(v, lane_xor<16>(v));
    auto rr = __builtin_amdgcn_permlane32_swap(__float_as_uint(v), __float_as_uint(v), false, false);
    return fmaxf(__uint_as_float(rr[0]), __uint_as_float(rr[1]));
}
__device__ __forceinline__ void unpack8(const u32x4 w, float* f) {
    f[0] = bflo(w.x); f[1] = bfhi(w.x); f[2] = bflo(w.y); f[3] = bfhi(w.y); f[4] = bflo(w.z); f[5] = bfhi(w.z); f[6] = bflo(w.w); f[7] = bfhi(w.w);
}
__device__ __forceinline__ u32x4 pack8(const float* f) { u32x4 w; w.x = pk2(f[0], f[1]); w.y = pk2(f[2], f[3]); w.z = pk2(f[4], f[5]); w.w = pk2(f[6], f[7]); return w; }

namespace pg8 {
#define PG8_LAS __attribute__((address_space(3)))
constexpr int BM = 256, BK = 64, HALF = 128, HTB = HALF * BK * 2, STAGE_BYTES = 8 * HTB, NXCD = 8, WGM = 8;
__host__ __device__ __forceinline__ int lds_byte(int r, int c) { const int st = (r >> 4) * 2 + (c >> 5), rr = r & 15, cc = c & 31, ob = rr * 64 + cc * 2; return st * 1024 + (ob ^ (((ob >> 9) & 1) << 5)); }
__host__ __device__ __forceinline__ void stage_rc(int b, int& R, int& C) { const int st = b / 1024, sb = b % 1024, swz = sb ^ (((sb >> 9) & 1) << 5); R = (st >> 1) * 16 + swz / 64; C = (st & 1) * 32 + (swz % 64) / 2; }
__host__ __device__ __forceinline__ int perm32(int rho) { const int n = rho >> 4, i = rho & 15; return 8 * (i >> 2) + 4 * n + (i & 3); }

struct Unit { int pm, pn; };
struct Gemm { const bf16_t* A; const bf16_t* Bt; int lda, ldb, K, mper; long abatch; };

template <int WG_M> struct StaticOrderT {
    int nM, nN, nwg, G, c;
    __device__ void init(int nM_, int nN_, int G_, int c_) { nM = nM_; nN = nN_; nwg = nM * nN; G = G_; c = c_; }
    __device__ bool next(int i, Unit& u) const {
        const long L = (long)i * G + c; if (c < 0 || L >= nwg) return false;
        int wgid = (int)L; { const int q = nwg / NXCD, r = nwg % NXCD, xcd = wgid % NXCD, off = wgid / NXCD; wgid = (xcd < r ? xcd * (q + 1) : r * (q + 1) + (xcd - r) * q) + off; }
        const int nig = WG_M * nN, gid = wgid / nig, fm = gid * WG_M, rem = wgid - gid * nig;
        u.pm = fm + (rem % WG_M); u.pn = rem / WG_M; return true;
    }
};
typedef StaticOrderT<4> StaticOrder;
struct RangeOrder {
    int nM, nN, first, last, G, c;
    __device__ void init(int nM_, int nN_, int G_, int c_) { nM = nM_; nN = nN_; first = 0; last = nM_ * nN_; G = G_; c = (c_ >= 0 && c_ < G_) ? c_ : -1; }
    __device__ void init_range(int nM_, int nN_, int first_, int last_, int G_, int c_) { nM = nM_; nN = nN_; first = first_; last = last_; G = G_; c = (c_ >= 0 && c_ < G_) ? c_ : -1; }
    __device__ bool next(int i, Unit& u) const {
        if (c < 0) return false; const long L = (long)first + (long)i * G + c; if (L >= last) return false;
        u.pm = (int)(L % nM); u.pn = (int)(L / nM); return true;
    }
};

__device__ __forceinline__ unsigned cvt_pk_bf16(float lo, float hi) { unsigned r; asm volatile("v_cvt_pk_bf16_f32 %0, %1, %2" : "=v"(r) : "v"(lo), "v"(hi)); return r; }

struct Epi {
    static constexpr bool PERM = true, AFTER_DRAIN = false;
    int kind;
    bf16_t* O; int ldc; int rowoff; int cmul, cadd, csplit, cadd2;
    int mirror;
    bf16_t* xt_lat; bf16_t* xt_ctx;
    const float* kr2; bf16_t* kh; float* rh; const float* kw; const float* qwk; PG8_LAS float* part;
    const float* sq8; float* sqo;
    const float* rs; const float* bias;
    const bf16_t* P; const bf16_t* NY; const float* fw; int nseq, lgseq;
    const float* xin_lat; const float* xin_ctx; float* out_lat; float* out_ctx; const float* mods;
    const bf16_t* xbr;
    bf16_t* xb; const float* nw1; const float* sc1; float* ss;
    __device__ __forceinline__ void k4(f32x4 (&acc)[2][2][4][2], const Unit& u, int wr, int wc, int fr, int fq) const {
        const int row0 = u.pm * BM + wr * 64 + fr;
        const int cl0 = wc * 32 + 8 * fq;
        {
            const int h = u.pn, rowl0 = wr * 64 + fr;
#pragma unroll
            for (int ai = 0; ai < 2; ++ai) {
                float t[4][8], rr4[4];
#pragma unroll
                for (int m = 0; m < 4; ++m)
#pragma unroll
                    for (int k = 0; k < 8; ++k) t[m][k] = sq8[(size_t)k * MT + (row0 + ai * HALF + m * 16)];
#pragma unroll
                for (int m = 0; m < 4; ++m) rr4[m] = 1.0f / sqrtf((((t[m][0] + t[m][1]) + (t[m][2] + t[m][3])) + ((t[m][4] + t[m][5]) + (t[m][6] + t[m][7]))) * (1.f / 512.f) + EPS);
#pragma unroll
                for (int m = 0; m < 4; ++m) { const int rk = row0 + ai * HALF + m * 16; const float rr = rr4[m];
                    { const f32x4 v0 = acc[ai][1][m][0] * rr, v1 = acc[ai][1][m][1] * rr;
                      u32x4 w; w.x = cvt_pk_bf16(v0[0], v0[1]); w.y = cvt_pk_bf16(v0[2], v0[3]); w.z = cvt_pk_bf16(v1[0], v1[1]); w.w = cvt_pk_bf16(v1[2], v1[3]);
                      *(u32x4*)(O + (size_t)rk * ldc + h * 256 + HALF + cl0) = w; }
                    acc[ai][0][m][0] = acc[ai][0][m][0] * rr; acc[ai][0][m][1] = acc[ai][0][m][1] * rr;
                    const f32x4 k0 = acc[ai][0][m][0], k1 = acc[ai][0][m][1];
                    float sq = ((k0[0] * k0[0] + k0[1] * k0[1]) + (k0[2] * k0[2] + k0[3] * k0[3])) + ((k1[0] * k1[0] + k1[1] * k1[1]) + (k1[2] * k1[2] + k1[3] * k1[3]));
                    sq += lane_xor<16>(sq);
                    { auto pr = __builtin_amdgcn_permlane32_swap(__float_as_uint(sq), __float_as_uint(sq), false, false); sq = __uint_as_float(pr[0]) + __uint_as_float(pr[1]); }
                    if (fq == 0) part[wc * 256 + rowl0 + ai * HALF + m * 16] = sq; }
            }
            float krs[2][4];
#pragma unroll
            for (int ai = 0; ai < 2; ++ai)
#pragma unroll
                for (int m = 0; m < 4; ++m) { const int rk = row0 + ai * HALF + m * 16; typedef const __attribute__((address_space(1))) float* gfp;
                    krs[ai][m] = ((gfp)kr2)[rk] + ((gfp)kr2)[(size_t)MT + rk]; }
            asm volatile("s_waitcnt lgkmcnt(0)" ::: "memory");
            __builtin_amdgcn_s_barrier();
            const f32x4 kw0 = *(const f32x4*)(kw + cl0) * *(const f32x4*)(qwk + cl0), kw1 = *(const f32x4*)(kw + cl0 + 4) * *(const f32x4*)(qwk + cl0 + 4);
#pragma unroll
            for (int ai = 0; ai < 2; ++ai)
#pragma unroll
                for (int m = 0; m < 4; ++m) { const int rk = row0 + ai * HALF + m * 16, rl = rowl0 + ai * HALF + m * 16;
                    const float tot = ((part[rl] + part[256 + rl]) + (part[512 + rl] + part[768 + rl])) + krs[ai][m];
                    const float rhv = 1.0f / sqrtf(tot * (1.f / 192.f) + EPS);
                    if (wc == 0 && fq == 0) rh[(size_t)rk * 8 + h] = rhv;
                    const f32x4 k0 = acc[ai][0][m][0] * rhv * kw0, k1 = acc[ai][0][m][1] * rhv * kw1;
                    u32x4 w; w.x = cvt_pk_bf16(k0[0], k0[1]); w.y = cvt_pk_bf16(k0[2], k0[3]); w.z = cvt_pk_bf16(k1[0], k1[1]); w.w = cvt_pk_bf16(k1[2], k1[3]);
                    *(u32x4*)(kh + (size_t)rk * (8 * 192) + h * 192 + cl0) = w; }
        }
    }
    __device__ __forceinline__ void operator()(f32x4 (&acc)[2][2][4][2], const Unit& u, int wr, int wc, int fr, int fq) const {
        const int row0 = u.pm * BM + wr * 64 + fr;
        const int cl0 = wc * 32 + 8 * fq;
        if (kind == 0 && xt_lat && (u.pn == 4 || u.pn == 5)) {
            const bool lat = u.pm < MLAT / 256;
            const int b = lat ? (u.pm >> 4) : (u.pm - MLAT / 256);
            const int nseq = lat ? DPITCH : CTX;
            bf16_t* XC = lat ? xt_lat : xt_ctx; bf16_t* XS = XC + (size_t)1280 * nseq;
            const int tok0 = (lat ? (u.pm & 15) * 256 : 0) + wr * 64 + fr;
            float rv[2][4];
#pragma unroll
            for (int ai = 0; ai < 2; ++ai)
#pragma unroll
                for (int m = 0; m < 4; ++m) rv[ai][m] = rs ? rs[row0 + ai * HALF + m * 16] : 1.f;
#pragma unroll
            for (int bj = 0; bj < 2; ++bj) {
                const int n0 = (u.pn - 4) * BM + bj * HALF + cl0, g = n0 >> 7, j0 = n0 & 127;
                f32x4 bz[2]; bz[0] = (f32x4){0.f, 0.f, 0.f, 0.f}; bz[1] = bz[0];
                if (rs) { const float* bp = bias + (size_t)(lat ? b : 4) * NIN + u.pn * BM + bj * HALF + cl0; bz[0] = *(const f32x4*)bp; bz[1] = *(const f32x4*)(bp + 4); }
                bf16_t* base = (j0 < 64 ? XC + (size_t)(b * 256 + g * 64 + j0) * nseq : XS + (size_t)(b * 256 + g * 64 + (j0 - 64)) * nseq) + tok0;
                bf16_t* nyq = XC + (size_t)(1024 + b * 4 + g) * nseq + tok0;
#pragma unroll
                for (int ai = 0; ai < 2; ++ai)
#pragma unroll
                    for (int m = 0; m < 4; ++m) { const int to = ai * HALF + m * 16;
#pragma unroll
                        for (int n = 0; n < 2; ++n)
#pragma unroll
                            for (int e = 0; e < 4; ++e) base[(size_t)(4 * n + e) * nseq + to] = (bf16_t)f2bf(acc[ai][bj][m][n][e] * rv[ai][m] + bz[n][e]);
                        if (j0 == 64) nyq[to] = (bf16_t)f2bf(acc[ai][bj][m][0][0] * rv[ai][m] + bz[0][0]); }
            }
        } else if (kind == 0) {
            const int dcol = (u.pn < csplit ? u.pn * cmul + cadd : cadd2) + cl0;
            f32x4 bz[2][2];
#pragma unroll
            for (int bj = 0; bj < 2; ++bj) { bz[bj][0] = (f32x4){0.f, 0.f, 0.f, 0.f}; bz[bj][1] = bz[bj][0]; }
            if (rs) { const float* bp = bias + (size_t)(row0 < MLAT ? (row0 >> 12) : 4) * NIN + dcol;
#pragma unroll
                for (int bj = 0; bj < 2; ++bj) { bz[bj][0] = *(const f32x4*)(bp + bj * HALF); bz[bj][1] = *(const f32x4*)(bp + bj * HALF + 4); } }
            const bool wsq = sqo != nullptr && ((u.pn >= 8 && u.pn < 12) || (u.pn == 12 && wc < 2));
#pragma unroll
            for (int ai = 0; ai < 2; ++ai) {
                float rr4[4];
                if (sq8) {
                    float t[4][8];
#pragma unroll
                    for (int m = 0; m < 4; ++m)
#pragma unroll
                        for (int k = 0; k < 8; ++k) t[m][k] = sq8[(size_t)k * MT + (rowoff + row0 + ai * HALF + m * 16)];
#pragma unroll
                    for (int m = 0; m < 4; ++m) rr4[m] = 1.0f / sqrtf((((t[m][0] + t[m][1]) + (t[m][2] + t[m][3])) + ((t[m][4] + t[m][5]) + (t[m][6] + t[m][7]))) * (1.f / 512.f) + EPS);
                } else {
#pragma unroll
                    for (int m = 0; m < 4; ++m) rr4[m] = rs ? rs[rowoff + row0 + ai * HALF + m * 16] : 1.f;
                }
#pragma unroll
                for (int m = 0; m < 4; ++m) { const int rk = rowoff + row0 + ai * HALF + m * 16; bf16_t* rowp = O + (size_t)rk * ldc + dcol;
                    bf16_t* mirp = O + (size_t)(SEQ - rk) * ldc + dcol; const unsigned sx = (mirror < 0) ? 0x80008000u : 0u;
                    const float rr = rr4[m]; float sq = 0.f;
#pragma unroll
                    for (int bj = 0; bj < 2; ++bj) { const f32x4 v0 = acc[ai][bj][m][0] * rr + bz[bj][0], v1 = acc[ai][bj][m][1] * rr + bz[bj][1];
                        u32x4 w; w.x = cvt_pk_bf16(v0[0], v0[1]); w.y = cvt_pk_bf16(v0[2], v0[3]); w.z = cvt_pk_bf16(v1[0], v1[1]); w.w = cvt_pk_bf16(v1[2], v1[3]);
                        const bool st = dcol + bj * HALF < DIN && !(mirror > 0 && u.pn >= csplit && cl0 + bj * HALF >= 16);
                        if (st) *(u32x4*)(rowp + bj * HALF) = w;
                        if (st && mirror != 0 && rk > 0) { u32x4 wm; wm.x = w.x ^ sx; wm.y = w.y ^ sx; wm.z = w.z ^ sx; wm.w = w.w ^ sx; *(u32x4*)(mirp + bj * HALF) = wm; }
                        if (wsq && (u.pn != 12 || bj == 0)) sq += ((v0[0] * v0[0] + v0[1] * v0[1]) + (v0[2] * v0[2] + v0[3] * v0[3])) + ((v1[0] * v1[0] + v1[1] * v1[1]) + (v1[2] * v1[2] + v1[3] * v1[3])); }
                    if (wsq) { sq += lane_xor<16>(sq);
                        { auto pr = __builtin_amdgcn_permlane32_swap(__float_as_uint(sq), __float_as_uint(sq), false, false); sq = __uint_as_float(pr[0]) + __uint_as_float(pr[1]); }
                        if (fq == 0) sqo[(size_t)((u.pn - 8) * 4 + wc) * MT + rk] = sq; } }
            }
        } else if (kind == 1) {
#pragma unroll
            for (int bj = 0; bj < 2; ++bj) {
                const int n0 = u.pn * BM + bj * HALF + cl0;
                const int g = n0 >> 7, d0 = n0 & 127;
                const f32x4 f0 = *(const f32x4*)(fw + (size_t)(g * 128 + 64) * 128 + d0), f1 = *(const f32x4*)(fw + (size_t)(g * 128 + 64) * 128 + d0 + 4);
                u32x4 gw[2][4]; unsigned short nyb[2][4];
#pragma unroll
                for (int ai = 0; ai < 2; ++ai)
#pragma unroll
                    for (int m = 0; m < 4; ++m) { const int rl = row0 + ai * HALF + m * 16; const int b = rl >> lgseq, k = rl & (nseq - 1);
                        nyb[ai][m] = NY[(size_t)k * PCSW + 2048 + b * 4 + g]; gw[ai][m] = *(const u32x4*)(P + ((size_t)rowoff + rl) * NIN + OFF_FGATE + n0); }
                asm volatile("" ::: "memory");
#pragma unroll
                for (int ai = 0; ai < 2; ++ai)
#pragma unroll
                    for (int m = 0; m < 4; ++m) {
                        const size_t R = (size_t)rowoff + row0 + ai * HALF + m * 16;
                        const float ny = bf2f(nyb[ai][m]);
                        float gt[8]; unpack8(gw[ai][m], gt);
                        const f32x4 v0 = acc[ai][bj][m][0], v1 = acc[ai][bj][m][1];
                        float o[8];
#pragma unroll
                        for (int e = 0; e < 4; ++e) { o[e] = (v0[e] + ny * f0[e]) * siluf(gt[e]); o[4 + e] = (v1[e] + ny * f1[e]) * siluf(gt[4 + e]); }
                        u32x4 w; w.x = cvt_pk_bf16(o[0], o[1]); w.y = cvt_pk_bf16(o[2], o[3]); w.z = cvt_pk_bf16(o[4], o[5]); w.w = cvt_pk_bf16(o[6], o[7]);
                        *(u32x4*)(O + R * ldc + 512 + n0) = w;
                    }
                asm volatile("" ::: "memory");
            }
        } else if (kind == 3) {
#pragma unroll
            for (int ai = 0; ai < 2; ++ai)
#pragma unroll
                for (int m = 0; m < 4; ++m) { float* xo = out_ctx + (size_t)(row0 + ai * HALF + m * 16) * DM + u.pn * BM + cl0;
#pragma unroll
                    for (int bj = 0; bj < 2; ++bj)
#pragma unroll
                        for (int n = 0; n < 2; ++n) *(f32x4*)(xo + bj * HALF + 4 * n) = acc[ai][bj][m][n]; }
        } else {
            const int R0 = row0;
            const bool lat = R0 < MLAT;
            const int mr = lat ? (R0 >> 12) : 4;
            const float* xi0 = (lat ? xin_lat + (size_t)R0 * DM : xin_ctx + (size_t)(R0 - MLAT) * DM) + u.pn * BM + cl0;
            float* xo0 = (lat ? out_lat + (size_t)R0 * DM : out_ctx + (size_t)(R0 - MLAT) * DM) + u.pn * BM + cl0;
            const float* gp = mods + (size_t)mr * 6144 + 4096 + u.pn * BM + cl0;
            f32x4 gv[2][2], cf[2][2];
#pragma unroll
            for (int bj = 0; bj < 2; ++bj)
#pragma unroll
                for (int n = 0; n < 2; ++n) { gv[bj][n] = *(const f32x4*)(gp + bj * HALF + 4 * n); cf[bj][n] = gv[bj][n]; }
            if (xb || xbr) { const float* n1 = nw1 + u.pn * BM + cl0; const float* s1 = sc1 + (size_t)mr * 6144 + u.pn * BM + cl0;
#pragma unroll
                for (int bj = 0; bj < 2; ++bj)
#pragma unroll
                    for (int n = 0; n < 2; ++n) cf[bj][n] = *(const f32x4*)(n1 + bj * HALF + 4 * n) * (*(const f32x4*)(s1 + bj * HALF + 4 * n) + 1.f); }
            if (xb) {
#pragma unroll
                for (int ch = 0; ch < 3; ++ch) {
                    constexpr int NCH = 3;
                    f32x4 xv[NCH][2][2];
#pragma unroll
                    for (int mm = 0; mm < NCH; ++mm) { const int q = ch * NCH + mm; if (q < 8) { const int ai = q >> 2, m = q & 3;
#pragma unroll
                            for (int bj = 0; bj < 2; ++bj)
#pragma unroll
                                for (int n = 0; n < 2; ++n) xv[mm][bj][n] = *(const f32x4*)(xi0 + (size_t)(ai * HALF + m * 16) * DM + bj * HALF + 4 * n); } }
                    asm volatile("" ::: "memory");
#pragma unroll
                    for (int mm = 0; mm < NCH; ++mm) { const int q = ch * NCH + mm; if (q < 8) { const int ai = q >> 2, m = q & 3; const size_t R = (size_t)(R0 + ai * HALF + m * 16); float sq = 0.f;
#pragma unroll
                            for (int bj = 0; bj < 2; ++bj) { const f32x4 o0 = xv[mm][bj][0] + gv[bj][0] * acc[ai][bj][m][0], o1 = xv[mm][bj][1] + gv[bj][1] * acc[ai][bj][m][1];
                                sq += ((o0[0] * o0[0] + o0[1] * o0[1]) + (o0[2] * o0[2] + o0[3] * o0[3])) + ((o1[0] * o1[0] + o1[1] * o1[1]) + (o1[2] * o1[2] + o1[3] * o1[3]));
                                const f32x4 h0 = o0 * cf[bj][0], h1 = o1 * cf[bj][1];
                                u32x4 w; w.x = cvt_pk_bf16(h0[0], h0[1]); w.y = cvt_pk_bf16(h0[2], h0[3]); w.z = cvt_pk_bf16(h1[0], h1[1]); w.w = cvt_pk_bf16(h1[2], h1[3]);
                                *(u32x4*)(xb + R * DM + u.pn * BM + cl0 + bj * HALF) = w; }
                            sq += lane_xor<16>(sq);
                            { auto pr = __builtin_amdgcn_permlane32_swap(__float_as_uint(sq), __float_as_uint(sq), false, false); sq = __uint_as_float(pr[0]) + __uint_as_float(pr[1]); }
                            if (fq == 0) ss[(size_t)(u.pn * 4 + wc) * MLAT + R] = sq; } }
                    asm volatile("" ::: "memory");
                }
            } else {
                f32x4 rcf[2][2];
#pragma unroll
                for (int bj = 0; bj < 2; ++bj)
#pragma unroll
                    for (int n = 0; n < 2; ++n)
#pragma unroll
                        for (int e = 0; e < 4; ++e) rcf[bj][n][e] = cf[bj][n][e] != 0.f ? __builtin_amdgcn_rcpf(cf[bj][n][e]) : 0.f;
                const bf16_t* xr0 = xbr + (size_t)R0 * DM + u.pn * BM + cl0;
#pragma unroll
            for (int ai = 0; ai < 2; ++ai) {
                u32x4 xw[4][2];
#pragma unroll
                for (int m = 0; m < 4; ++m)
#pragma unroll
                    for (int bj = 0; bj < 2; ++bj) xw[m][bj] = *(const u32x4*)(xr0 + (size_t)(ai * HALF + m * 16) * DM + bj * HALF);
                asm volatile("" ::: "memory");
#pragma unroll
                for (int m = 0; m < 4; ++m)
#pragma unroll
                    for (int bj = 0; bj < 2; ++bj) { float xf[8]; unpack8(xw[m][bj], xf);
                        const f32x4 x0 = {xf[0], xf[1], xf[2], xf[3]}, x1 = {xf[4], xf[5], xf[6], xf[7]};
                        *(f32x4*)(xo0 + (size_t)(ai * HALF + m * 16) * DM + bj * HALF) = x0 * rcf[bj][0] + gv[bj][0] * acc[ai][bj][m][0];
                        *(f32x4*)(xo0 + (size_t)(ai * HALF + m * 16) * DM + bj * HALF + 4) = x1 * rcf[bj][1] + gv[bj][1] * acc[ai][bj][m][1]; }
                asm volatile("" ::: "memory");
            }
            }
        }
    }
};

struct Epi4 {
    static constexpr bool PERM = true, AFTER_DRAIN = false;
    Epi e;
    __device__ __forceinline__ void prefetch(const Unit&, int, PG8_LAS unsigned char*) const {}
    __device__ __forceinline__ void operator()(f32x4 (&acc)[2][2][4][2], const Unit& u, int wr, int wc, int fr, int fq) const { e.k4(acc, u, wr, wc, fr, fq); }
};

template <class Epi, class Sched, bool ALIGN_EPI = false, bool SP2 = false>
__device__ __forceinline__ void gemm_phase(PG8_LAS unsigned char* lds, const Gemm g, const Sched& S, const Epi& E, int wave_) {
    int tid_ = wave_ * 64 + lane_id(); asm volatile("" : "+v"(tid_));
    const int tid = tid_, wid = __builtin_amdgcn_readfirstlane(tid >> 6), lane = tid & 63, wr = wid >> 2, wc = wid & 3, fr = lane & 15, fq = lane >> 4;
    const int K = g.K, nt = K / BK;
    unsigned voffA[2], voffB[2];
#pragma unroll
    for (int i = 0; i < 2; ++i) { int R, C; stage_rc(tid * 16 + i * 8192, R, C); const int Rb = Epi::PERM ? ((R & ~31) + perm32(R & 31)) : R;
        voffA[i] = (unsigned)(R * g.lda + C) * 2u; voffB[i] = (unsigned)(Rb * g.ldb + C) * 2u; }
    const size_t kstep = (size_t)(BK * 2);
    const size_t hA = (size_t)HALF * g.lda * 2, hB = (size_t)HALF * g.ldb * 2;
    const unsigned ldsw = (unsigned)wid * 1024u;
    const int aoff = lds_byte(wr * 64 + fr, fq * 8), boff = lds_byte(wc * 32 + fr, fq * 8);
#define PG8_TA(pm) ((const char*)g.A + ((size_t)((pm) % g.mper) * 2 * hA + (size_t)((pm) / g.mper) * (size_t)g.abatch * 2))
#define PG8_TB(pn) ((const char*)g.Bt + (size_t)(pn) * 2 * hB)
#define PG8_SA(b, h) (((b) * 2 + (h)) * HTB)
#define PG8_SB(b, h) ((4 + (b) * 2 + (h)) * HTB)
#define PG8_STAGE(bufoff, gbase, voff) do { _Pragma("unroll") for (int _i = 0; _i < 2; ++_i) \
        __builtin_amdgcn_global_load_lds((const unsigned*)((const char*)(gbase) + (voff)[_i]), (PG8_LAS unsigned*)(lds + (bufoff) + ldsw + _i * 8192), 16, 0, 0); } while (0)
#define PG8_LDA(dst, b, h) do { _Pragma("unroll") for (int m = 0; m < 4; ++m) _Pragma("unroll") for (int k = 0; k < 2; ++k) dst[m][k] = *(const PG8_LAS bf16x8*)(lds + PG8_SA(b, h) + aoff + m * 2048 + k * 1024); } while (0)
#define PG8_LDB(dst, b, h) do { _Pragma("unroll") for (int n = 0; n < 2; ++n) _Pragma("unroll") for (int k = 0; k < 2; ++k) dst[n][k] = *(const PG8_LAS bf16x8*)(lds + PG8_SB(b, h) + boff + n * 2048 + k * 1024); } while (0)
#define PG8_MMA(ai, bj, At, Bt) do { __builtin_amdgcn_s_setprio(1); _Pragma("unroll") for (int m = 0; m < 4; ++m) _Pragma("unroll") for (int n = 0; n < 2; ++n) _Pragma("unroll") for (int k = 0; k < 2; ++k) \
        acc[ai][bj][m][n] = __builtin_amdgcn_mfma_f32_16x16x32_bf16(Bt[n][k], At[m][k], acc[ai][bj][m][n], 0, 0, 0); __builtin_amdgcn_s_setprio(0); } while (0)
#define PG8_WAIT_V(n) asm volatile("s_waitcnt vmcnt(" #n ")" ::: "memory")
#define PG8_WAIT_L(n) asm volatile("s_waitcnt lgkmcnt(" #n ")" ::: "memory")
#define PG8_BAR __builtin_amdgcn_s_barrier()
#define PG8_SCHED __builtin_amdgcn_sched_barrier(0)
    Unit cur, nxt; int ui = 0;
    if (!S.next(0, cur)) return;
    f32x4 acc[2][2][4][2];
#pragma unroll
    for (int a = 0; a < 2; ++a)
#pragma unroll
        for (int b = 0; b < 2; ++b)
#pragma unroll
            for (int m = 0; m < 4; ++m)
#pragma unroll
                for (int n = 0; n < 2; ++n) acc[a][b][m][n] = (f32x4){0.f, 0.f, 0.f, 0.f};
    bf16x8 At[4][2], B0[2][2], B1[2][2];
    const char* cA = PG8_TA(cur.pm); const char* cB = PG8_TB(cur.pn);
    if constexpr (SP2) {
        PG8_STAGE(PG8_SB(0, 0), cB, voffB); PG8_STAGE(PG8_SB(0, 1), cB + hB, voffB); PG8_STAGE(PG8_SA(0, 0), cA, voffA); PG8_STAGE(PG8_SA(0, 1), cA + hA, voffA);
        if (wr == 1) PG8_BAR;
        PG8_WAIT_V(2); PG8_BAR;
        PG8_STAGE(PG8_SB(1, 0), cB + kstep, voffB); PG8_STAGE(PG8_SA(1, 0), cA + kstep, voffA); PG8_STAGE(PG8_SB(1, 1), cB + hB + kstep, voffB);
        PG8_WAIT_V(6); PG8_BAR;
    } else {
        PG8_STAGE(PG8_SB(0, 0), cB, voffB); PG8_STAGE(PG8_SA(0, 0), cA, voffA); PG8_STAGE(PG8_SB(0, 1), cB + hB, voffB); PG8_STAGE(PG8_SA(0, 1), cA + hA, voffA);
        if (wr == 1) PG8_BAR;
        PG8_WAIT_V(4); PG8_BAR;
        PG8_STAGE(PG8_SB(1, 0), cB + kstep, voffB); PG8_STAGE(PG8_SA(1, 0), cA + kstep, voffA); PG8_STAGE(PG8_SB(1, 1), cB + hB + kstep, voffB);
        PG8_WAIT_V(6); PG8_BAR;
    }
    for (;;) {
        const bool has_next = S.next(ui + 1, nxt);
        const char* nA = has_next ? PG8_TA(nxt.pm) : cA; const char* nB = has_next ? PG8_TB(nxt.pn) : cB;
        for (int t = 0; t < nt; t += 2) {
            const bool last = (t == nt - 2);
            const char* a1 = cA + (size_t)(t + 1) * kstep;
            const char* a2 = last ? nA : cA + (size_t)(t + 2) * kstep; const char* b2 = last ? nB : cB + (size_t)(t + 2) * kstep;
            const char* a3 = a2 + kstep; const char* b3 = b2 + kstep;
            if constexpr (SP2) {
            PG8_LDB(B0, 0, 0); PG8_LDB(B1, 0, 1); PG8_SCHED; PG8_LDA(At, 0, 0); PG8_STAGE(PG8_SA(1, 1), a1 + hA, voffA);
            PG8_WAIT_V(8); PG8_WAIT_L(0); PG8_BAR; PG8_MMA(0, 0, At, B0); PG8_MMA(0, 1, At, B1); PG8_BAR; PG8_SCHED;
            PG8_LDA(At, 0, 1); PG8_STAGE(PG8_SB(0, 0), b2, voffB); PG8_STAGE(PG8_SB(0, 1), b2 + hB, voffB); PG8_STAGE(PG8_SA(0, 0), a2, voffA);
            PG8_WAIT_V(8); PG8_WAIT_L(0); PG8_BAR; PG8_MMA(1, 0, At, B0); PG8_MMA(1, 1, At, B1); PG8_BAR; PG8_SCHED;
            PG8_LDB(B0, 1, 0); PG8_LDB(B1, 1, 1); PG8_SCHED; PG8_LDA(At, 1, 0); PG8_STAGE(PG8_SA(0, 1), a2 + hA, voffA);
            PG8_WAIT_V(8); PG8_WAIT_L(0); PG8_BAR; PG8_MMA(0, 0, At, B0); PG8_MMA(0, 1, At, B1); PG8_BAR; PG8_SCHED;
            PG8_LDA(At, 1, 1); PG8_STAGE(PG8_SB(1, 0), b3, voffB); PG8_STAGE(PG8_SB(1, 1), b3 + hB, voffB); PG8_STAGE(PG8_SA(1, 0), a3, voffA);
            PG8_WAIT_V(8); PG8_WAIT_L(0); PG8_BAR; PG8_MMA(1, 0, At, B0); PG8_MMA(1, 1, At, B1); PG8_BAR; PG8_SCHED;
            } else {
            PG8_LDB(B0, 0, 0); PG8_SCHED; PG8_LDA(At, 0, 0); PG8_STAGE(PG8_SA(1, 1), a1 + hA, voffA);
            PG8_WAIT_L(8); PG8_BAR; PG8_WAIT_L(0); PG8_MMA(0, 0, At, B0); PG8_BAR; PG8_SCHED;
            PG8_LDB(B1, 0, 1); PG8_STAGE(PG8_SB(0, 0), b2, voffB);
            PG8_BAR; PG8_WAIT_L(0); PG8_MMA(0, 1, At, B1); PG8_BAR;
            PG8_LDA(At, 0, 1); PG8_STAGE(PG8_SA(0, 0), a2, voffA);
            PG8_BAR; PG8_WAIT_L(0); PG8_MMA(1, 0, At, B0); PG8_BAR; PG8_SCHED;
            PG8_STAGE(PG8_SB(0, 1), b2 + hB, voffB);
            PG8_WAIT_V(6); PG8_BAR; PG8_MMA(1, 1, At, B1); PG8_BAR;
            PG8_LDB(B0, 1, 0); PG8_SCHED; PG8_LDA(At, 1, 0); PG8_STAGE(PG8_SA(0, 1), a2 + hA, voffA);
            PG8_WAIT_L(8); PG8_BAR; PG8_WAIT_L(0); PG8_MMA(0, 0, At, B0); PG8_BAR; PG8_SCHED;
            PG8_LDB(B1, 1, 1); PG8_STAGE(PG8_SB(1, 0), b3, voffB);
            PG8_BAR; PG8_WAIT_L(0); PG8_MMA(0, 1, At, B1); PG8_BAR;
            PG8_LDA(At, 1, 1); PG8_STAGE(PG8_SA(1, 0), a3, voffA);
            PG8_BAR; PG8_WAIT_L(0); PG8_MMA(1, 0, At, B0); PG8_BAR; PG8_SCHED;
            PG8_STAGE(PG8_SB(1, 1), b3 + hB, voffB);
            PG8_WAIT_V(6); PG8_BAR; PG8_MMA(1, 1, At, B1); PG8_BAR;
            }
        }
        if constexpr (ALIGN_EPI) { if (wr == 0) PG8_BAR; }
        { int te_ = wave_ * 64 + lane_id(); asm volatile("" : "+v"(te_));
          E(acc, cur, wr, wc, te_ & 15, (te_ & 63) >> 4); }
        if (!has_next) break;
#pragma unroll
        for (int a = 0; a < 2; ++a)
#pragma unroll
            for (int b = 0; b < 2; ++b)
#pragma unroll
                for (int m = 0; m < 4; ++m)
#pragma unroll
                    for (int n = 0; n < 2; ++n) acc[a][b][m][n] = (f32x4){0.f, 0.f, 0.f, 0.f};
        cur = nxt; cA = nA; cB = nB; ++ui;
        if constexpr (ALIGN_EPI) { if (wr == 1) PG8_BAR; }
    }
    PG8_WAIT_V(0);
    if constexpr (!ALIGN_EPI) { if (wr == 0) PG8_BAR; }
    PG8_BAR;
#undef PG8_TA
#undef PG8_TB
#undef PG8_SA
#undef PG8_SB
#undef PG8_STAGE
#undef PG8_LDA
#undef PG8_LDB
#undef PG8_MMA
#undef PG8_WAIT_V
#undef PG8_WAIT_L
#undef PG8_BAR
#undef PG8_SCHED
}
}

namespace att {
constexpr int NW = 8, QBLK = 32, KVBLK = 64;
constexpr float SCALE = 0.07216878364870322f;
#ifndef ATT_SDEPTH
#define ATT_SDEPTH 1
#endif
constexpr int SDEPTH = ATT_SDEPTH;
#ifndef ATT_QKT_GRP
#define ATT_QKT_GRP 4
#endif
constexpr int QKT_GRP = ATT_QKT_GRP;
constexpr int LDQ = NQ, LDKK = NQ, LDV = NKV;
constexpr int KPITCH = 400;
constexpr int SHM_V = KVBLK * 128 * 2, SHM_K = KVBLK * KPITCH;
constexpr int SHM_QR = 2 * SHM_V + 2 * SHM_K + NW * 64 * 4;
#ifndef ATT_NQR
#define ATT_NQR 6
#endif
constexpr int NQR = ATT_NQR, QLB = (12 - NQR) * 1024;
constexpr int SHM_ATTN = SHM_QR + NW * QLB;
#define KSWZ(row, colB) ((row) * KPITCH + (colB))
#define SBAR() __builtin_amdgcn_sched_barrier(0)
__device__ __forceinline__ int crow(int r, int hi) { return (r & 3) + 8 * (r >> 2) + 4 * hi; }
__device__ __forceinline__ unsigned cvtpk(float lo, float hi) { unsigned r; asm volatile("v_cvt_pk_bf16_f32 %0, %1, %2" : "=v"(r) : "v"(lo), "v"(hi)); return r; }

__device__ __forceinline__ void partialSM(f32x16& p0, f32x16& p1, float) {
#pragma unroll
    for (int r = 0; r < 16; ++r) p0[r] = __builtin_amdgcn_exp2f(p0[r]);
}
__device__ __forceinline__ void finishSM(f32x16& p0, f32x16& p1, float& l_reg, bf16x8& pa0, bf16x8& pa1, bf16x8& pa2, bf16x8& pa3) {
#pragma unroll
    for (int r = 0; r < 16; ++r) p1[r] = __builtin_amdgcn_exp2f(p1[r]);
    float s0 = p0[0] + p1[0], s1 = p0[1] + p1[1], s2 = p0[2] + p1[2], s3 = p0[3] + p1[3];
#pragma unroll
    for (int r = 4; r < 16; r += 4) { s0 += p0[r] + p1[r]; s1 += p0[r + 1] + p1[r + 1]; s2 += p0[r + 2] + p1[r + 2]; s3 += p0[r + 3] + p1[r + 3]; }
    l_reg += (s0 + s1) + (s2 + s3);
#define PK4(P, BASE, OUT) do { unsigned a0 = cvtpk(P[BASE + 0], P[BASE + 1]), a1 = cvtpk(P[BASE + 2], P[BASE + 3]);   \
    unsigned b0 = cvtpk(P[BASE + 4], P[BASE + 5]), b1 = cvtpk(P[BASE + 6], P[BASE + 7]);                              \
    auto r0 = __builtin_amdgcn_permlane32_swap(a0, b0, false, false); auto r1 = __builtin_amdgcn_permlane32_swap(a1, b1, false, false); \
    u32x4 w = {r0[0], r1[0], r0[1], r1[1]}; OUT = *reinterpret_cast<bf16x8*>(&w); } while (0)
    PK4(p0, 0, pa0); PK4(p0, 8, pa1); PK4(p1, 0, pa2); PK4(p1, 8, pa3);
#undef PK4
}
template <int OFF> __device__ __forceinline__ void lds_rd128(bf16x8& d, unsigned a) { asm volatile("ds_read_b128 %0, %1 offset:%2" : "=v"(d) : "v"(a), "i"(OFF) : "memory"); }
template <int N> __device__ __forceinline__ void lds_wait2(bf16x8& a, bf16x8& b) { asm volatile("s_waitcnt lgkmcnt(%2)" : "+v"(a), "+v"(b) : "i"(N) : "memory"); }
template <int N> __device__ __forceinline__ void lds_wait3(bf16x8& a, bf16x8& b, bf16x8& c) { asm volatile("s_waitcnt lgkmcnt(%3)" : "+v"(a), "+v"(b), "+v"(c) : "i"(N) : "memory"); }
constexpr int qkt_cnt(int d0) { return (d0 > 11) ? 0 : ((d0 >= NQR) ? 3 : 2); }
template <int KOFF, int D0> struct QktStep {
    static __device__ __forceinline__ void load(bf16x8& k0, bf16x8& k1, bf16x8& q, unsigned kad, unsigned qa) {
        lds_rd128<KOFF + D0 * 32>(k0, kad); lds_rd128<KOFF + 32 * KPITCH + D0 * 32>(k1, kad);
        if constexpr (D0 >= NQR) lds_rd128<(D0 - NQR) * 1024>(q, qa);
    }
};
struct DmaPlan { const char* kb; const char* vb; LAS unsigned char* kdst; LAS unsigned char* vdst; unsigned koff0, koff1, koff2, voff0, voff1; int wave; bool dok, dov; };
template <int I> __device__ __forceinline__ void dma_piece(const DmaPlan& d) {
    if constexpr (I < 3) { if (d.dok) __builtin_amdgcn_global_load_lds((const unsigned*)(d.kb + (I == 0 ? d.koff0 : I == 1 ? d.koff1 : d.koff2)), (LAS unsigned*)(d.kdst + (d.wave + 8 * I) * 1024), 16, 0, 0); }
    else if constexpr (I == 3) { if (d.dok && d.wave == 0) { const int p_ = 24 * 64 + lane_id(), r_ = p_ / 25, c_ = p_ - r_ * 25;
            __builtin_amdgcn_global_load_lds((const unsigned*)(d.kb + (unsigned)(r_ * LDKK * 2 + c_ * 16)), (LAS unsigned*)(d.kdst + 24 * 1024), 16, 0, 0); } }
    else { if (d.dov) __builtin_amdgcn_global_load_lds((const unsigned*)(d.vb + (I == 4 ? d.voff0 : d.voff1)), (LAS unsigned*)(d.vdst + (d.wave * 2 + (I - 4)) * 1024), 16, 0, 0); }
}
template <int KOFF, bool FIN, bool DMA> __device__ __forceinline__ void qkt(f32x16& p0, f32x16& p1, const bf16x8* qr, unsigned kad, unsigned qa_in, float negMC,
                                                              f32x16& x0, f32x16& x1, float& l_reg, bf16x8& pa0, bf16x8& pa1, bf16x8& pa2, bf16x8& pa3, const DmaPlan& dm) {
    p0 = f32x16{}; p1 = f32x16{};
    unsigned qa = qa_in; asm volatile("" : "+v"(qa));
    bf16x8 ka[2], kb[2], qf[2];
    float s0 = 0.f, s1 = 0.f, s2 = 0.f, s3 = 0.f;
#define QL(S, D) QktStep<KOFF, D>::load(ka[S], kb[S], qf[S], kad, qa)
#define QM(S, D) do { if constexpr (D >= NQR) lds_wait3<qkt_cnt(D + 1)>(ka[S], kb[S], qf[S]); else lds_wait2<qkt_cnt(D + 1)>(ka[S], kb[S]); \
        const bf16x8 qq = (D < NQR) ? qr[D < NQR ? D : 0] : qf[S]; \
        p0 = __builtin_amdgcn_mfma_f32_32x32x16_bf16(ka[S], qq, p0, 0, 0, 0); p1 = __builtin_amdgcn_mfma_f32_32x32x16_bf16(kb[S], qq, p1, 0, 0, 0); } while (0)
#define PK4(P, BASE, OUT) do { if constexpr (FIN) { unsigned a0 = cvtpk(P[BASE + 0], P[BASE + 1]), a1 = cvtpk(P[BASE + 2], P[BASE + 3]);   \
    unsigned b0 = cvtpk(P[BASE + 4], P[BASE + 5]), b1 = cvtpk(P[BASE + 6], P[BASE + 7]);                              \
    auto r0 = __builtin_amdgcn_permlane32_swap(a0, b0, false, false); auto r1 = __builtin_amdgcn_permlane32_swap(a1, b1, false, false); \
    u32x4 w = {r0[0], r1[0], r0[1], r1[1]}; OUT = *reinterpret_cast<bf16x8*>(&w); } } while (0)
#define EX4(B) do { if constexpr (FIN) { x1[B] = __builtin_amdgcn_exp2f(x1[B]); x1[B + 1] = __builtin_amdgcn_exp2f(x1[B + 1]); x1[B + 2] = __builtin_amdgcn_exp2f(x1[B + 2]); x1[B + 3] = __builtin_amdgcn_exp2f(x1[B + 3]); } } while (0)
#define SUM8(X, B) do { if constexpr (FIN) { s0 += X[B] + X[B + 4]; s1 += X[B + 1] + X[B + 5]; s2 += X[B + 2] + X[B + 6]; s3 += X[B + 3] + X[B + 7]; } } while (0)
    QL(0, 0); QL(1, 1);
    QM(0, 0); QL(0, 2);                            if constexpr (DMA) dma_piece<0>(dm);
    QM(1, 1); QL(1, 3);                            if constexpr (DMA) dma_piece<1>(dm);
    QM(0, 2); QL(0, 4);  EX4(0); SUM8(x0, 0);      if constexpr (DMA) dma_piece<2>(dm);
    QM(1, 3); QL(1, 5);  EX4(4); SUM8(x0, 8);      if constexpr (DMA) dma_piece<3>(dm);
    QM(0, 4); QL(0, 6);  EX4(8); SUM8(x1, 0);      if constexpr (DMA) dma_piece<4>(dm);
    QM(1, 5); QL(1, 7);  EX4(12);                  if constexpr (DMA) dma_piece<5>(dm);
    QM(0, 6); QL(0, 8);  SUM8(x1, 8); PK4(x0, 0, pa0);
    QM(1, 7); QL(1, 9);  PK4(x0, 8, pa1);
    QM(0, 8); QL(0, 10); PK4(x1, 0, pa2);
    QM(1, 9); QL(1, 11); PK4(x1, 8, pa3);
    QM(0, 10); if constexpr (FIN) l_reg += (s0 + s1) + (s2 + s3);
    QM(1, 11);
#undef QL
#undef QM
#undef PK4
#undef EX4
#undef SUM8
}
__device__ __forceinline__ int v_st(int k, int c) { const int kk = (k & ~0xC) | ((k & 4) << 1) | ((k & 8) >> 1); return ((kk >> 3) * 4 + (c >> 5)) * 512 + ((kk & 7) * 32 + (c & 31)) * 2; }
__device__ __forceinline__ int v_rd_base(int lane) { return ((lane & 3) << 3) | (((lane >> 2) & 3) << 6) | (((lane >> 4) & 1) << 5) | (((lane >> 5) & 1) << 8); }
constexpr int v_rd_off(int d0, int ks, int half) { return d0 * 512 + ks * 4096 + half * 2048; }
template <int OFF> __device__ __forceinline__ s16x4 tr_read(int vb) {
    s16x4 r; asm volatile("ds_read_b64_tr_b16 %0, %1 offset:%2" : "=&v"(r) : "v"(vb), "i"(OFF) : "memory"); return r;
}
template <int D0> __device__ __forceinline__ void pv_one(f32x16& od, int vb, bf16x8 pa0, bf16x8 pa1, bf16x8 pa2, bf16x8 pa3) {
    const s16x4 l0 = tr_read<v_rd_off(D0, 0, 0)>(vb), h0 = tr_read<v_rd_off(D0, 0, 1)>(vb), l1 = tr_read<v_rd_off(D0, 1, 0)>(vb), h1 = tr_read<v_rd_off(D0, 1, 1)>(vb);
    const s16x4 l2 = tr_read<v_rd_off(D0, 2, 0)>(vb), h2 = tr_read<v_rd_off(D0, 2, 1)>(vb), l3 = tr_read<v_rd_off(D0, 3, 0)>(vb), h3 = tr_read<v_rd_off(D0, 3, 1)>(vb);
    asm volatile("s_waitcnt lgkmcnt(0)" ::: "memory"); SBAR();
#define PK(L, H) (bf16x8){L[0], L[1], L[2], L[3], H[0], H[1], H[2], H[3]}
    od = __builtin_amdgcn_mfma_f32_32x32x16_bf16(pa0, PK(l0, h0), od, 0, 0, 0);
    od = __builtin_amdgcn_mfma_f32_32x32x16_bf16(pa1, PK(l1, h1), od, 0, 0, 0);
    od = __builtin_amdgcn_mfma_f32_32x32x16_bf16(pa2, PK(l2, h2), od, 0, 0, 0);
    od = __builtin_amdgcn_mfma_f32_32x32x16_bf16(pa3, PK(l3, h3), od, 0, 0, 0);
#undef PK
}
__device__ __forceinline__ void pv_d0(f32x16* o, int vb, bf16x8 pa0, bf16x8 pa1, bf16x8 pa2, bf16x8 pa3) {
    pv_one<0>(o[0], vb, pa0, pa1, pa2, pa3); pv_one<1>(o[1], vb, pa0, pa1, pa2, pa3); pv_one<2>(o[2], vb, pa0, pa1, pa2, pa3); pv_one<3>(o[3], vb, pa0, pa1, pa2, pa3);
}
struct VFrag { s16x4 l0, h0, l1, h1, l2, h2, l3, h3; };
template <int D0> __device__ __forceinline__ void v_reads(VFrag& f, int vb) {
    f.l0 = tr_read<v_rd_off(D0, 0, 0)>(vb); f.h0 = tr_read<v_rd_off(D0, 0, 1)>(vb); f.l1 = tr_read<v_rd_off(D0, 1, 0)>(vb); f.h1 = tr_read<v_rd_off(D0, 1, 1)>(vb);
    f.l2 = tr_read<v_rd_off(D0, 2, 0)>(vb); f.h2 = tr_read<v_rd_off(D0, 2, 1)>(vb); f.l3 = tr_read<v_rd_off(D0, 3, 0)>(vb); f.h3 = tr_read<v_rd_off(D0, 3, 1)>(vb);
}
template <int N> __device__ __forceinline__ void v_wait(VFrag& f) {
    asm volatile("s_waitcnt lgkmcnt(%8)" : "+v"(f.l0), "+v"(f.h0), "+v"(f.l1), "+v"(f.h1), "+v"(f.l2), "+v"(f.h2), "+v"(f.l3), "+v"(f.h3) : "i"(N) : "memory");
}
__device__ __forceinline__ void v_mfmas(f32x16& od, const VFrag& f, bf16x8 pa0, bf16x8 pa1, bf16x8 pa2, bf16x8 pa3) {
#define PK(L, H) (bf16x8){L[0], L[1], L[2], L[3], H[0], H[1], H[2], H[3]}
    od = __builtin_amdgcn_mfma_f32_32x32x16_bf16(pa0, PK(f.l0, f.h0), od, 0, 0, 0);
    od = __builtin_amdgcn_mfma_f32_32x32x16_bf16(pa1, PK(f.l1, f.h1), od, 0, 0, 0);
    od = __builtin_amdgcn_mfma_f32_32x32x16_bf16(pa2, PK(f.l2, f.h2), od, 0, 0, 0);
    od = __builtin_amdgcn_mfma_f32_32x32x16_bf16(pa3, PK(f.l3, f.h3), od, 0, 0, 0);
#undef PK
}
template <bool EXP> __device__ __forceinline__ void pv_exp(f32x16* o, int vb, bf16x8 pa0, bf16x8 pa1, bf16x8 pa2, bf16x8 pa3, f32x16& x0) {
#define EX4(B) do { if constexpr (EXP) { x0[B] = __builtin_amdgcn_exp2f(x0[B]); x0[B + 1] = __builtin_amdgcn_exp2f(x0[B + 1]); x0[B + 2] = __builtin_amdgcn_exp2f(x0[B + 2]); x0[B + 3] = __builtin_amdgcn_exp2f(x0[B + 3]); } } while (0)
    VFrag fa, fb;
    v_reads<0>(fa, vb); v_reads<1>(fb, vb);
    v_wait<8>(fa); v_mfmas(o[0], fa, pa0, pa1, pa2, pa3); EX4(0);
    v_reads<2>(fa, vb);
    v_wait<8>(fb); v_mfmas(o[1], fb, pa0, pa1, pa2, pa3); EX4(4);
    v_reads<3>(fb, vb);
    v_wait<8>(fa); v_mfmas(o[2], fa, pa0, pa1, pa2, pa3); EX4(8);
    v_wait<0>(fb); v_mfmas(o[3], fb, pa0, pa1, pa2, pa3); EX4(12);
#undef EX4
}

__device__ __forceinline__ void attn_unit(const bf16_t* __restrict__ Qg, const bf16_t* __restrict__ KHg, const bf16_t* __restrict__ KVg, const bf16_t* __restrict__ Pg, bf16_t* __restrict__ mix,
                                          const float* __restrict__ qhw, const float* __restrict__ ropet,
                                          int h, int qrow0, int kc0, int kl0, int nct, int NT, float negMC, char* lds, int wave_) {
    int tid_ = wave_ * 64 + lane_id(); asm volatile("" : "+v"(tid_));
    const int tid = tid_, wid = tid >> 6, lane = tid & 63, r32 = lane & 31, hi = lane >> 5;
    char* V_lds = lds; char* K_lds = lds + 2 * SHM_V;
    bf16x8 qr[NQR];
    const bf16_t* Qw = Qg + (size_t)(qrow0 + wid * QBLK + r32) * LDQ + h * DQK + hi * 8;
    const unsigned qa = (unsigned)(uintptr_t)(lds + SHM_QR) + wid * QLB + lane * 16;
    {
        u32x4 qx[12]; f32x4 wr[4][2], rt[2][4];
        const bool latq = qrow0 < 16384; const int trow = (qrow0 + wid * QBLK + r32) & 4095;
#pragma unroll
        for (int d0 = 0; d0 < 12; ++d0) qx[d0] = *reinterpret_cast<const u32x4*>(Qw + d0 * 16);
#pragma unroll
        for (int i = 0; i < 4; ++i) { wr[i][0] = *(const f32x4*)(qhw + 128 + 16 * i + 8 * hi); wr[i][1] = *(const f32x4*)(qhw + 128 + 16 * i + 8 * hi + 4); }
#pragma unroll
        for (int pp = 0; pp < 2; ++pp) { const int pos = latq ? (pp == 0 ? (trow >> 6) : (trow & 63)) : 0;
            const f32x4* rp = (const f32x4*)(ropet + (size_t)(pos * 16 + 8 * hi) * 2);
#pragma unroll
            for (int q4 = 0; q4 < 4; ++q4) rt[pp][q4] = rp[q4]; }
        float ssq = 0.f;
#pragma unroll
        for (int d0 = 0; d0 < 12; ++d0) { float f[8]; unpack8(qx[d0], f);
#pragma unroll
            for (int e = 0; e < 8; ++e) ssq += f[e] * f[e]; }
        { auto pr = __builtin_amdgcn_permlane32_swap(__float_as_uint(ssq), __float_as_uint(ssq), false, false); ssq = __uint_as_float(pr[0]) + __uint_as_float(pr[1]); }
        const float rhq = (SCALE * 1.4426950408889634f) / sqrtf(ssq * (1.f / 192.f) + 1e-6f);
#pragma unroll
        for (int d0 = 0; d0 < 8; ++d0) { float f[8]; unpack8(qx[d0], f);
#pragma unroll
            for (int e = 0; e < 8; ++e) f[e] *= rhq;
            qx[d0] = pack8(f); }
#pragma unroll
        for (int pp = 0; pp < 2; ++pp) { float fa[8], fb[8]; unpack8(qx[8 + 2 * pp], fa); unpack8(qx[9 + 2 * pp], fb);
#pragma unroll
            for (int e = 0; e < 4; ++e) { fa[e] = fa[e] * rhq * wr[2 * pp][0][e]; fa[4 + e] = fa[4 + e] * rhq * wr[2 * pp][1][e]; fb[e] = fb[e] * rhq * wr[2 * pp + 1][0][e]; fb[4 + e] = fb[4 + e] * rhq * wr[2 * pp + 1][1][e]; }
            if (latq) {
#pragma unroll
                for (int q4 = 0; q4 < 4; ++q4) { const f32x4 v = rt[pp][q4];
#pragma unroll
                    for (int t2 = 0; t2 < 2; ++t2) { const int e = 2 * q4 + t2; const float cs = v[2 * t2], sn = v[2 * t2 + 1]; const float ya = fa[e], yb = fb[e];
                        fa[e] = ya * cs - yb * sn; fb[e] = yb * cs + ya * sn; } } }
            qx[8 + 2 * pp] = pack8(fa); qx[9 + 2 * pp] = pack8(fb); }
#pragma unroll
        for (int d0 = 0; d0 < NQR; ++d0) qr[d0] = __builtin_bit_cast(bf16x8, qx[d0]);
#pragma unroll
        for (int d0 = NQR; d0 < 12; ++d0) *(LAS u32x4*)(uintptr_t)(qa + (d0 - NQR) * 1024) = qx[d0];
    }
    float l_reg = 0; f32x16 o[4] = {};
    const int vb0 = (int)(uintptr_t)V_lds + v_rd_base(lane);
    const unsigned kad = (unsigned)(uintptr_t)K_lds + (unsigned)(r32 * KPITCH + hi * 16);
    const bf16_t* Kbase = KHg + h * DQK; const bf16_t* Vbase = KVg + h * 256 + 128;
    unsigned koff[3], voff[2];
#pragma unroll
    for (int i = 0; i < 3; ++i) { const int p = (wid + 8 * i) * 64 + lane, r = p / 25, c = p - r * 25; koff[i] = (unsigned)(r * LDKK * 2 + c * 16); }
#pragma unroll
    for (int i = 0; i < 2; ++i) { const int o = (wid * 2 + i) * 1024 + lane * 16, sub = o >> 9, kk = (sub >> 2) * 8 + ((o & 511) >> 6), k = (kk & ~0xC) | ((kk & 4) << 1) | ((kk & 8) >> 1), c = (sub & 3) * 32 + ((o & 63) >> 1);
        voff[i] = (unsigned)(k * LDV * 2 + c * 2); }
    LAS unsigned char* K3 = (LAS unsigned char*)(uintptr_t)(unsigned)(uintptr_t)K_lds; LAS unsigned char* V3 = (LAS unsigned char*)(uintptr_t)(unsigned)(uintptr_t)V_lds;
#define TROW(j) ((j) < nct ? kc0 + (j) * KVBLK : kl0 + ((j) - nct) * KVBLK)
#define DMA_K(j, slot) do { const char* kb_ = (const char*)Kbase + (size_t)TROW(j) * (LDKK * 2); _Pragma("unroll") for (int i_ = 0; i_ < 3; ++i_) \
    __builtin_amdgcn_global_load_lds((const unsigned*)(kb_ + koff[i_]), (LAS unsigned*)(K3 + (slot) * SHM_K + (wave_ + 8 * i_) * 1024), 16, 0, 0); \
    if (wave_ == 0) { int l4_ = lane_id(); const int p_ = 24 * 64 + l4_, r_ = p_ / 25, c_ = p_ - r_ * 25; \
        __builtin_amdgcn_global_load_lds((const unsigned*)(kb_ + (unsigned)(r_ * LDKK * 2 + c_ * 16)), (LAS unsigned*)(K3 + (slot) * SHM_K + 24 * 1024), 16, 0, 0); } } while (0)
#define DMA_V(j, slot) do { const char* vb_ = (const char*)Vbase + (size_t)TROW(j) * (LDV * 2); _Pragma("unroll") for (int i_ = 0; i_ < 2; ++i_) \
    __builtin_amdgcn_global_load_lds((const unsigned*)(vb_ + voff[i_]), (LAS unsigned*)(V3 + (slot) * SHM_V + (wave_ * 2 + i_) * 1024), 16, 0, 0); } while (0)
#define WAITBAR() do { asm volatile("s_waitcnt vmcnt(0)" ::: "memory"); __syncthreads(); } while (0)
    f32x16 pA0, pA1, pB0, pB1; bf16x8 pa0, pa1, pa2, pa3;
    DMA_K(0, 0); DMA_V(0, 0); DMA_K(1, 1);
    WAITBAR();
    const DmaPlan none0{nullptr, nullptr, K3, V3, 0u, 0u, 0u, 0u, 0u, wave_, false, false};
#define PLAN(tk, sk_, tv, sv_) DmaPlan{(const char*)Kbase + (size_t)TROW((tk) < NT ? (tk) : 0) * (LDKK * 2), (const char*)Vbase + (size_t)TROW((tv) < NT ? (tv) : 0) * (LDV * 2), \
        K3 + (sk_) * SHM_K, V3 + (sv_) * SHM_V, koff[0], koff[1], koff[2], voff[0], voff[1], wave_, (tk) < NT, (tv) < NT}
    if (wave_ < 4) {
#define STEPA(jj, ks, vs, PN0, PN1, PP0, PP1) do { const DmaPlan dp = PLAN((jj) + 1, 1 - (ks), (jj), 1 - (vs)); \
        qkt<0, true, true>(PN0, PN1, qr, kad + (ks) * SHM_K, qa, negMC, PP0, PP1, l_reg, pa0, pa1, pa2, pa3, dp); \
        pv_exp<true>(o, vb0 + (vs) * SHM_V, pa0, pa1, pa2, pa3, PN0); WAITBAR(); } while (0)
        qkt<0, false, false>(pA0, pA1, qr, kad, qa, negMC, pA0, pA1, l_reg, pa0, pa1, pa2, pa3, none0); partialSM(pA0, pA1, negMC);
        WAITBAR();
        for (int j = 1; j + 1 < NT; j += 2) { STEPA(j, 1, 0, pB0, pB1, pA0, pA1); STEPA(j + 1, 0, 1, pA0, pA1, pB0, pB1); }
        STEPA(NT - 1, 1, 0, pB0, pB1, pA0, pA1);
        finishSM(pB0, pB1, l_reg, pa0, pa1, pa2, pa3); SBAR();
        pv_d0(o, vb0 + SHM_V, pa0, pa1, pa2, pa3);
#undef STEPA
    } else {
#define STEPB(jj, ks, vs) do { const DmaPlan dp = PLAN((jj) + 1, 1 - (ks), (jj), 1 - (vs)); \
        pv_exp<false>(o, vb0 + (vs) * SHM_V, pa0, pa1, pa2, pa3, pA0); \
        qkt<0, false, true>(pA0, pA1, qr, kad + (ks) * SHM_K, qa, negMC, pA0, pA1, l_reg, pa0, pa1, pa2, pa3, dp); \
        partialSM(pA0, pA1, negMC); finishSM(pA0, pA1, l_reg, pa0, pa1, pa2, pa3); WAITBAR(); } while (0)
        qkt<0, false, false>(pA0, pA1, qr, kad, qa, negMC, pA0, pA1, l_reg, pa0, pa1, pa2, pa3, none0); partialSM(pA0, pA1, negMC);
        finishSM(pA0, pA1, l_reg, pa0, pa1, pa2, pa3);
        WAITBAR();
        for (int j = 1; j + 1 < NT; j += 2) { STEPB(j, 1, 0); STEPB(j + 1, 0, 1); }
        STEPB(NT - 1, 1, 0);
        pv_d0(o, vb0 + SHM_V, pa0, pa1, pa2, pa3);
#undef STEPB
    }
    {
        int te_ = wave_ * 64 + lane_id(); asm volatile("" : "+v"(te_));
        const int ewid = te_ >> 6, elane = te_ & 63, er32 = elane & 31, ehi = elane >> 5;
        float* eli = (float*)(lds + 2 * SHM_V + 2 * SHM_K) + ewid * 64;
        { auto rr = __builtin_amdgcn_permlane32_swap(__float_as_uint(l_reg), __float_as_uint(l_reg), false, false); l_reg = __uint_as_float(rr[0]) + __uint_as_float(rr[1]); }
        if (ehi == 0) eli[er32] = l_reg; asm volatile("s_waitcnt lgkmcnt(0)" ::: "memory");
        const size_t Rw = (size_t)(qrow0 + ewid * QBLK);
        unsigned short gtb[16][4];
#pragma unroll
        for (int r = 0; r < 16; ++r)
#pragma unroll
            for (int d0 = 0; d0 < 4; ++d0) gtb[r][d0] = Pg[(Rw + crow(r, ehi)) * NIN + OFF_MGATE + h * 128 + d0 * 32 + er32];
        asm volatile("" ::: "memory");
#pragma unroll
        for (int r = 0; r < 16; ++r) { const size_t R = Rw + crow(r, ehi); const float rl = __builtin_amdgcn_rcpf(eli[crow(r, ehi)]);
#pragma unroll
            for (int d0 = 0; d0 < 4; ++d0) { const int d = h * 128 + d0 * 32 + er32;
                mix[R * DM + 1024 + d] = (bf16_t)f2bf(o[d0][r] * rl * siluf(bf2f(gtb[r][d0]))); } }
    }
    __syncthreads();
#undef TROW
#undef DMA_K
#undef DMA_V
#undef WAITBAR
#undef PLAN
}
#undef SBAR
}

constexpr int CW_BAR = 4096, CW_FOLD = 8192;
constexpr int KFOLD = 2176;
#define XB_TMO      128
#define XB_XCNT(j)  (256  + 64 * (j))
#define XB_XSUB(j)  (1280 + 64 * (j))
#define XB_XGEN(j)  (2304 + 64 * (j))
#define XB_TOP      3328
#define XB_TOPGEN   3392
#define XCD_BAR_WORDS 3456
#define XB_SPIN_CAP (1u << 18)
__device__ __forceinline__ unsigned xb_ld(unsigned* p)              { return __hip_atomic_load(p, __ATOMIC_RELAXED, __HIP_MEMORY_SCOPE_AGENT); }
__device__ __forceinline__ unsigned xb_add(unsigned* p, unsigned v) { return __hip_atomic_fetch_add(p, v, __ATOMIC_RELAXED, __HIP_MEMORY_SCOPE_AGENT); }
__device__ __forceinline__ unsigned xb_xcc_id() { return (unsigned)__builtin_amdgcn_s_getreg((3 << 11) | 20) & 0xFu; }
#define XB_SPIN(cond, bar) do { unsigned _sp = 0; while (cond) { __builtin_amdgcn_s_sleep(1); \
    if ((++_sp & 255u) == 0u) { if (xb_ld(&(bar)[XB_TMO])) break; if (_sp > XB_SPIN_CAP) { atomicAdd(&(bar)[XB_TMO], 1u); break; } } } } while (0)
struct XcdBarrier { unsigned* bar; unsigned x; volatile LAS unsigned* st; };
__device__ __forceinline__ XcdBarrier xcd_barrier_post(unsigned* bar, volatile LAS unsigned* st, int tid) {
    XcdBarrier b; b.bar = bar; b.x = xb_xcc_id(); b.st = st;
    if (tid == 0) (void)xb_add(&bar[XB_XCNT(b.x)], 1u);
    return b;
}
__device__ __forceinline__ void xcd_barrier_complete(unsigned* bar, unsigned x, unsigned& nloc, unsigned& nx) {
    const unsigned G = gridDim.x * gridDim.y * gridDim.z;
    unsigned sum, cnt, mine, sp = 0u;
    for (;;) {
        sum = 0u; cnt = 0u; mine = 0u;
#pragma unroll
        for (unsigned j = 0; j < 16; ++j) { const unsigned c = xb_ld(&bar[XB_XCNT(j)]); sum += c; cnt += (c > 0u) ? 1u : 0u; mine = (j == x) ? c : mine; }
        if (sum == G) break;
        __builtin_amdgcn_s_sleep(1);
        if ((++sp & 255u) == 0u) { if (xb_ld(&bar[XB_TMO])) break; if (sp > XB_SPIN_CAP) { atomicAdd(&bar[XB_TMO], 1u); break; } }
    }
    nloc = mine > 0u ? mine : 1u; nx = cnt > 0u ? cnt : 1u;
}
__device__ __forceinline__ void xcd_barrier(const XcdBarrier& b, int tid) {
    asm volatile("s_waitcnt vmcnt(0)" ::: "memory");
    __syncthreads();
    if (tid == 0) {
        unsigned* bar = b.bar;
        __builtin_amdgcn_s_waitcnt(0);
        unsigned nloc = b.st[0], nx = b.st[1];
        if (nloc == 0u) { xcd_barrier_complete(bar, b.x, nloc, nx); b.st[0] = nloc; b.st[1] = nx; }
        const unsigned old = xb_add(&bar[XB_XSUB(b.x)], 1u);
        const unsigned gen = old / nloc;
        if (old + 1u == (gen + 1u) * nloc) {
            __builtin_amdgcn_fence(__ATOMIC_RELEASE, "agent");
            asm volatile("s_waitcnt vmcnt(0)" ::: "memory");
            const unsigned og = xb_add(&bar[XB_TOP], 1u);
            const unsigned tg = og / nx;
            if (og + 1u == (tg + 1u) * nx) xb_add(&bar[XB_TOPGEN], 1u);
            else XB_SPIN(xb_ld(&bar[XB_TOPGEN]) == tg, bar);
            __builtin_amdgcn_fence(__ATOMIC_ACQUIRE, "agent");
            xb_add(&bar[XB_XGEN(b.x)], 1u);
            asm volatile("s_waitcnt vmcnt(0)" ::: "memory");
        } else {
            XB_SPIN(xb_ld(&bar[XB_XGEN(b.x)]) == gen, bar);
            __builtin_amdgcn_fence(__ATOMIC_ACQUIRE, "agent");
            asm volatile("s_waitcnt vmcnt(0)" ::: "memory");
        }
    }
    __syncthreads();
}

constexpr int NWAVES = 8, NCU = 256;
constexpr int RING_BYTES = 150528, LDSCTL_OFF = RING_BYTES, MISC_OFF = LDSCTL_OFF + 320, LDS_BYTES = 151552;
static_assert(att::SHM_ATTN <= RING_BYTES && pg8::STAGE_BYTES <= RING_BYTES, "phase scratch fits the ring");

struct Args { const void* in[18]; float* out; unsigned char* ws; int ph_lo, ph_hi; };

struct Frame {
    unsigned char* lds;
    LAS unsigned char* lds3;
    int wave, vcu, G, bx;
};
__device__ __forceinline__ const void* ldptr(LAS unsigned char*, int i) {
    typedef __attribute__((address_space(4))) const unsigned long long* kaptr_t;
    kaptr_t ka = (kaptr_t)__builtin_amdgcn_kernarg_segment_ptr();
    asm volatile("" : "+s"(ka));
    return (const void*)ka[i];
}
#define FRESH_TID(name) int name = F.wave * 64 + lane_id(); asm volatile("" : "+v"(name))
#define F_IN(i) ((const float*)ldptr(F.lds3, (i)))
#define F_OUT ((float*)ldptr(F.lds3, 18))
#define F_WS ((unsigned char*)ldptr(F.lds3, 19))
#define WSP(T, off) ((T*)(ws + (off)))

__device__ __forceinline__ void transpose_item(const float* W, int K, int N, bf16_t* WT, int row_off, float* scr, int item, int lane, const float* kscale = nullptr) {
    const int nblk = N / 32, kb = item / nblk, nb = item % nblk, k0 = 64 * kb, n0 = 32 * nb;
    float wv[32];
#pragma unroll
    for (int i = 0; i < 32; ++i) { const int kk = 2 * i + (lane >> 5); wv[i] = W[(size_t)(k0 + kk) * N + n0 + (lane & 31)]; }
    if (kscale) {
#pragma unroll
        for (int i = 0; i < 32; ++i) wv[i] *= kscale[k0 + 2 * i + (lane >> 5)]; }
#pragma unroll
    for (int i = 0; i < 32; ++i) { const int kk = 2 * i + (lane >> 5); scr[kk * 33 + (lane & 31)] = wv[i]; }
    asm volatile("s_waitcnt lgkmcnt(0)" ::: "memory");
    const int c = lane & 7;
#pragma unroll
    for (int j = 0; j < 4; ++j) { const int n = (lane >> 3) + 8 * j; const float* s = scr + (8 * c) * 33 + n;
        u32x4 o; o.x = pk2(s[0 * 33], s[1 * 33]); o.y = pk2(s[2 * 33], s[3 * 33]); o.z = pk2(s[4 * 33], s[5 * 33]); o.w = pk2(s[6 * 33], s[7 * 33]);
        *(u32x4*)(WT + (size_t)(row_off + n0 + n) * K + k0 + 8 * c) = o; }
    asm volatile("s_waitcnt lgkmcnt(0)" ::: "memory");
}

__device__ __forceinline__ void phase_prep(Frame& F, int part, int wg, int nwg) {
    float* ldsf = (float*)F.lds;
    FRESH_TID(tid_); const int tid = tid_, lane = tid & 63, wave = F.wave;
    unsigned char* ws = F_WS;
    const float* in_win = F_IN(7);
    if (part == 0) {
        const float* in_c = F_IN(1); const float* in_cctx = F_IN(3); const float* in_wada = F_IN(5); const float* in_bada = F_IN(6);
        float* s_c = ldsf;
        float* red = ldsf + 5 * 2048;
        for (int idx = tid; idx < 5 * 2048; idx += 512) { const int r = idx >> 11, k = idx & 2047; const float v = (r < 4) ? in_c[r * 2048 + k] : in_cctx[k]; s_c[idx] = siluf(v); }
        __syncthreads();
        float* mods = WSP(float, WS_MODS);
        for (int rp = 0; rp < ((REP_P & 1) ? 2 : 1); ++rp)
        for (int item = wg; item < 192; item += nwg) {
            const int l = item / 96, nb = item % 96, col = nb * 64 + lane;
            const float* w = in_wada + (size_t)l * 2048 * 6144 + col;
            float a0 = 0.f, a1 = 0.f, a2 = 0.f, a3 = 0.f, a4 = 0.f;
            const int kb = wave * 256;
            for (int k0 = 0; k0 < 256; k0 += 32) { float wv[32];
#pragma unroll
                for (int k = 0; k < 32; ++k) wv[k] = w[(size_t)(kb + k0 + k) * 6144];
#pragma unroll
                for (int k = 0; k < 32; ++k) { const int kk = kb + k0 + k;
                    a0 += s_c[kk] * wv[k]; a1 += s_c[2048 + kk] * wv[k]; a2 += s_c[4096 + kk] * wv[k]; a3 += s_c[6144 + kk] * wv[k]; a4 += s_c[8192 + kk] * wv[k]; } }
            red[(wave * 5 + 0) * 64 + lane] = a0; red[(wave * 5 + 1) * 64 + lane] = a1; red[(wave * 5 + 2) * 64 + lane] = a2; red[(wave * 5 + 3) * 64 + lane] = a3; red[(wave * 5 + 4) * 64 + lane] = a4;
            __syncthreads();
            if (tid < 320) { const int r = tid >> 6, ln = tid & 63; float s = 0.f;
#pragma unroll
                for (int w8 = 0; w8 < 8; ++w8) s += red[(w8 * 5 + r) * 64 + ln];
                mods[((size_t)l * 5 + r) * 6144 + nb * 64 + ln] = s + in_bada[(size_t)l * 6144 + nb * 64 + ln]; }
            __syncthreads();
        }
    }
    if (part == 0) {
        const float* in_poolw = F_IN(8); const float* in_pools = F_IN(9);
        float* Ml = ldsf;
        float* Wt = ldsf + 128 * 128;
        for (int rp = 0; rp < ((REP_P & 2) ? 2 : 1); ++rp)
        for (int item = wg; item < 512; item += nwg) {
            const int l = item >> 8, kind = (item >> 7) & 1, g = (item >> 5) & 3, kb = item & 31;
            __syncthreads();
            for (int idx = tid; idx < 128 * 128; idx += 512) { const int j = idx >> 7, n = idx & 127; float v;
                if (kind == 0) v = in_poolw[(((size_t)l * 4 + g) * 128 + j) * 128 + n] * in_pools[(size_t)l * 512 + g * 128 + n];
                else { const float sc = 0.08838834764831845f;
                    if (n <= 64) v = __builtin_amdgcn_cosf((float)((j * n) & 127) * (1.f / 128.f)) * sc;
                    else v = __builtin_amdgcn_sinf((float)((j * (n - 64)) & 127) * (1.f / 128.f)) * sc; }
                Ml[idx] = v; }
            const int colbase = (kind == 0 ? OFF_POOL : OFF_FNET) + g * 128;
            { float wv[16];
#pragma unroll
              for (int q = 0; q < 16; ++q) { const int idx = tid + q * 512, kk = idx >> 7, jj = idx & 127; wv[q] = in_win[((size_t)l * DM + kb * 64 + kk) * DIN + colbase + jj]; }
#pragma unroll
              for (int q = 0; q < 16; ++q) { const int idx = tid + q * 512, kk = idx >> 7, jj = idx & 127; Wt[jj * 68 + kk] = wv[q]; } }
            __syncthreads();
            const int n4 = (tid & 31) * 4, k4 = (tid >> 5) * 4;
            f32x4 acc4[4];
#pragma unroll
            for (int i = 0; i < 4; ++i) acc4[i] = (f32x4){0.f, 0.f, 0.f, 0.f};
#pragma unroll 8
            for (int j = 0; j < 128; ++j) { const f32x4 mv = *(const f32x4*)(Ml + j * 128 + n4), wq = *(const f32x4*)(Wt + j * 68 + k4);
#pragma unroll
                for (int i = 0; i < 4; ++i) acc4[i] += mv * wq[i]; }
            bf16_t* dst = WSP(bf16_t, WS_WIN) + ((size_t)l * NIN + colbase + n4) * DM + kb * 64 + k4;
#pragma unroll
            for (int e = 0; e < 4; ++e) { u32x2 w; w.x = pk2(acc4[0][e], acc4[1][e]); w.y = pk2(acc4[2][e], acc4[3][e]); *(u32x2*)(dst + (size_t)e * DM) = w; }
        }
        __syncthreads();
    }
    {
        const float* in_wuq = F_IN(12); const float* in_wukv = F_IN(14); const float* in_wout = F_IN(17); const float* in_qnw = F_IN(11); const float* in_kvnw = F_IN(13);
        float* scr = ldsf + wave * (64 * 33 + 16);
        const int gw = wg * NWAVES + wave, NGW = nwg * NWAVES;
        constexpr int I_IN = 32 * 130, I_UQ = 8 * 48, I_UKV = 8 * 64, I_OUT = 32 * 64, I_REST = I_UQ + I_UKV + I_OUT;
        const int ntot = (part == 0) ? 2 * I_IN : I_REST;
        for (int rp = 0; rp < ((REP_P & 4) ? 2 : 1); ++rp)
        for (int it = gw; it < ntot; it += NGW) {
            int r = it;
            if (part == 0) { const int l = r / I_IN; r -= l * I_IN; const int nb = r % 130; if (nb < 16 || (nb >= 32 && nb < 48)) continue;
                transpose_item(in_win + (size_t)l * DM * DIN, DM, DIN, WSP(bf16_t, WS_WIN) + (size_t)l * NIN * DM, 0, scr, r, lane); continue; }
            const int l = part - 1;
            if (r < I_UQ) { transpose_item(in_wuq + (size_t)l * 512 * NQ, 512, NQ, WSP(bf16_t, WS_WUQ) + (size_t)l * NQ * 512, 0, scr, r, lane, in_qnw + (size_t)l * 512); continue; } r -= I_UQ;
            if (r < I_UKV) { transpose_item(in_wukv + (size_t)l * 512 * NKV, 512, NKV, WSP(bf16_t, WS_WUKV) + (size_t)l * NKV * 512, 0, scr, r, lane, in_kvnw + (size_t)l * 512); continue; } r -= I_UKV;
            transpose_item(in_wout + (size_t)l * DM * DM, DM, DM, WSP(bf16_t, WS_WOUT) + (size_t)l * DM * DM, 0, scr, r, lane);
        }
    }
    {
        const int gt = wg * 512 + tid, NGT = nwg * 512;
        if (part == 1) {
            const float* in_fnetw = F_IN(10);
            for (int idx = gt; idx < NL * 512 * 512; idx += NGT) { const int l = idx >> 18, n = (idx >> 9) & 511, kidx = idx & 511;
                const int g = n >> 7, d = n & 127; const int g2 = (kidx & 255) >> 6, s = kidx & 63; float v = 0.f;
                if (g2 == g) { const float* fw = in_fnetw + (((size_t)l * 4 + g) * 128) * 128 + d;
                    if (kidx < 256) v = (s == 0) ? fw[0] : fw[(size_t)s * 128] + fw[(size_t)(128 - s) * 128];
                    else v = (s == 0) ? 0.f : fw[(size_t)s * 128] - fw[(size_t)(128 - s) * 128]; }
                WSP(bf16_t, WS_FWAB)[idx] = (bf16_t)f2bf(v); }
        }
        if (part == 0) {
            const float* in_qhw = F_IN(15); const float* in_khw = F_IN(16);
            for (int idx = gt; idx < 256 * 256; idx += NGT) { const int k = idx >> 8, n = idx & 255; const float ph = (float)((k * n) & 255) * (1.f / 256.f);
                WSP(bf16_t, WS_DCTX)[idx] = (bf16_t)f2bf(__builtin_amdgcn_cosf(ph) * 0.0625f);
                WSP(bf16_t, WS_DCTX)[65536 + idx] = (bf16_t)f2bf(-__builtin_amdgcn_sinf(ph) * 0.0625f); }
            if (wg == 0 && F.wave == 0) { for (int l = 0; l < NL; ++l) { float mq = 0.f, mk = 0.f;
                    for (int i = lane; i < DQK; i += 64) { mq = fmaxf(mq, fabsf(in_qhw[l * DQK + i])); mk = fmaxf(mk, fabsf(in_khw[l * DQK + i])); }
                    mq = wave_max(mq); mk = wave_max(mk);
                    if (lane == 0) WSP(float, WS_SMB)[l] = -(att::SCALE * (float)DQK * mq * mk) * 1.4426950408889634f; } }
            for (int idx = gt; idx < 1024; idx += NGT) { const int p = idx >> 4, i = idx & 15; const float inv = powf(10000.f, -(float)i / 16.f); const float ang = (float)p * inv;
                WSP(float, WS_ROPE)[2 * idx] = cosf(ang); WSP(float, WS_ROPE)[2 * idx + 1] = sinf(ang); }
        }
    }
}

__device__ __forceinline__ void phase_norm(Frame& F, int l) {
    FRESH_TID(tid_); const int lane = tid_ & 63;
    const int gw = F.vcu * NWAVES + F.wave, NGW = F.G * NWAVES;
    unsigned char* ws = F_WS;
    if (l == 0) {
        const float* mods = WSP(float, WS_MODS);
        const float* nw = F_IN(4);
        const float* src_lat = F_IN(0); const float* src_ctx = F_IN(2);
        bf16_t* H = WSP(bf16_t, WS_HMIX);
        for (int it = gw; it < MT / 2; it += NGW) {
            const int rowa = 2 * it;
            const bool lat = rowa < MLAT; const int rr = lat ? rowa : rowa - MLAT; const int mr = lat ? (rowa >> 12) : 4;
            const float* shp = mods + (size_t)mr * 6144; const float* scp = shp + 2048;
            f32x4 v[2][8], w4[8], sc4[8], sh4[8];
#pragma unroll
            for (int q = 0; q < 2; ++q) { const f32x4* xr = (const f32x4*)((lat ? src_lat : src_ctx) + (size_t)(rr + q) * DM) + lane;
#pragma unroll
                for (int j = 0; j < 8; ++j) v[q][j] = xr[64 * j]; }
#pragma unroll
            for (int j = 0; j < 8; ++j) { const int c0 = 4 * (lane + 64 * j); w4[j] = *(const f32x4*)(nw + c0); sc4[j] = *(const f32x4*)(scp + c0); sh4[j] = *(const f32x4*)(shp + c0); }
            float ssq[2];
#pragma unroll
            for (int q = 0; q < 2; ++q) { float s8 = 0.f;
#pragma unroll
                for (int j = 0; j < 8; ++j) s8 += (v[q][j][0] * v[q][j][0] + v[q][j][1] * v[q][j][1]) + (v[q][j][2] * v[q][j][2] + v[q][j][3] * v[q][j][3]);
                ssq[q] = wave_sum(s8); }
#pragma unroll
            for (int q = 0; q < 2; ++q) { const float rstd = 1.0f / sqrtf(ssq[q] * (1.f / DM) + EPS);
                u32x2* o8 = (u32x2*)(H + (size_t)(rowa + q) * DM) + lane;
#pragma unroll
                for (int j = 0; j < 8; ++j) { f32x4 hv;
#pragma unroll
                    for (int e = 0; e < 4; ++e) hv[e] = (v[q][j][e] * rstd * w4[j][e]) * (1.f + sc4[j][e]) + sh4[j][e];
                    u32x2 w; w.x = pk2(hv[0], hv[1]); w.y = pk2(hv[2], hv[3]); o8[64 * j] = w; } }
        }
        const float* mods1 = mods + (size_t)5 * 6144;
        LAS float* shl = (LAS float*)F.lds3;
        { float sv[20];
#pragma unroll
          for (int i = 0; i < 20; ++i) { const int e = tid_ + i * NWAVES * 64; sv[i] = mods1[(size_t)(e >> 11) * 6144 + (e & 2047)]; }
#pragma unroll
          for (int i = 0; i < 20; ++i) shl[tid_ + i * NWAVES * 64] = sv[i]; }
        __syncthreads();
        const bf16_t* WT = WSP(bf16_t, WS_WIN) + (size_t)NIN * DM; float* BI = WSP(float, WS_BIAS);
        u32x4 wv3[3][4];
#pragma unroll
        for (int ci = 0; ci < 3; ++ci) { const int c = gw + ci * NGW;
#pragma unroll
            for (int j = 0; j < 4; ++j) wv3[ci][j] = *(const u32x4*)(WT + (size_t)(c < NIN ? c : 0) * DM + (size_t)(lane + 64 * j) * 8); }
#pragma unroll
        for (int ci = 0; ci < 3; ++ci) { const int c = gw + ci * NGW; if (c >= NIN) break;
            float acc5[5] = {0.f, 0.f, 0.f, 0.f, 0.f};
#pragma unroll
            for (int j = 0; j < 4; ++j) { float wf[8]; unpack8(wv3[ci][j], wf);
#pragma unroll
                for (int b = 0; b < 5; ++b) { const f32x4 s0 = *(const LAS f32x4*)(shl + b * DM + (lane + 64 * j) * 8), s1 = *(const LAS f32x4*)(shl + b * DM + (lane + 64 * j) * 8 + 4);
                    acc5[b] += ((wf[0] * s0[0] + wf[1] * s0[1]) + (wf[2] * s0[2] + wf[3] * s0[3])) + ((wf[4] * s1[0] + wf[5] * s1[1]) + (wf[6] * s1[2] + wf[7] * s1[3])); } }
#pragma unroll
            for (int b = 0; b < 5; ++b) { const float t = wave_sum(acc5[b]); if (lane == 0) BI[(size_t)b * NIN + c] = t; } }
        __syncthreads();
    } else {
        const float* mods = WSP(float, WS_MODS) + (size_t)l * 5 * 6144;
        const float* nw = F_IN(4) + (size_t)l * DM;
        const float* src_ctx = F_IN(2);
        const float* part = WSP(float, WS_Q); const float* gate_c0 = WSP(float, WS_MODS) + (size_t)4 * 6144 + 4096;
        bf16_t* XB = WSP(bf16_t, WS_KV); float* RS = WSP(float, WS_RS);
        if ((gw & 1) == 0) { const int row = gw >> 1;
            if (row < MCTX) {
                f32x4 v[8], p0[8], p1[8], p2[8], p3[8], g4[8];
#pragma unroll
                for (int j = 0; j < 8; ++j) { const int c0 = 4 * (lane + 64 * j); const size_t po = (size_t)row * DM + c0;
                    v[j] = *(const f32x4*)(src_ctx + po); p0[j] = *(const f32x4*)(part + po); p1[j] = *(const f32x4*)(part + (size_t)MCTX * DM + po);
                    p2[j] = *(const f32x4*)(part + (size_t)2 * MCTX * DM + po); p3[j] = *(const f32x4*)(part + (size_t)3 * MCTX * DM + po); g4[j] = *(const f32x4*)(gate_c0 + c0); }
                float s8 = 0.f;
#pragma unroll
                for (int j = 0; j < 8; ++j) { v[j] = v[j] + g4[j] * ((p0[j] + p1[j]) + (p2[j] + p3[j]));
                    s8 += (v[j][0] * v[j][0] + v[j][1] * v[j][1]) + (v[j][2] * v[j][2] + v[j][3] * v[j][3]); }
                const float ssq = wave_sum(s8);
                if (lane == 0) RS[MLAT + row] = 1.0f / sqrtf(ssq * (1.f / DM) + EPS);
                const float* scp = mods + (size_t)4 * 6144 + 2048;
                u32x2* o8 = (u32x2*)(XB + (size_t)(MLAT + row) * DM) + lane;
#pragma unroll
                for (int j = 0; j < 8; ++j) { const int c0 = 4 * (lane + 64 * j); const f32x4 w4 = *(const f32x4*)(nw + c0), sc4 = *(const f32x4*)(scp + c0); f32x4 hv;
#pragma unroll
                    for (int e = 0; e < 4; ++e) hv[e] = (v[j][e] * w4[e]) * (1.f + sc4[e]);
                    u32x2 w; w.x = pk2(hv[0], hv[1]); w.y = pk2(hv[2], hv[3]); o8[64 * j] = w; }
            }
        } else {
            const float* SS = WSP(float, WS_SS);
            for (int r = (gw >> 1) * 64 + lane; r < MLAT; r += (NGW >> 1) * 64) { f32x4 a[8];
#pragma unroll
                for (int j = 0; j < 8; ++j)
#pragma unroll
                    for (int e = 0; e < 4; ++e) a[j][e] = SS[(size_t)(4 * j + e) * MLAT + r];
                float t = 0.f;
#pragma unroll
                for (int j = 0; j < 8; ++j) t += (a[j][0] + a[j][1]) + (a[j][2] + a[j][3]);
                RS[r] = 1.0f / sqrtf(t * (1.f / DM) + EPS); }
        }
    }
}

__device__ __forceinline__ void dft_gen(Frame& F, int l, int wg, int nwg) {
    FRESH_TID(tidl_); const int tidl = tidl_;
    unsigned char* ws = F_WS;
    bf16_t* Dc = (l == 0) ? (bf16_t*)F_OUT : WSP(bf16_t, WS_WIN); bf16_t* Ds = Dc + (size_t)2048 * KFOLD;
    for (int idx = wg * 512 + tidl; idx < 2048 * (KFOLD / 8); idx += nwg * 512) { const int k = idx / (KFOLD / 8), n0 = (idx - k * (KFOLD / 8)) * 8;
        float cv[8], sv[8];
#pragma unroll
        for (int e = 0; e < 8; ++e) { const float ph = (float)((k * (n0 + e)) & 4095) * (1.f / 4096.f);
            cv[e] = __builtin_amdgcn_cosf(ph) * 0.015625f; sv[e] = -__builtin_amdgcn_sinf(ph) * 0.015625f; }
        *(u32x4*)(Dc + (size_t)k * KFOLD + n0) = pack8(cv); *(u32x4*)(Ds + (size_t)k * KFOLD + n0) = pack8(sv); }
}

__device__ __forceinline__ void phase_heads_pool(Frame& F, int l, bool inplace) {
    FRESH_TID(tidl_); const int tidl = tidl_, lane = tidl & 63;
    const int npost = (l == 0) ? 136 : 128;
    const int nshare = (F.bx < npost) ? 1 : 2, vwg0 = (F.bx < npost) ? F.bx : npost + 2 * (F.bx - npost), NVWG = npost + 2 * (F.G - npost);
    unsigned char* ws = F_WS;
    const bf16_t* P = WSP(bf16_t, WS_P); bf16_t* KH = WSP(bf16_t, WS_KH);
    const float* rope = WSP(float, WS_ROPE);
    const float* kw = F_IN(16) + (size_t)l * DQK;
    const int h = lane >> 3, sub = lane & 7;
    const float sgn = (sub & 2) ? 1.f : -1.f;
    float kwr[8];
#pragma unroll
    for (int e = 0; e < 8; ++e) kwr[e] = kw[128 + sub * 8 + e];
    const float* RHp = WSP(float, WS_RH);
    for (int rf = 0; rf < ((REP_F & 1) ? 2 : 1); ++rf)
    for (int sh = 0; sh < nshare; ++sh)
    for (int row0 = (vwg0 + sh) * NWAVES + F.wave; row0 < MT; row0 += 4 * NVWG * NWAVES) {
        u32x4 l_kr[4]; float l_rh[4]; f32x4 rt[4][4];
#pragma unroll
        for (int k = 0; k < 4; ++k) { const int row = row0 + k * NVWG * NWAVES; const int rc = row < MT ? row : row0;
            l_kr[k] = *(const u32x4*)(P + (size_t)rc * NIN + OFF_KROPE + sub * 8); l_rh[k] = RHp[(size_t)rc * 8 + h];
            const int t = rc & (SEQ - 1); const int pos = (sub < 4) ? (t >> 6) : (t & 63);
            const f32x4* rp = (const f32x4*)(rope + (size_t)(pos * 16 + (sub & 1) * 8) * 2);
#pragma unroll
            for (int q4 = 0; q4 < 4; ++q4) rt[k][q4] = rp[q4]; }
        asm volatile("" ::: "memory");
#pragma unroll
        for (int k = 0; k < 4; ++k) { const int row = row0 + k * NVWG * NWAVES;
            if (row < MT) { const bool lat = row < MLAT;
                float r8[8], y[8]; unpack8(l_kr[k], r8);
#pragma unroll
                for (int e = 0; e < 8; ++e) { const float cs = lat ? rt[k][e >> 1][2 * (e & 1)] : 1.f, sn = lat ? rt[k][e >> 1][2 * (e & 1) + 1] : 0.f;
                    const float yy = r8[e] * l_rh[k] * kwr[e]; const float pr = lane_xor<2>(yy); y[e] = yy * cs + sgn * pr * sn; }
                *(u32x4*)(KH + (size_t)row * NQ + h * DQK + 128 + sub * 8) = pack8(y); } }
    }
    {
        bf16_t* mix = WSP(bf16_t, WS_HMIX);
        const int nrows = (l == 0) ? MT : MLAT;
        for (int rf = 0; rf < ((REP_F & 2) ? 2 : 1); ++rf)
        for (int sh = 0; sh < nshare; ++sh)
        for (int idx = (vwg0 + sh) * 512 + tidl; idx < nrows * 64; idx += NVWG * 512) { const int row = idx >> 6, cc = idx & 63, g = cc >> 4;
            const int w = 2 << g, lo = w >> 1, hi = w - lo - 1;
            const bool lat = row < MLAT; const int rr = lat ? row : row - MLAT;
            const int n = lat ? SEQ : CTX, t = rr & (n - 1), base = row - t;
            const int a = (t - lo) < 0 ? 0 : (t - lo), e = (t + hi) > (n - 1) ? (n - 1) : (t + hi);
            float s[8];
#pragma unroll
            for (int q = 0; q < 8; ++q) s[q] = 0.f;
            u32x4 wv[16]; const int cnt = e - a + 1;
#pragma unroll
            for (int k = 0; k < 16; ++k) wv[k] = (k < cnt) ? *(const u32x4*)(P + (size_t)(base + a + k) * NIN + OFF_POOL + cc * 8) : (u32x4){0u, 0u, 0u, 0u};
#pragma unroll
            for (int k = 0; k < 16; ++k) { float f[8]; unpack8(wv[k], f);
#pragma unroll
                for (int q = 0; q < 8; ++q) s[q] += f[q]; }
            float self[8], gt8[8]; unpack8(*(const u32x4*)(P + (size_t)row * NIN + OFF_POOL + cc * 8), self); unpack8(*(const u32x4*)(P + (size_t)row * NIN + OFF_PGATE + cc * 8), gt8);
            const float inv = 1.f / (float)(e - a + 1);
#pragma unroll
            for (int q = 0; q < 8; ++q) s[q] = siluf(gt8[q]) * (s[q] * inv - self[q]);
            *(u32x4*)(mix + (size_t)row * DM + cc * 8) = pack8(s); }
    }
}

__global__ void __launch_bounds__(NWAVES * 64, 2) fwd_kernel(Args args) {
    extern __shared__ __attribute__((aligned(16))) unsigned char lds[];
    Frame F;
    F.lds = lds;
    const int tid0 = threadIdx.x; F.wave = __builtin_amdgcn_readfirstlane(tid0 >> 6);
    F.G = NCU; F.bx = blockIdx.x; F.vcu = (F.bx % 8) * (NCU / 8) + F.bx / 8;
    LAS unsigned char* lds3 = (LAS unsigned char*)lds; F.lds3 = lds3;
    volatile LAS unsigned* MISC = (volatile LAS unsigned*)(lds3 + MISC_OFF);
    for (int u = tid0; u < (LDS_BYTES - LDSCTL_OFF) / 4; u += NWAVES * 64) ((LAS unsigned*)(lds3 + LDSCTL_OFF))[u] = 0u;
    __syncthreads();
    unsigned char* ws = F_WS;
    unsigned* ctl = (unsigned*)(ws + WS_CTL);
    XcdBarrier bar; bar.bar = ctl + CW_BAR; bar.x = 0; bar.st = nullptr;
    const int lo = MK_ONE_LAUNCH ? 0 : args.ph_lo, hi = MK_ONE_LAUNCH ? (1 + 6 * NL) : args.ph_hi;
    const bool multi = (hi - lo) > 1;
    if (multi) bar = xcd_barrier_post(ctl + CW_BAR, MISC + 8, tid0);
#ifndef PHM
#define PHM 0xff
#endif
#ifndef REP_MASK
#define REP_MASK 0
#endif
#define NREP(bit) ((REP_MASK & (bit)) ? 2 : 1)

    for (int ph = lo; ph < hi; ++ph) {
        const int l = (ph > 6) ? 1 : 0, kind = (ph == 0) ? 0 : ph - 6 * l;
        unsigned char* ws = F_WS;
        if ((PHM & 1) && kind == 0) { for (int rep = 0; rep < NREP(1); ++rep) { phase_prep(F, 0, F.vcu, F.G); __syncthreads(); } }
        if ((PHM & 2) && kind == 1) for (int rep = 0; rep < NREP(2); ++rep) phase_norm(F, l);
        if ((PHM & 4) && kind == 2) for (int rep = 0; rep < NREP(4); ++rep) {
            pg8::Gemm g{l == 0 ? WSP(bf16_t, WS_HMIX) : WSP(bf16_t, WS_KV), WSP(bf16_t, WS_WIN) + (size_t)l * NIN * DM, DM, DM, DM, 1 << 20, 0};
            pg8::StaticOrder S; S.init(MT / 256, NIN / 256, F.G, F.bx);
            pg8::Epi E{}; E.kind = 0; E.O = WSP(bf16_t, WS_P); E.ldc = NIN; E.rowoff = 0; E.cmul = 256; E.cadd = 0; E.csplit = 1 << 20; E.cadd2 = 0;
            E.xt_lat = WSP(bf16_t, WS_XTC); E.xt_ctx = WSP(bf16_t, WS_XTCC);
            if (l != 0) { E.rs = WSP(float, WS_RS); E.bias = WSP(float, WS_BIAS); }
            E.sqo = WSP(float, WS_SQ);
            for (int rc = 0; rc < ((REP_P & 16) ? 2 : 1); ++rc)
            pg8::gemm_phase<pg8::Epi, pg8::StaticOrder, true, true>(lds3, g, S, E, F.wave);
            { const int nfull = (MT / 256) * (NIN / 256) % F.G; const bool sub = nfull > 0 && nfull < F.G;
              if (!sub || F.bx >= nfull) { const int wgi = sub ? F.bx - nfull : F.bx, nwgi = sub ? F.G - nfull : F.G;
                  dft_gen(F, l, wgi, nwgi); __syncthreads(); phase_prep(F, l == 0 ? 1 : 2, wgi, nwgi); } }
        }
        if ((PHM & 16) && kind == 3) for (int rep = 0; rep < NREP(16); ++rep) {
            constexpr int split = 72;
            const int nrest = F.G - split;
            if (rep == 0) {
                FRESH_TID(tz_); const int lz = tz_ & 63; const int gwz = F.vcu * NWAVES + F.wave, NGWZ = F.G * NWAVES;
                bf16_t* XC = WSP(bf16_t, WS_XTC); bf16_t* PC = WSP(bf16_t, WS_PCS) + (size_t)2048 * PCSW;
                for (int r = gwz; r < 1040 + 1024; r += NGWZ) {
                    const bool cosr = r < 1040;
                    bf16_t* xr = XC + (size_t)(cosr ? r : r + 240) * DPITCH;
                    u32x4 lo[4], hi[4]; unsigned short f0[4];
#pragma unroll
                    for (int i = 0; i < 4; ++i) { const int c = i * 64 + lz;
                        lo[i] = *(const u32x4*)(xr + 8 * c); hi[i] = *(const u32x4*)(xr + 8 * (511 - c)); f0[i] = *(const unsigned short*)(xr + 4096 - 8 * c); }
                    asm volatile("s_waitcnt vmcnt(0)" ::: "memory");
                    float a = 0.f; const float sg = cosr ? 1.f : -1.f;
#pragma unroll
                    for (int i = 0; i < 4; ++i) { const int c = i * 64 + lz;
                        float L[8], H[8], f[8]; unpack8(lo[i], L); unpack8(hi[i], H);
                        f[0] = (c == 0) ? L[0] : L[0] + sg * bf2f(f0[i]);
#pragma unroll
                        for (int q = 1; q < 8; ++q) f[q] = L[q] + sg * H[8 - q];
                        a += ((f[0] - f[1]) + (f[2] - f[3])) + ((f[4] - f[5]) + (f[6] - f[7]));
                        *(u32x4*)(xr + 8 * c) = pack8(f); }
                    unsigned zz = 0u; asm volatile("" : "+v"(zz));
                    if (lz == 63) { a += bf2f((unsigned short)(hi[3].x & 0xffffu)); u32x4 z; z.x = hi[3].x & 0xffffu; z.y = zz; z.z = zz; z.w = zz; *(u32x4*)(xr + 2048) = z; }
                    if (lz < 15) { u32x4 z; z.x = zz; z.y = zz; z.z = zz; z.w = zz; *(u32x4*)(xr + 2056 + 8 * lz) = z; }
                    a = wave_sum(a) * 0.015625f;
                    if (cosr) { const int col = (r < 1024) ? ((r >> 8) * 512 + (r & 255)) : (2048 + (r - 1024)); if (lz == 0) PC[col] = (bf16_t)f2bf(a); }
                    else { const int q = r - 1040; if (lz == 0) PC[(q >> 8) * 512 + 256 + (q & 255)] = 0; }
                }
                asm volatile("s_waitcnt vmcnt(0)" ::: "memory");
                __syncthreads();
                if (tz_ == 0) { __builtin_amdgcn_fence(__ATOMIC_RELEASE, "agent"); asm volatile("s_waitcnt vmcnt(0)" ::: "memory"); (void)xb_add(WSP(unsigned, WS_CTL) + CW_FOLD + 64 * l, 1u); }
            }
            int qf = 0, ql = 0, kf = 0, kl = 0; const int cc = F.bx - split;
            if (cc >= 0) {
                if (l == 0) { if (cc < 64) { kf = 144 + 4 * cc; kl = kf + 4; } else if (cc < 136) { qf = 5 * (cc - 64); ql = qf + 5; } else { qf = 360 + (cc - 136); ql = qf + 1; kf = 400 + 3 * (cc - 136); kl = kf + 3; } }
                else { if (cc < 40) { kf = 144 + 4 * cc; kl = kf + 4; } else if (cc < 88) { qf = 5 * (cc - 40); ql = qf + 5; } else if (cc < 136) { qf = 240 + (cc - 88); ql = qf + 1; kf = 304 + 3 * (cc - 88); kl = kf + 3; }
                       else { qf = 288 + 2 * (cc - 136); ql = qf + 2; kf = 448 + 2 * (cc - 136); kl = kf + 2; } }
            } else { kf = 2 * F.bx; kl = kf + 2; }
            for (int jj = 0; jj < 7; ++jj) { const int job = (jj == 0) ? 5 : (jj < 6 ? jj - 1 : 6);
                pg8::Gemm g{}; pg8::RangeOrder S; pg8::Epi E{}; E.kind = 0; E.rowoff = 0; E.cmul = 256; E.cadd = 0; E.csplit = 1 << 20; E.cadd2 = 0; E.xt_lat = nullptr; E.xt_ctx = nullptr; E.mirror = 0;
                if (job == 0) {
                    if (F.bx < split) {
                        FRESH_TID(tw_);
                        if (tw_ == 0) { unsigned* cw = WSP(unsigned, WS_CTL); XB_SPIN(xb_ld(cw + CW_FOLD + 64 * l) < (unsigned)F.G, cw + CW_BAR); __builtin_amdgcn_fence(__ATOMIC_ACQUIRE, "agent"); asm volatile("s_waitcnt vmcnt(0)" ::: "memory"); }
                        __syncthreads(); }
                    g = pg8::Gemm{(l == 0) ? (const bf16_t*)F_OUT : WSP(bf16_t, WS_WIN), WSP(bf16_t, WS_XTC), KFOLD, DPITCH, KFOLD, 1 << 20, 0};
                    S.init(8, 5, 40, F.bx);
                    E.O = WSP(bf16_t, WS_PCS); E.ldc = PCSW; E.cmul = 512; E.csplit = 4; E.cadd2 = 2048; E.mirror = 1;
                } else if (job == 1) {
                    g = pg8::Gemm{((l == 0) ? (const bf16_t*)F_OUT : WSP(bf16_t, WS_WIN)) + (size_t)2048 * KFOLD, WSP(bf16_t, WS_XTS), KFOLD, DPITCH, KFOLD, 1 << 20, 0};
                    S.init(8, 4, 32, F.bx - 40);
                    E.O = WSP(bf16_t, WS_PCS); E.ldc = PCSW; E.cmul = 512; E.cadd = 256; E.mirror = -1;
                } else if (job == 2) {
                    if (l != 0) continue;
                    g = pg8::Gemm{WSP(bf16_t, WS_DCTX), WSP(bf16_t, WS_XTCC), 256, 256, 256, 1 << 20, 0};
                    S.init(1, 5, 5, cc - 136);
                    E.O = WSP(bf16_t, WS_PCSC); E.ldc = PCSW; E.cmul = 512; E.csplit = 4; E.cadd2 = 2048;
                } else if (job == 3) {
                    if (l != 0) continue;
                    g = pg8::Gemm{WSP(bf16_t, WS_DCTX) + 65536, WSP(bf16_t, WS_XTSC), 256, 256, 256, 1 << 20, 0};
                    S.init(1, 4, 4, cc - 141);
                    E.O = WSP(bf16_t, WS_PCSC); E.ldc = PCSW; E.cmul = 512; E.cadd = 256;
                } else if (job == 4) {
                    g = pg8::Gemm{WSP(bf16_t, WS_P) + OFF_CQ, WSP(bf16_t, WS_WUQ) + (size_t)l * NQ * 512, NIN, 512, 512, 1 << 20, 0};
                    S.init_range(l == 0 ? MT / 256 : MLAT / 256, NQ / 256, qf, ql, 1, 0);
                    E.O = WSP(bf16_t, WS_Q); E.ldc = NQ; E.sq8 = WSP(float, WS_SQ);
                } else {
                    g = pg8::Gemm{WSP(bf16_t, WS_P) + OFF_CKV, WSP(bf16_t, WS_WUKV) + (size_t)l * NKV * 512, NIN, 512, 512, 1 << 20, 0};
                    if (job == 5) S.init_range(MT / 256, NKV / 256, cc < 0 ? kf : 0, cc < 0 ? kl : 0, 1, 0);
                    else S.init_range(MT / 256, NKV / 256, cc >= 0 ? kf : 0, cc >= 0 ? kl : 0, 1, 0);
                    E.O = (l == 0) ? WSP(bf16_t, WS_KV) : (bf16_t*)F_OUT; E.ldc = NKV; E.sq8 = WSP(float, WS_SQ) + (size_t)8 * MT;
                    E.kind = 4; E.kr2 = WSP(float, WS_SQ) + (size_t)16 * MT; E.kh = WSP(bf16_t, WS_KH); E.rh = WSP(float, WS_RH); E.kw = F_IN(16) + (size_t)l * DQK; E.qwk = F_IN(15) + (size_t)l * DQK;
                    E.part = (LAS float*)(lds3 + 132096);
                }
                if (job >= 5) { pg8::Epi4 E4{E}; pg8::gemm_phase<pg8::Epi4, pg8::RangeOrder, true, true>(lds3, g, S, E4, F.wave); }
                else
                for (int rj = 0; rj < (((REP_EJ >> job) & 1) ? 2 : 1); ++rj)
                pg8::gemm_phase<pg8::Epi, pg8::RangeOrder, true, true>(lds3, g, S, E, F.wave);
            }
        }
        if ((PHM & 32) && kind == 4) for (int rep = 0; rep < NREP(32); ++rep) {
            phase_heads_pool(F, l, rep == 0);
            __syncthreads();
            for (int job = 0; job < 2; ++job) {
                if (job == 1 && l != 0) continue;
                pg8::Gemm g{}; pg8::RangeOrder S; pg8::Epi E{}; E.kind = 1; E.O = WSP(bf16_t, WS_HMIX); E.ldc = DM; E.P = WSP(bf16_t, WS_P);
                E.fw = F_IN(10) + (size_t)l * 4 * 128 * 128;
                if (job == 0) { g = pg8::Gemm{WSP(bf16_t, WS_PCS), WSP(bf16_t, WS_FWAB) + (size_t)l * 512 * 512, PCSW, 512, 512, 16, 512};
                    S.init(64, 2, F.G, F.bx); E.rowoff = 0; E.NY = WSP(bf16_t, WS_PCS); E.nseq = SEQ; E.lgseq = 12; }
                else { g = pg8::Gemm{WSP(bf16_t, WS_PCSC), WSP(bf16_t, WS_FWAB) + (size_t)l * 512 * 512, PCSW, 512, 512, 1, 512};
                    S.init_range(4, 2, 0, 8, 8, F.bx - 128); E.rowoff = MLAT; E.NY = WSP(bf16_t, WS_PCSC); E.nseq = CTX; E.lgseq = 8; }
                for (int rf = 0; rf < ((REP_F & 4) ? 2 : 1); ++rf)
                pg8::gemm_phase<pg8::Epi, pg8::RangeOrder, true, true>(lds3, g, S, E, F.wave);
            }
        }
        if ((PHM & 64) && kind == 5) for (int rep = 0; rep < NREP(64); ++rep) {
            const bf16_t* Qg = WSP(bf16_t, WS_Q); const bf16_t* KHg = WSP(bf16_t, WS_KH); const bf16_t* KVg = (l == 0) ? WSP(bf16_t, WS_KV) : (const bf16_t*)F_OUT; const bf16_t* Pg = WSP(bf16_t, WS_P); bf16_t* mix = WSP(bf16_t, WS_HMIX);
            const float* qhw = F_IN(15) + (size_t)l * DQK; const float* ropet = WSP(float, WS_ROPE);
            const float negMC = __builtin_bit_cast(float, __builtin_amdgcn_readfirstlane(__builtin_bit_cast(int, WSP(float, WS_SMB)[l])));
            for (int u = F.vcu; u < NB * NH * 16; u += F.G) {
                const int bh = u >> 4, qb = u & 15, b = bh >> 3, h = bh & 7;
                att::attn_unit(Qg, KHg, KVg, Pg, mix, qhw, ropet, h, b * SEQ + qb * 256, MLAT + b * CTX, b * SEQ, 4, 68, negMC, (char*)lds, F.wave);
            }
            if (l == 0) for (int u = F.vcu; u < NB * NH; u += F.G) {
                const int b = u >> 3, h = u & 7;
                att::attn_unit(Qg, KHg, KVg, Pg, mix, qhw, ropet, h, MLAT + b * CTX, MLAT + b * CTX, 0, 4, 4, negMC, (char*)lds, F.wave);
            }
        }
        if ((PHM & 128) && kind == 6) for (int rep = 0; rep < (l == 0 ? NREP(128) : 1); ++rep) {
            if (l == 0) for (int kq = 0; kq < 4; ++kq) {
                pg8::Gemm g{WSP(bf16_t, WS_HMIX) + (size_t)MLAT * DM + kq * 512, WSP(bf16_t, WS_WOUT) + kq * 512, DM, DM, 512, 1 << 20, 0};
                pg8::RangeOrder S; if (F.G >= 128) S.init(MCTX / 256, DM / 256, 32, F.bx - kq * 32); else S.init(MCTX / 256, DM / 256, F.G, F.bx);
                pg8::Epi E{}; E.kind = 3; E.out_ctx = WSP(float, WS_Q) + (size_t)kq * MCTX * DM;
                pg8::gemm_phase<pg8::Epi, pg8::RangeOrder, true, true>(lds3, g, S, E, F.wave);
            }
            { pg8::Gemm g{WSP(bf16_t, WS_HMIX), WSP(bf16_t, WS_WOUT) + (size_t)l * DM * DM, DM, DM, DM, 1 << 20, 0};
              pg8::StaticOrder S; S.init(MLAT / 256, DM / 256, F.G, F.bx);
              pg8::Epi E{}; E.kind = 2; E.mods = WSP(float, WS_MODS) + (size_t)l * 5 * 6144;
              E.xin_lat = (l == 0) ? F_IN(0) : (const float*)F_OUT; E.xin_ctx = nullptr; E.out_lat = F_OUT; E.out_ctx = nullptr;
              E.nw1 = F_IN(4) + DM; E.sc1 = WSP(float, WS_MODS) + (size_t)5 * 6144 + 2048;
              if (l == 0) { E.xb = WSP(bf16_t, WS_KV); E.ss = WSP(float, WS_SS); } else E.xbr = WSP(bf16_t, WS_KV);
              pg8::gemm_phase<pg8::Epi, pg8::StaticOrder, true, true>(lds3, g, S, E, F.wave); }
        }
        if (ph + 1 < hi) { FRESH_TID(tb_); xcd_barrier(bar, tb_); }
    }
}

constexpr int N_PHASES = 1 + 6 * NL;
extern "C" void kernel_launch(void* const* d_in, const int* in_sizes, int n_in, void* d_out, int out_size, void* d_ws, size_t ws_size, hipStream_t stream) {
    static int grid = 0;
    if (grid == 0) {
        if (n_in != 18 || out_size != MLAT * DM || ws_size < WS_END) { fprintf(stderr, "kernel_launch: unexpected shapes (n_in %d out %d ws %zu need %zu)\n", n_in, out_size, ws_size, (size_t)WS_END); grid = -1; return; }
        int dev = 0, cus = 0;
        if (hipGetDevice(&dev) != hipSuccess || hipDeviceGetAttribute(&cus, hipDeviceAttributeMultiprocessorCount, dev) != hipSuccess) { grid = -1; return; }
        if (hipFuncSetAttribute((const void*)fwd_kernel, hipFuncAttributeMaxDynamicSharedMemorySize, LDS_BYTES) != hipSuccess) { fprintf(stderr, "kernel_launch: hipFuncSetAttribute failed\n"); grid = -1; return; }
        if (cus != NCU) fprintf(stderr, "kernel_launch: built for %d CUs, device reports %d\n", NCU, cus);
        grid = NCU;
    }
    if (grid < 0) return;
    (void)hipMemsetAsync((char*)d_ws + WS_CTL, 0, 65536, stream);
    Args a{};
    for (int i = 0; i < 18; ++i) a.in[i] = d_in[i];
    a.out = (float*)d_out; a.ws = (unsigned char*)d_ws;
#if MK_ONE_LAUNCH
    a.ph_lo = 0; a.ph_hi = N_PHASES;
    hipLaunchKernelGGL(fwd_kernel, dim3(grid), dim3(NWAVES * 64), LDS_BYTES, stream, a);
#else
    for (int p = 0; p < N_PHASES; ++p) { a.ph_lo = p; a.ph_hi = p + 1; hipLaunchKernelGGL(fwd_kernel, dim3(grid), dim3(NWAVES * 64), LDS_BYTES, stream, a); }
#endif
}
```

```cpp
#include <hip/hip_runtime.h>
#include <hip/hip_bf16.h>
#include <cstdio>
#include <cstdint>
#include <cmath>

#ifndef MK_ONE_LAUNCH
#define MK_ONE_LAUNCH 1
#endif
#ifndef REP_EJ
#define REP_EJ 0
#endif
#ifndef REP_F
#define REP_F 0
#endif
#ifndef REP_P
#define REP_P 0
#endif

constexpr int DM = 2048, NB = 4, SEQ = 4096, NL = 2, CTX = 256;
constexpr int MLAT = NB * SEQ, MCTX = NB * CTX, MT = MLAT + MCTX;
constexpr int DIN = 4160, NIN = 4352;
constexpr int OFF_POOL = 0, OFF_PGATE = 512, OFF_FNET = 1024, OFF_FGATE = 1536, OFF_CQ = 2048, OFF_CKV = 2560, OFF_KROPE = 3072, OFF_MGATE = 3136;
constexpr int NH = 8, DQK = 192, NQ = NH * DQK, NKV = NH * 256;
constexpr int PCSW = 2304;
constexpr int DPITCH = SEQ + 64;
constexpr float EPS = 1e-6f;

constexpr size_t al256(size_t x) { return (x + 255) / 256 * 256; }
constexpr size_t WS_CTL = 0, CTL_BYTES = 1u << 20;
constexpr size_t WS_MODS = WS_CTL + CTL_BYTES;
constexpr size_t WS_ROPE = WS_MODS + al256((size_t)NL * 5 * 6144 * 4);
constexpr size_t WS_SMB = WS_ROPE + al256(64 * 16 * 2 * 4);
constexpr size_t WS_WIN = WS_SMB + 256;
constexpr size_t WS_WUQ = WS_WIN + (size_t)NL * NIN * DM * 2;
constexpr size_t WS_WUKV = WS_WUQ + (size_t)NL * NQ * 512 * 2;
constexpr size_t WS_WOUT = WS_WUKV + (size_t)NL * NKV * 512 * 2;
constexpr size_t WS_FWAB = WS_WOUT + (size_t)NL * DM * DM * 2;
constexpr size_t WS_DCTX = WS_FWAB + (size_t)NL * 512 * 512 * 2;
constexpr size_t WS_HMIX = WS_DCTX + 2 * 256 * 256 * 2;
constexpr size_t WS_P = WS_HMIX + (size_t)MT * DM * 2;
constexpr size_t WS_Q = WS_P + (size_t)MT * NIN * 2;
constexpr size_t WS_KV = WS_Q + (size_t)MT * NQ * 2;
constexpr size_t WS_XTC = WS_KV + (size_t)MT * NKV * 2;
constexpr size_t WS_XTS = WS_XTC + (size_t)1280 * DPITCH * 2;
constexpr size_t WS_XTCC = WS_XTS + (size_t)1024 * DPITCH * 2;
constexpr size_t WS_XTSC = WS_XTCC + (size_t)1280 * 256 * 2;
constexpr size_t WS_PCS = WS_XTSC + (size_t)1024 * 256 * 2;
constexpr size_t WS_PCSC = WS_PCS + (size_t)4096 * PCSW * 2;
constexpr size_t WS_CTXN = WS_PCSC + (size_t)256 * PCSW * 2;
constexpr size_t WS_KH = WS_CTXN + (size_t)MCTX * DM * 4;
constexpr size_t WS_SS = WS_KH + (size_t)MT * NQ * 2;
constexpr size_t WS_RS = WS_SS + (size_t)MLAT * 32 * 4;
constexpr size_t WS_BIAS = WS_RS + al256((size_t)MT * 4);
constexpr size_t WS_SQ = WS_BIAS + al256((size_t)5 * NIN * 4);
constexpr size_t WS_RH = WS_SQ + (size_t)18 * MT * 4;
constexpr size_t WS_END = WS_RH + (size_t)MT * 8 * 4;
static_assert((size_t)2 * 2048 * 2176 * 2 <= (size_t)NIN * DM * 2, "layer-1 DFT matrices fit layer 0's WinT");
static_assert(WS_END <= (size_t)512 * 1024 * 1024, "workspace map exceeds 512 MiB");

#define LAS __attribute__((address_space(3)))
typedef unsigned short bf16_t;
typedef short bf16x8 __attribute__((ext_vector_type(8)));
typedef short s16x4 __attribute__((ext_vector_type(4)));
typedef float f32x4 __attribute__((ext_vector_type(4)));
typedef float f32x2 __attribute__((ext_vector_type(2)));
typedef float f32x16 __attribute__((ext_vector_type(16)));
typedef unsigned u32x4 __attribute__((ext_vector_type(4)));
typedef unsigned u32x2 __attribute__((ext_vector_type(2)));
#define RLX_AGENT __ATOMIC_RELAXED, __HIP_MEMORY_SCOPE_AGENT

__device__ __forceinline__ int lane_id() { int r; asm volatile("v_mbcnt_lo_u32_b32 %0, -1, 0\n\tv_mbcnt_hi_u32_b32 %0, -1, %0" : "=v"(r)); return r; }
__device__ __forceinline__ unsigned f2bf(float f) { unsigned u = __builtin_bit_cast(unsigned, f); return (u + 0x7fffu + ((u >> 16) & 1u)) >> 16; }
__device__ __forceinline__ unsigned pk2(float lo, float hi) { return f2bf(lo) | (f2bf(hi) << 16); }
__device__ __forceinline__ float bf2f(unsigned short h) { return __builtin_bit_cast(float, (unsigned)h << 16); }
__device__ __forceinline__ float bflo(unsigned w) { return __builtin_bit_cast(float, w << 16); }
__device__ __forceinline__ float bfhi(unsigned w) { return __builtin_bit_cast(float, w & 0xffff0000u); }
__device__ __forceinline__ float siluf(float v) { return v * __builtin_amdgcn_rcpf(1.f + __builtin_amdgcn_exp2f(-1.4426950408889634f * v)); }
template <int O> __device__ __forceinline__ float lane_xor(float v) {
    return __builtin_bit_cast(float, __builtin_amdgcn_ds_swizzle(__builtin_bit_cast(int, v), (O << 10) | 0x1f));
}
__device__ __forceinline__ float wave_sum(float v) {
    v += lane_xor<1>(v); v += lane_xor<2>(v); v += lane_xor<4>(v); v += lane_xor<8>(v); v += lane_xor<16>(v);
    auto rr = __builtin_amdgcn_permlane32_swap(__float_as_uint(v), __float_as_uint(v), false, false);
    return __uint_as_float(rr[0]) + __uint_as_float(rr[1]);
}
__device__ __forceinline__ float wave_max(float v) {
    v = fmaxf(v, lane_xor<1>(v)); v = fmaxf(v, lane_xor<2>(v)); v = fmaxf(v, lane_xor<4>(v)); v = fmaxf(v, lane_xor<8>(v)); v = fmaxf(v, lane_xor<16>(v));
    auto rr = __builtin_amdgcn_permlane32_swap(__float_as_uint(v), __float_as_uint(v), false, false);
    return fmaxf(__uint_as_float(rr[0]), __uint_as_float(rr[1]));
}
__device__ __forceinline__ void st16_wt(void* p, u32x4 v) { asm volatile("global_store_dwordx4 %0, %1, off sc1\n\ts_nop 1" :: "v"(p), "v"(v) : "memory"); }
__device__ __forceinline__ void unpack8(const u32x4 w, float* f) {
    f[0] = bflo(w.x); f[1] = bfhi(w.x); f[2] = bflo(w.y); f[3] = bfhi(w.y); f[4] = bflo(w.z); f[5] = bfhi(w.z); f[6] = bflo(w.w); f[7] = bfhi(w.w);
}
__device__ __forceinline__ u32x4 pack8(const float* f) { u32x4 w; w.x = pk2(f[0], f[1]); w.y = pk2(f[2], f[3]); w.z = pk2(f[4], f[5]); w.w = pk2(f[6], f[7]); return w; }

namespace pg8 {
#define PG8_LAS __attribute__((address_space(3)))
constexpr int BM = 256, BK = 64, HALF = 128, HTB = HALF * BK * 2, STAGE_BYTES = 8 * HTB, NXCD = 8, WGM = 8;
__host__ __device__ __forceinline__ int lds_byte(int r, int c) { const int st = (r >> 4) * 2 + (c >> 5), rr = r & 15, cc = c & 31, ob = rr * 64 + cc * 2; return st * 1024 + (ob ^ (((ob >> 9) & 1) << 5)); }
__host__ __device__ __forceinline__ void stage_rc(int b, int& R, int& C) { const int st = b / 1024, sb = b % 1024, swz = sb ^ (((sb >> 9) & 1) << 5); R = (st >> 1) * 16 + swz / 64; C = (st & 1) * 32 + (swz % 64) / 2; }
__host__ __device__ __forceinline__ int perm32(int rho) { const int n = rho >> 4, i = rho & 15; return 8 * (i >> 2) + 4 * n + (i & 3); }

struct Unit { int pm, pn; };
struct Gemm { const bf16_t* A; const bf16_t* Bt; int lda, ldb, K, mper; long abatch; };

template <int WG_M> struct StaticOrderT {
    int nM, nN, nwg, G, c;
    __device__ void init(int nM_, int nN_, int G_, int c_) { nM = nM_; nN = nN_; nwg = nM * nN; G = G_; c = c_; }
    __device__ bool next(int i, Unit& u) const {
        const long L = (long)i * G + c; if (c < 0 || L >= nwg) return false;
        int wgid = (int)L; { const int q = nwg / NXCD, r = nwg % NXCD, xcd = wgid % NXCD, off = wgid / NXCD; wgid = (xcd < r ? xcd * (q + 1) : r * (q + 1) + (xcd - r) * q) + off; }
        const int nig = WG_M * nN, gid = wgid / nig, fm = gid * WG_M, rem = wgid - gid * nig;
        u.pm = fm + (rem % WG_M); u.pn = rem / WG_M; return true;
    }
};
typedef StaticOrderT<4> StaticOrder;
struct RangeOrder {
    int nM, nN, first, last, G, c;
    __device__ void init(int nM_, int nN_, int G_, int c_) { nM = nM_; nN = nN_; first = 0; last = nM_ * nN_; G = G_; c = (c_ >= 0 && c_ < G_) ? c_ : -1; }
    __device__ void init_range(int nM_, int nN_, int first_, int last_, int G_, int c_) { nM = nM_; nN = nN_; first = first_; last = last_; G = G_; c = (c_ >= 0 && c_ < G_) ? c_ : -1; }
    __device__ bool next(int i, Unit& u) const {
        if (c < 0) return false; const long L = (long)first + (long)i * G + c; if (L >= last) return false;
        u.pm = (int)(L % nM); u.pn = (int)(L / nM); return true;
    }
};

__device__ __forceinline__ unsigned cvt_pk_bf16(float lo, float hi) { unsigned r; asm volatile("v_cvt_pk_bf16_f32 %0, %1, %2" : "=v"(r) : "v"(lo), "v"(hi)); return r; }

struct Epi {
    static constexpr bool PERM = true, AFTER_DRAIN = false;
    int kind;
    bf16_t* O; int ldc; int rowoff; int cmul, cadd, csplit, cadd2;
    int mirror;
    bf16_t* xt_lat; bf16_t* xt_ctx;
    const float* kr2; bf16_t* kh; float* rh; const float* kw; const float* qwk; PG8_LAS float* part;
    const float* sq8; float* sqo;
    const float* rs; const float* bias;
    const bf16_t* P; const bf16_t* NY; const float* fw; int nseq, lgseq;
    const float* xin_lat; const float* xin_ctx; float* out_lat; float* out_ctx; const float* mods;
    const bf16_t* xbr;
    bf16_t* xb; const float* nw1; const float* sc1; float* ss;
    __device__ __forceinline__ void k4(f32x4 (&acc)[2][2][4][2], const Unit& u, int wr, int wc, int fr, int fq) const {
        const int row0 = u.pm * BM + wr * 64 + fr;
        const int cl0 = wc * 32 + 8 * fq;
        {
            const int h = u.pn, rowl0 = wr * 64 + fr;
#pragma unroll
            for (int ai = 0; ai < 2; ++ai) {
                float t[4][8], rr4[4];
#pragma unroll
                for (int m = 0; m < 4; ++m)
#pragma unroll
                    for (int k = 0; k < 8; ++k) t[m][k] = sq8[(size_t)k * MT + (row0 + ai * HALF + m * 16)];
#pragma unroll
                for (int m = 0; m < 4; ++m) rr4[m] = 1.0f / sqrtf((((t[m][0] + t[m][1]) + (t[m][2] + t[m][3])) + ((t[m][4] + t[m][5]) + (t[m][6] + t[m][7]))) * (1.f / 512.f) + EPS);
#pragma unroll
                for (int m = 0; m < 4; ++m) { const int rk = row0 + ai * HALF + m * 16; const float rr = rr4[m];
                    { const f32x4 v0 = acc[ai][1][m][0] * rr, v1 = acc[ai][1][m][1] * rr;
                      u32x4 w; w.x = cvt_pk_bf16(v0[0], v0[1]); w.y = cvt_pk_bf16(v0[2], v0[3]); w.z = cvt_pk_bf16(v1[0], v1[1]); w.w = cvt_pk_bf16(v1[2], v1[3]);
                      *(u32x4*)(O + (size_t)rk * ldc + h * 256 + HALF + cl0) = w; }
                    acc[ai][0][m][0] = acc[ai][0][m][0] * rr; acc[ai][0][m][1] = acc[ai][0][m][1] * rr;
                    const f32x4 k0 = acc[ai][0][m][0], k1 = acc[ai][0][m][1];
                    float sq = ((k0[0] * k0[0] + k0[1] * k0[1]) + (k0[2] * k0[2] + k0[3] * k0[3])) + ((k1[0] * k1[0] + k1[1] * k1[1]) + (k1[2] * k1[2] + k1[3] * k1[3]));
                    sq += lane_xor<16>(sq);
                    { auto pr = __builtin_amdgcn_permlane32_swap(__float_as_uint(sq), __float_as_uint(sq), false, false); sq = __uint_as_float(pr[0]) + __uint_as_float(pr[1]); }
                    if (fq == 0) part[wc * 256 + rowl0 + ai * HALF + m * 16] = sq; }
            }
            float krs[2][4];
#pragma unroll
            for (int ai = 0; ai < 2; ++ai)
#pragma unroll
                for (int m = 0; m < 4; ++m) { const int rk = row0 + ai * HALF + m * 16; typedef const __attribute__((address_space(1))) float* gfp;
                    krs[ai][m] = ((gfp)kr2)[rk] + ((gfp)kr2)[(size_t)MT + rk]; }
            asm volatile("s_waitcnt lgkmcnt(0)" ::: "memory");
            __builtin_amdgcn_s_barrier();
            const f32x4 kw0 = *(const f32x4*)(kw + cl0) * *(const f32x4*)(qwk + cl0), kw1 = *(const f32x4*)(kw + cl0 + 4) * *(const f32x4*)(qwk + cl0 + 4);
#pragma unroll
            for (int ai = 0; ai < 2; ++ai)
#pragma unroll
                for (int m = 0; m < 4; ++m) { const int rk = row0 + ai * HALF + m * 16, rl = rowl0 + ai * HALF + m * 16;
                    const float tot = ((part[rl] + part[256 + rl]) + (part[512 + rl] + part[768 + rl])) + krs[ai][m];
                    const float rhv = 1.0f / sqrtf(tot * (1.f / 192.f) + EPS);
                    if (wc == 0 && fq == 0) rh[(size_t)rk * 8 + h] = rhv;
                    const f32x4 k0 = acc[ai][0][m][0] * rhv * kw0, k1 = acc[ai][0][m][1] * rhv * kw1;
                    u32x4 w; w.x = cvt_pk_bf16(k0[0], k0[1]); w.y = cvt_pk_bf16(k0[2], k0[3]); w.z = cvt_pk_bf16(k1[0], k1[1]); w.w = cvt_pk_bf16(k1[2], k1[3]);
                    *(u32x4*)(kh + (size_t)rk * (8 * 192) + h * 192 + cl0) = w; }
        }
    }
    __device__ __forceinline__ void operator()(f32x4 (&acc)[2][2][4][2], const Unit& u, int wr, int wc, int fr, int fq) const {
        const int row0 = u.pm * BM + wr * 64 + fr;
        const int cl0 = wc * 32 + 8 * fq;
        if (kind == 0 && xt_lat && (u.pn == 4 || u.pn == 5)) {
            const bool lat = u.pm < MLAT / 256;
            const int b = lat ? (u.pm >> 4) : (u.pm - MLAT / 256);
            const int nseq = lat ? DPITCH : CTX;
            bf16_t* XC = lat ? xt_lat : xt_ctx; bf16_t* XS = XC + (size_t)1280 * nseq;
            const int tok0 = (lat ? (u.pm & 15) * 256 : 0) + wr * 64 + fr;
            float rv[2][4];
#pragma unroll
            for (int ai = 0; ai < 2; ++ai)
#pragma unroll
                for (int m = 0; m < 4; ++m) rv[ai][m] = rs ? rs[row0 + ai * HALF + m * 16] : 1.f;
#pragma unroll
            for (int bj = 0; bj < 2; ++bj) {
                const int n0 = (u.pn - 4) * BM + bj * HALF + cl0, g = n0 >> 7, j0 = n0 & 127;
                f32x4 bz[2]; bz[0] = (f32x4){0.f, 0.f, 0.f, 0.f}; bz[1] = bz[0];
                if (rs) { const float* bp = bias + (size_t)(lat ? b : 4) * NIN + u.pn * BM + bj * HALF + cl0; bz[0] = *(const f32x4*)bp; bz[1] = *(const f32x4*)(bp + 4); }
                bf16_t* base = (j0 < 64 ? XC + (size_t)(b * 256 + g * 64 + j0) * nseq : XS + (size_t)(b * 256 + g * 64 + (j0 - 64)) * nseq) + tok0;
                bf16_t* nyq = XC + (size_t)(1024 + b * 4 + g) * nseq + tok0;
#pragma unroll
                for (int ai = 0; ai < 2; ++ai)
#pragma unroll
                    for (int m = 0; m < 4; ++m) { const int to = ai * HALF + m * 16;
#pragma unroll
                        for (int n = 0; n < 2; ++n)
#pragma unroll
                            for (int e = 0; e < 4; ++e) base[(size_t)(4 * n + e) * nseq + to] = (bf16_t)f2bf(acc[ai][bj][m][n][e] * rv[ai][m] + bz[n][e]);
                        if (j0 == 64) nyq[to] = (bf16_t)f2bf(acc[ai][bj][m][0][0] * rv[ai][m] + bz[0][0]); }
            }
        } else if (kind == 0) {
            const int dcol = (u.pn < csplit ? u.pn * cmul + cadd : cadd2) + cl0;
            f32x4 bz[2][2];
#pragma unroll
            for (int bj = 0; bj < 2; ++bj) { bz[bj][0] = (f32x4){0.f, 0.f, 0.f, 0.f}; bz[bj][1] = bz[bj][0]; }
            if (rs) { const float* bp = bias + (size_t)(row0 < MLAT ? (row0 >> 12) : 4) * NIN + dcol;
#pragma unroll
                for (int bj = 0; bj < 2; ++bj) { bz[bj][0] = *(const f32x4*)(bp + bj * HALF); bz[bj][1] = *(const f32x4*)(bp + bj * HALF + 4); } }
            const bool wsq = sqo != nullptr && ((u.pn >= 8 && u.pn < 12) || (u.pn == 12 && wc < 2));
#pragma unroll
            for (int ai = 0; ai < 2; ++ai) {
                float rr4[4];
                if (sq8) {
                    float t[4][8];
#pragma unroll
                    for (int m = 0; m < 4; ++m)
#pragma unroll
                        for (int k = 0; k < 8; ++k) t[m][k] = sq8[(size_t)k * MT + (rowoff + row0 + ai * HALF + m * 16)];
#pragma unroll
                    for (int m = 0; m < 4; ++m) rr4[m] = 1.0f / sqrtf((((t[m][0] + t[m][1]) + (t[m][2] + t[m][3])) + ((t[m][4] + t[m][5]) + (t[m][6] + t[m][7]))) * (1.f / 512.f) + EPS);
                } else {
#pragma unroll
                    for (int m = 0; m < 4; ++m) rr4[m] = rs ? rs[rowoff + row0 + ai * HALF + m * 16] : 1.f;
                }
#pragma unroll
                for (int m = 0; m < 4; ++m) { const int rk = rowoff + row0 + ai * HALF + m * 16; bf16_t* rowp = O + (size_t)rk * ldc + dcol;
                    bf16_t* mirp = O + (size_t)(SEQ - rk) * ldc + dcol; const unsigned sx = (mirror < 0) ? 0x80008000u : 0u;
                    const float rr = rr4[m]; float sq = 0.f;
#pragma unroll
                    for (int bj = 0; bj < 2; ++bj) { const f32x4 v0 = acc[ai][bj][m][0] * rr + bz[bj][0], v1 = acc[ai][bj][m][1] * rr + bz[bj][1];
                        u32x4 w; w.x = cvt_pk_bf16(v0[0], v0[1]); w.y = cvt_pk_bf16(v0[2], v0[3]); w.z = cvt_pk_bf16(v1[0], v1[1]); w.w = cvt_pk_bf16(v1[2], v1[3]);
                        const bool st = dcol + bj * HALF < DIN && !(mirror > 0 && u.pn >= csplit && cl0 + bj * HALF >= 16);
                        if (st) *(u32x4*)(rowp + bj * HALF) = w;
                        if (st && mirror != 0 && rk > 0) { u32x4 wm; wm.x = w.x ^ sx; wm.y = w.y ^ sx; wm.z = w.z ^ sx; wm.w = w.w ^ sx; *(u32x4*)(mirp + bj * HALF) = wm; }
                        if (wsq && (u.pn != 12 || bj == 0)) sq += ((v0[0] * v0[0] + v0[1] * v0[1]) + (v0[2] * v0[2] + v0[3] * v0[3])) + ((v1[0] * v1[0] + v1[1] * v1[1]) + (v1[2] * v1[2] + v1[3] * v1[3])); }
                    if (wsq) { sq += lane_xor<16>(sq);
                        { auto pr = __builtin_amdgcn_permlane32_swap(__float_as_uint(sq), __float_as_uint(sq), false, false); sq = __uint_as_float(pr[0]) + __uint_as_float(pr[1]); }
                        if (fq == 0) sqo[(size_t)((u.pn - 8) * 4 + wc) * MT + rk] = sq; } }
            }
        } else if (kind == 1) {
#pragma unroll
            for (int bj = 0; bj < 2; ++bj) {
                const int n0 = u.pn * BM + bj * HALF + cl0;
                const int g = n0 >> 7, d0 = n0 & 127;
                const f32x4 f0 = *(const f32x4*)(fw + (size_t)(g * 128 + 64) * 128 + d0), f1 = *(const f32x4*)(fw + (size_t)(g * 128 + 64) * 128 + d0 + 4);
                u32x4 gw[2][4]; unsigned short nyb[2][4];
#pragma unroll
                for (int ai = 0; ai < 2; ++ai)
#pragma unroll
                    for (int m = 0; m < 4; ++m) { const int rl = row0 + ai * HALF + m * 16; const int b = rl >> lgseq, k = rl & (nseq - 1);
                        nyb[ai][m] = NY[(size_t)k * PCSW + 2048 + b * 4 + g]; gw[ai][m] = *(const u32x4*)(P + ((size_t)rowoff + rl) * NIN + OFF_FGATE + n0); }
                asm volatile("" ::: "memory");
#pragma unroll
                for (int ai = 0; ai < 2; ++ai)
#pragma unroll
                    for (int m = 0; m < 4; ++m) {
                        const size_t R = (size_t)rowoff + row0 + ai * HALF + m * 16;
                        const float ny = bf2f(nyb[ai][m]);
                        float gt[8]; unpack8(gw[ai][m], gt);
                        const f32x4 v0 = acc[ai][bj][m][0], v1 = acc[ai][bj][m][1];
                        float o[8];
#pragma unroll
                        for (int e = 0; e < 4; ++e) { o[e] = (v0[e] + ny * f0[e]) * siluf(gt[e]); o[4 + e] = (v1[e] + ny * f1[e]) * siluf(gt[4 + e]); }
                        u32x4 w; w.x = cvt_pk_bf16(o[0], o[1]); w.y = cvt_pk_bf16(o[2], o[3]); w.z = cvt_pk_bf16(o[4], o[5]); w.w = cvt_pk_bf16(o[6], o[7]);
                        *(u32x4*)(O + R * ldc + 512 + n0) = w;
                    }
                asm volatile("" ::: "memory");
            }
        } else if (kind == 3) {
#pragma unroll
            for (int ai = 0; ai < 2; ++ai)
#pragma unroll
                for (int m = 0; m < 4; ++m) { float* xo = out_ctx + (size_t)(row0 + ai * HALF + m * 16) * DM + u.pn * BM + cl0;
#pragma unroll
                    for (int bj = 0; bj < 2; ++bj)
#pragma unroll
                        for (int n = 0; n < 2; ++n) *(f32x4*)(xo + bj * HALF + 4 * n) = acc[ai][bj][m][n]; }
        } else {
            const int R0 = row0;
            const bool lat = R0 < MLAT;
            const int mr = lat ? (R0 >> 12) : 4;
            const float* xi0 = (lat ? xin_lat + (size_t)R0 * DM : xin_ctx + (size_t)(R0 - MLAT) * DM) + u.pn * BM + cl0;
            float* xo0 = (lat ? out_lat + (size_t)R0 * DM : out_ctx + (size_t)(R0 - MLAT) * DM) + u.pn * BM + cl0;
            const float* gp = mods + (size_t)mr * 6144 + 4096 + u.pn * BM + cl0;
            f32x4 gv[2][2], cf[2][2];
#pragma unroll
            for (int bj = 0; bj < 2; ++bj)
#pragma unroll
                for (int n = 0; n < 2; ++n) { gv[bj][n] = *(const f32x4*)(gp + bj * HALF + 4 * n); cf[bj][n] = gv[bj][n]; }
            if (xb || xbr) { const float* n1 = nw1 + u.pn * BM + cl0; const float* s1 = sc1 + (size_t)mr * 6144 + u.pn * BM + cl0;
#pragma unroll
                for (int bj = 0; bj < 2; ++bj)
#pragma unroll
                    for (int n = 0; n < 2; ++n) cf[bj][n] = *(const f32x4*)(n1 + bj * HALF + 4 * n) * (*(const f32x4*)(s1 + bj * HALF + 4 * n) + 1.f); }
            if (xb) {
#pragma unroll
                for (int ch = 0; ch < 3; ++ch) {
                    constexpr int NCH = 3;
                    f32x4 xv[NCH][2][2];
#pragma unroll
                    for (int mm = 0; mm < NCH; ++mm) { const int q = ch * NCH + mm; if (q < 8) { const int ai = q >> 2, m = q & 3;
#pragma unroll
                            for (int bj = 0; bj < 2; ++bj)
#pragma unroll
                                for (int n = 0; n < 2; ++n) xv[mm][bj][n] = *(const f32x4*)(xi0 + (size_t)(ai * HALF + m * 16) * DM + bj * HALF + 4 * n); } }
                    asm volatile("" ::: "memory");
#pragma unroll
                    for (int mm = 0; mm < NCH; ++mm) { const int q = ch * NCH + mm; if (q < 8) { const int ai = q >> 2, m = q & 3; const size_t R = (size_t)(R0 + ai * HALF + m * 16); float sq = 0.f;
#pragma unroll
                            for (int bj = 0; bj < 2; ++bj) { const f32x4 o0 = xv[mm][bj][0] + gv[bj][0] * acc[ai][bj][m][0], o1 = xv[mm][bj][1] + gv[bj][1] * acc[ai][bj][m][1];
                                sq += ((o0[0] * o0[0] + o0[1] * o0[1]) + (o0[2] * o0[2] + o0[3] * o0[3])) + ((o1[0] * o1[0] + o1[1] * o1[1]) + (o1[2] * o1[2] + o1[3] * o1[3]));
                                const f32x4 h0 = o0 * cf[bj][0], h1 = o1 * cf[bj][1];
                                u32x4 w; w.x = cvt_pk_bf16(h0[0], h0[1]); w.y = cvt_pk_bf16(h0[2], h0[3]); w.z = cvt_pk_bf16(h1[0], h1[1]); w.w = cvt_pk_bf16(h1[2], h1[3]);
                                *(u32x4*)(xb + R * DM + u.pn * BM + cl0 + bj * HALF) = w; }
                            sq += lane_xor<16>(sq);
                            { auto pr = __builtin_amdgcn_permlane32_swap(__float_as_uint(sq), __float_as_uint(sq), false, false); sq = __uint_as_float(pr[0]) + __uint_as_float(pr[1]); }
                            if (fq == 0) ss[(size_t)(u.pn * 4 + wc) * MLAT + R] = sq; } }
                    asm volatile("" ::: "memory");
                }
            } else {
                f32x4 rcf[2][2];
#pragma unroll
                for (int bj = 0; bj < 2; ++bj)
#pragma unroll
                    for (int n = 0; n < 2; ++n)
#pragma unroll
                        for (int e = 0; e < 4; ++e) rcf[bj][n][e] = cf[bj][n][e] != 0.f ? __builtin_amdgcn_rcpf(cf[bj][n][e]) : 0.f;
                const bf16_t* xr0 = xbr + (size_t)R0 * DM + u.pn * BM + cl0;
#pragma unroll
            for (int ai = 0; ai < 2; ++ai) {
                u32x4 xw[4][2];
#pragma unroll
                for (int m = 0; m < 4; ++m)
#pragma unroll
                    for (int bj = 0; bj < 2; ++bj) xw[m][bj] = *(const u32x4*)(xr0 + (size_t)(ai * HALF + m * 16) * DM + bj * HALF);
                asm volatile("" ::: "memory");
#pragma unroll
                for (int m = 0; m < 4; ++m)
#pragma unroll
                    for (int bj = 0; bj < 2; ++bj) { float xf[8]; unpack8(xw[m][bj], xf);
                        const f32x4 x0 = {xf[0], xf[1], xf[2], xf[3]}, x1 = {xf[4], xf[5], xf[6], xf[7]};
                        *(f32x4*)(xo0 + (size_t)(ai * HALF + m * 16) * DM + bj * HALF) = x0 * rcf[bj][0] + gv[bj][0] * acc[ai][bj][m][0];
                        *(f32x4*)(xo0 + (size_t)(ai * HALF + m * 16) * DM + bj * HALF + 4) = x1 * rcf[bj][1] + gv[bj][1] * acc[ai][bj][m][1]; }
                asm volatile("" ::: "memory");
            }
            }
        }
    }
};

struct Epi4 {
    static constexpr bool PERM = true, AFTER_DRAIN = false;
    Epi e;
    __device__ __forceinline__ void prefetch(const Unit&, int, PG8_LAS unsigned char*) const {}
    __device__ __forceinline__ void operator()(f32x4 (&acc)[2][2][4][2], const Unit& u, int wr, int wc, int fr, int fq) const { e.k4(acc, u, wr, wc, fr, fq); }
};

template <class Epi, class Sched, bool ALIGN_EPI = false, bool SP2 = false>
__device__ __forceinline__ void gemm_phase(PG8_LAS unsigned char* lds, const Gemm g, const Sched& S, const Epi& E, int wave_) {
    int tid_ = wave_ * 64 + lane_id(); asm volatile("" : "+v"(tid_));
    const int tid = tid_, wid = __builtin_amdgcn_readfirstlane(tid >> 6), lane = tid & 63, wr = wid >> 2, wc = wid & 3, fr = lane & 15, fq = lane >> 4;
    const int K = g.K, nt = K / BK;
    unsigned voffA[2], voffB[2];
#pragma unroll
    for (int i = 0; i < 2; ++i) { int R, C; stage_rc(tid * 16 + i * 8192, R, C); const int Rb = Epi::PERM ? ((R & ~31) + perm32(R & 31)) : R;
        voffA[i] = (unsigned)(R * g.lda + C) * 2u; voffB[i] = (unsigned)(Rb * g.ldb + C) * 2u; }
    const size_t kstep = (size_t)(BK * 2);
    const size_t hA = (size_t)HALF * g.lda * 2, hB = (size_t)HALF * g.ldb * 2;
    const unsigned ldsw = (unsigned)wid * 1024u;
    const int aoff = lds_byte(wr * 64 + fr, fq * 8), boff = lds_byte(wc * 32 + fr, fq * 8);
#define PG8_TA(pm) ((const char*)g.A + ((size_t)((pm) % g.mper) * 2 * hA + (size_t)((pm) / g.mper) * (size_t)g.abatch * 2))
#define PG8_TB(pn) ((const char*)g.Bt + (size_t)(pn) * 2 * hB)
#define PG8_SA(b, h) (((b) * 2 + (h)) * HTB)
#define PG8_SB(b, h) ((4 + (b) * 2 + (h)) * HTB)
#define PG8_STAGE(bufoff, gbase, voff) do { _Pragma("unroll") for (int _i = 0; _i < 2; ++_i) \
        __builtin_amdgcn_global_load_lds((const unsigned*)((const char*)(gbase) + (voff)[_i]), (PG8_LAS unsigned*)(lds + (bufoff) + ldsw + _i * 8192), 16, 0, 0); } while (0)
#define PG8_LDA(dst, b, h) do { _Pragma("unroll") for (int m = 0; m < 4; ++m) _Pragma("unroll") for (int k = 0; k < 2; ++k) dst[m][k] = *(const PG8_LAS bf16x8*)(lds + PG8_SA(b, h) + aoff + m * 2048 + k * 1024); } while (0)
#define PG8_LDB(dst, b, h) do { _Pragma("unroll") for (int n = 0; n < 2; ++n) _Pragma("unroll") for (int k = 0; k < 2; ++k) dst[n][k] = *(const PG8_LAS bf16x8*)(lds + PG8_SB(b, h) + boff + n * 2048 + k * 1024); } while (0)
#define PG8_MMA(ai, bj, At, Bt) do { __builtin_amdgcn_s_setprio(1); _Pragma("unroll") for (int m = 0; m < 4; ++m) _Pragma("unroll") for (int n = 0; n < 2; ++n) _Pragma("unroll") for (int k = 0; k < 2; ++k) \
        acc[ai][bj][m][n] = __builtin_amdgcn_mfma_f32_16x16x32_bf16(Bt[n][k], At[m][k], acc[ai][bj][m][n], 0, 0, 0); __builtin_amdgcn_s_setprio(0); } while (0)
#define PG8_WAIT_V(n) asm volatile("s_waitcnt vmcnt(" #n ")" ::: "memory")
#define PG8_WAIT_L(n) asm volatile("s_waitcnt lgkmcnt(" #n ")" ::: "memory")
#define PG8_BAR __builtin_amdgcn_s_barrier()
#define PG8_SCHED __builtin_amdgcn_sched_barrier(0)
    Unit cur, nxt; int ui = 0;
    if (!S.next(0, cur)) return;
    f32x4 acc[2][2][4][2];
#pragma unroll
    for (int a = 0; a < 2; ++a)
#pragma unroll
        for (int b = 0; b < 2; ++b)
#pragma unroll
            for (int m = 0; m < 4; ++m)
#pragma unroll
                for (int n = 0; n < 2; ++n) acc[a][b][m][n] = (f32x4){0.f, 0.f, 0.f, 0.f};
    bf16x8 At[4][2], B0[2][2], B1[2][2];
    const char* cA = PG8_TA(cur.pm); const char* cB = PG8_TB(cur.pn);
    if constexpr (SP2) {
        PG8_STAGE(PG8_SB(0, 0), cB, voffB); PG8_STAGE(PG8_SB(0, 1), cB + hB, voffB); PG8_STAGE(PG8_SA(0, 0), cA, voffA); PG8_STAGE(PG8_SA(0, 1), cA + hA, voffA);
        if (wr == 1) PG8_BAR;
        PG8_WAIT_V(2); PG8_BAR;
        PG8_STAGE(PG8_SB(1, 0), cB + kstep, voffB); PG8_STAGE(PG8_SA(1, 0), cA + kstep, voffA); PG8_STAGE(PG8_SB(1, 1), cB + hB + kstep, voffB);
        PG8_WAIT_V(6); PG8_BAR;
    } else {
        PG8_STAGE(PG8_SB(0, 0), cB, voffB); PG8_STAGE(PG8_SA(0, 0), cA, voffA); PG8_STAGE(PG8_SB(0, 1), cB + hB, voffB); PG8_STAGE(PG8_SA(0, 1), cA + hA, voffA);
        if (wr == 1) PG8_BAR;
        PG8_WAIT_V(4); PG8_BAR;
        PG8_STAGE(PG8_SB(1, 0), cB + kstep, voffB); PG8_STAGE(PG8_SA(1, 0), cA + kstep, voffA); PG8_STAGE(PG8_SB(1, 1), cB + hB + kstep, voffB);
        PG8_WAIT_V(6); PG8_BAR;
    }
    for (;;) {
        const bool has_next = S.next(ui + 1, nxt);
        const char* nA = has_next ? PG8_TA(nxt.pm) : cA; const char* nB = has_next ? PG8_TB(nxt.pn) : cB;
        for (int t = 0; t < nt; t += 2) {
            const bool last = (t == nt - 2);
            const char* a1 = cA + (size_t)(t + 1) * kstep;
            const char* a2 = last ? nA : cA + (size_t)(t + 2) * kstep; const char* b2 = last ? nB : cB + (size_t)(t + 2) * kstep;
            const char* a3 = a2 + kstep; const char* b3 = b2 + kstep;
            if constexpr (SP2) {
            PG8_LDB(B0, 0, 0); PG8_LDB(B1, 0, 1); PG8_SCHED; PG8_LDA(At, 0, 0); PG8_STAGE(PG8_SA(1, 1), a1 + hA, voffA);
            PG8_WAIT_V(8); PG8_WAIT_L(0); PG8_BAR; PG8_MMA(0, 0, At, B0); PG8_MMA(0, 1, At, B1); PG8_BAR; PG8_SCHED;
            PG8_LDA(At, 0, 1); PG8_STAGE(PG8_SB(0, 0), b2, voffB); PG8_STAGE(PG8_SB(0, 1), b2 + hB, voffB); PG8_STAGE(PG8_SA(0, 0), a2, voffA);
            PG8_WAIT_V(8); PG8_WAIT_L(0); PG8_BAR; PG8_MMA(1, 0, At, B0); PG8_MMA(1, 1, At, B1); PG8_BAR; PG8_SCHED;
            PG8_LDB(B0, 1, 0); PG8_LDB(B1, 1, 1); PG8_SCHED; PG8_LDA(At, 1, 0); PG8_STAGE(PG8_SA(0, 1), a2 + hA, voffA);
            PG8_WAIT_V(8); PG8_WAIT_L(0); PG8_BAR; PG8_MMA(0, 0, At, B0); PG8_MMA(0, 1, At, B1); PG8_BAR; PG8_SCHED;
            PG8_LDA(At, 1, 1); PG8_STAGE(PG8_SB(1, 0), b3, voffB); PG8_STAGE(PG8_SB(1, 1), b3 + hB, voffB); PG8_STAGE(PG8_SA(1, 0), a3, voffA);
            PG8_WAIT_V(8); PG8_WAIT_L(0); PG8_BAR; PG8_MMA(1, 0, At, B0); PG8_MMA(1, 1, At, B1); PG8_BAR; PG8_SCHED;
            } else {
            PG8_LDB(B0, 0, 0); PG8_SCHED; PG8_LDA(At, 0, 0); PG8_STAGE(PG8_SA(1, 1), a1 + hA, voffA);
            PG8_WAIT_L(8); PG8_BAR; PG8_WAIT_L(0); PG8_MMA(0, 0, At, B0); PG8_BAR; PG8_SCHED;
            PG8_LDB(B1, 0, 1); PG8_STAGE(PG8_SB(0, 0), b2, voffB);
            PG8_BAR; PG8_WAIT_L(0); PG8_MMA(0, 1, At, B1); PG8_BAR;
            PG8_LDA(At, 0, 1); PG8_STAGE(PG8_SA(0, 0), a2, voffA);
            PG8_BAR; PG8_WAIT_L(0); PG8_MMA(1, 0, At, B0); PG8_BAR; PG8_SCHED;
            PG8_STAGE(PG8_SB(0, 1), b2 + hB, voffB);
            PG8_WAIT_V(6); PG8_BAR; PG8_MMA(1, 1, At, B1); PG8_BAR;
            PG8_LDB(B0, 1, 0); PG8_SCHED; PG8_LDA(At, 1, 0); PG8_STAGE(PG8_SA(0, 1), a2 + hA, voffA);
            PG8_WAIT_L(8); PG8_BAR; PG8_WAIT_L(0); PG8_MMA(0, 0, At, B0); PG8_BAR; PG8_SCHED;
            PG8_LDB(B1, 1, 1); PG8_STAGE(PG8_SB(1, 0), b3, voffB);
            PG8_BAR; PG8_WAIT_L(0); PG8_MMA(0, 1, At, B1); PG8_BAR;
            PG8_LDA(At, 1, 1); PG8_STAGE(PG8_SA(1, 0), a3, voffA);
            PG8_BAR; PG8_WAIT_L(0); PG8_MMA(1, 0, At, B0); PG8_BAR; PG8_SCHED;
            PG8_STAGE(PG8_SB(1, 1), b3 + hB, voffB);
            PG8_WAIT_V(6); PG8_BAR; PG8_MMA(1, 1, At, B1); PG8_BAR;
            }
        }
        if constexpr (ALIGN_EPI) { if (wr == 0) PG8_BAR; }
        { int te_ = wave_ * 64 + lane_id(); asm volatile("" : "+v"(te_));
          E(acc, cur, wr, wc, te_ & 15, (te_ & 63) >> 4); }
        if (!has_next) break;
#pragma unroll
        for (int a = 0; a < 2; ++a)
#pragma unroll
            for (int b = 0; b < 2; ++b)
#pragma unroll
                for (int m = 0; m < 4; ++m)
#pragma unroll
                    for (int n = 0; n < 2; ++n) acc[a][b][m][n] = (f32x4){0.f, 0.f, 0.f, 0.f};
        cur = nxt; cA = nA; cB = nB; ++ui;
        if constexpr (ALIGN_EPI) { if (wr == 1) PG8_BAR; }
    }
    PG8_WAIT_V(0);
    if constexpr (!ALIGN_EPI) { if (wr == 0) PG8_BAR; }
    PG8_BAR;
#undef PG8_TA
#undef PG8_TB
#undef PG8_SA
#undef PG8_SB
#undef PG8_STAGE
#undef PG8_LDA
#undef PG8_LDB
#undef PG8_MMA
#undef PG8_WAIT_V
#undef PG8_WAIT_L
#undef PG8_BAR
#undef PG8_SCHED
}
}

namespace att {
constexpr int NW = 8, QBLK = 32, KVBLK = 64;
constexpr float SCALE = 0.07216878364870322f;
#ifndef ATT_SDEPTH
#define ATT_SDEPTH 1
#endif
constexpr int SDEPTH = ATT_SDEPTH;
#ifndef ATT_QKT_GRP
#define ATT_QKT_GRP 4
#endif
constexpr int QKT_GRP = ATT_QKT_GRP;
constexpr int LDQ = NQ, LDKK = NQ, LDV = NKV;
constexpr int KPITCH = 400;
constexpr int SHM_V = KVBLK * 128 * 2, SHM_K = KVBLK * KPITCH;
constexpr int SHM_QR = 2 * SHM_V + 2 * SHM_K + NW * 64 * 4;
#ifndef ATT_NQR
#define ATT_NQR 8
#endif
constexpr int NQR = ATT_NQR, QLB = (12 - NQR) * 1024;
constexpr int SHM_ATTN = SHM_QR + NW * QLB;
#define KSWZ(row, colB) ((row) * KPITCH + (colB))
#define SBAR() __builtin_amdgcn_sched_barrier(0)
__device__ __forceinline__ int crow(int r, int hi) { return (r & 3) + 8 * (r >> 2) + 4 * hi; }
__device__ __forceinline__ unsigned cvtpk(float lo, float hi) { unsigned r; asm volatile("v_cvt_pk_bf16_f32 %0, %1, %2" : "=v"(r) : "v"(lo), "v"(hi)); return r; }

__device__ __forceinline__ void partialSM(f32x16& p0, f32x16& p1, float) {
#pragma unroll
    for (int r = 0; r < 16; ++r) p0[r] = __builtin_amdgcn_exp2f(p0[r]);
}
__device__ __forceinline__ void finishSM(f32x16& p0, f32x16& p1, float& l_reg, bf16x8& pa0, bf16x8& pa1, bf16x8& pa2, bf16x8& pa3) {
#pragma unroll
    for (int r = 0; r < 16; ++r) p1[r] = __builtin_amdgcn_exp2f(p1[r]);
    float s0 = p0[0] + p1[0], s1 = p0[1] + p1[1], s2 = p0[2] + p1[2], s3 = p0[3] + p1[3];
#pragma unroll
    for (int r = 4; r < 16; r += 4) { s0 += p0[r] + p1[r]; s1 += p0[r + 1] + p1[r + 1]; s2 += p0[r + 2] + p1[r + 2]; s3 += p0[r + 3] + p1[r + 3]; }
    l_reg += (s0 + s1) + (s2 + s3);
#define PK4(P, BASE, OUT) do { unsigned a0 = cvtpk(P[BASE + 0], P[BASE + 1]), a1 = cvtpk(P[BASE + 2], P[BASE + 3]);   \
    unsigned b0 = cvtpk(P[BASE + 4], P[BASE + 5]), b1 = cvtpk(P[BASE + 6], P[BASE + 7]);                              \
    auto r0 = __builtin_amdgcn_permlane32_swap(a0, b0, false, false); auto r1 = __builtin_amdgcn_permlane32_swap(a1, b1, false, false); \
    u32x4 w = {r0[0], r1[0], r0[1], r1[1]}; OUT = *reinterpret_cast<bf16x8*>(&w); } while (0)
    PK4(p0, 0, pa0); PK4(p0, 8, pa1); PK4(p1, 0, pa2); PK4(p1, 8, pa3);
#undef PK4
}
template <int OFF> __device__ __forceinline__ void lds_rd128(bf16x8& d, unsigned a) { asm volatile("ds_read_b128 %0, %1 offset:%2" : "=v"(d) : "v"(a), "i"(OFF) : "memory"); }
template <int N> __device__ __forceinline__ void lds_wait2(bf16x8& a, bf16x8& b) { asm volatile("s_waitcnt lgkmcnt(%2)" : "+v"(a), "+v"(b) : "i"(N) : "memory"); }
template <int N> __device__ __forceinline__ void lds_wait3(bf16x8& a, bf16x8& b, bf16x8& c) { asm volatile("s_waitcnt lgkmcnt(%3)" : "+v"(a), "+v"(b), "+v"(c) : "i"(N) : "memory"); }
constexpr int qkt_cnt(int d0) { return (d0 > 11) ? 0 : ((d0 >= NQR) ? 3 : 2); }
template <int KOFF, int D0> struct QktStep {
    static __device__ __forceinline__ void load(bf16x8& k0, bf16x8& k1, bf16x8& q, unsigned kad, unsigned qa) {
        lds_rd128<KOFF + D0 * 32>(k0, kad); lds_rd128<KOFF + 32 * KPITCH + D0 * 32>(k1, kad);
        if constexpr (D0 >= NQR) lds_rd128<(D0 - NQR) * 1024>(q, qa);
    }
};
struct DmaPlan { const char* kb; const char* vb; LAS unsigned char* kdst; LAS unsigned char* vdst; unsigned koff0, koff1, koff2, voff0, voff1; int wave; bool dok, dov; };
template <int I> __device__ __forceinline__ void dma_piece(const DmaPlan& d) {
    if constexpr (I < 3) { if (d.dok) __builtin_amdgcn_global_load_lds((const unsigned*)(d.kb + (I == 0 ? d.koff0 : I == 1 ? d.koff1 : d.koff2)), (LAS unsigned*)(d.kdst + (d.wave + 8 * I) * 1024), 16, 0, 0); }
    else if constexpr (I == 3) { if (d.dok && d.wave == 0) { const int p_ = 24 * 64 + lane_id(), r_ = p_ / 25, c_ = p_ - r_ * 25;
            __builtin_amdgcn_global_load_lds((const unsigned*)(d.kb + (unsigned)(r_ * LDKK * 2 + c_ * 16)), (LAS unsigned*)(d.kdst + 24 * 1024), 16, 0, 0); } }
    else { if (d.dov) __builtin_amdgcn_global_load_lds((const unsigned*)(d.vb + (I == 4 ? d.voff0 : d.voff1)), (LAS unsigned*)(d.vdst + (d.wave * 2 + (I - 4)) * 1024), 16, 0, 0); }
}
template <int KOFF, bool FIN, bool DMA> __device__ __forceinline__ void qkt(f32x16& p0, f32x16& p1, const bf16x8* qr, unsigned kad, unsigned qa_in, float negMC,
                                                              f32x16& x0, f32x16& x1, float& l_reg, bf16x8& pa0, bf16x8& pa1, bf16x8& pa2, bf16x8& pa3, const DmaPlan& dm) {
    p0 = f32x16{}; p1 = f32x16{};
    unsigned qa = qa_in; asm volatile("" : "+v"(qa));
    bf16x8 ka[2], kb[2], qf[2];
    float s0 = 0.f, s1 = 0.f, s2 = 0.f, s3 = 0.f;
#define QL(S, D) QktStep<KOFF, D>::load(ka[S], kb[S], qf[S], kad, qa)
#define QM(S, D) do { if constexpr (D >= NQR) lds_wait3<qkt_cnt(D + 1)>(ka[S], kb[S], qf[S]); else lds_wait2<qkt_cnt(D + 1)>(ka[S], kb[S]); \
        const bf16x8 qq = (D < NQR) ? qr[D < NQR ? D : 0] : qf[S]; \
        p0 = __builtin_amdgcn_mfma_f32_32x32x16_bf16(ka[S], qq, p0, 0, 0, 0); p1 = __builtin_amdgcn_mfma_f32_32x32x16_bf16(kb[S], qq, p1, 0, 0, 0); } while (0)
#define PK4(P, BASE, OUT) do { if constexpr (FIN) { unsigned a0 = cvtpk(P[BASE + 0], P[BASE + 1]), a1 = cvtpk(P[BASE + 2], P[BASE + 3]);   \
    unsigned b0 = cvtpk(P[BASE + 4], P[BASE + 5]), b1 = cvtpk(P[BASE + 6], P[BASE + 7]);                              \
    auto r0 = __builtin_amdgcn_permlane32_swap(a0, b0, false, false); auto r1 = __builtin_amdgcn_permlane32_swap(a1, b1, false, false); \
    u32x4 w = {r0[0], r1[0], r0[1], r1[1]}; OUT = *reinterpret_cast<bf16x8*>(&w); } } while (0)
#define EX4(B) do { if constexpr (FIN) { x1[B] = __builtin_amdgcn_exp2f(x1[B]); x1[B + 1] = __builtin_amdgcn_exp2f(x1[B + 1]); x1[B + 2] = __builtin_amdgcn_exp2f(x1[B + 2]); x1[B + 3] = __builtin_amdgcn_exp2f(x1[B + 3]); } } while (0)
#define SUM8(X, B) do { if constexpr (FIN) { s0 += X[B] + X[B + 4]; s1 += X[B + 1] + X[B + 5]; s2 += X[B + 2] + X[B + 6]; s3 += X[B + 3] + X[B + 7]; } } while (0)
    QL(0, 0); QL(1, 1);
    QM(0, 0); QL(0, 2);                            if constexpr (DMA) dma_piece<0>(dm);
    QM(1, 1); QL(1, 3);                            if constexpr (DMA) dma_piece<1>(dm);
    QM(0, 2); QL(0, 4);  EX4(0); SUM8(x0, 0);      if constexpr (DMA) dma_piece<2>(dm);
    QM(1, 3); QL(1, 5);  EX4(4); SUM8(x0, 8);      if constexpr (DMA) dma_piece<3>(dm);
    QM(0, 4); QL(0, 6);  EX4(8); SUM8(x1, 0);      if constexpr (DMA) dma_piece<4>(dm);
    QM(1, 5); QL(1, 7);  EX4(12);                  if constexpr (DMA) dma_piece<5>(dm);
    QM(0, 6); QL(0, 8);  SUM8(x1, 8); PK4(x0, 0, pa0);
    QM(1, 7); QL(1, 9);  PK4(x0, 8, pa1);
    QM(0, 8); QL(0, 10); PK4(x1, 0, pa2);
    QM(1, 9); QL(1, 11); PK4(x1, 8, pa3);
    QM(0, 10); if constexpr (FIN) l_reg += (s0 + s1) + (s2 + s3);
    QM(1, 11);
#undef QL
#undef QM
#undef PK4
#undef EX4
#undef SUM8
}
__device__ __forceinline__ int v_st(int k, int c) { const int kk = (k & ~0xC) | ((k & 4) << 1) | ((k & 8) >> 1); return ((kk >> 3) * 4 + (c >> 5)) * 512 + ((kk & 7) * 32 + (c & 31)) * 2; }
__device__ __forceinline__ int v_rd_base(int lane) { return ((lane & 3) << 3) | (((lane >> 2) & 3) << 6) | (((lane >> 4) & 1) << 5) | (((lane >> 5) & 1) << 8); }
constexpr int v_rd_off(int d0, int ks, int half) { return d0 * 512 + ks * 4096 + half * 2048; }
template <int OFF> __device__ __forceinline__ s16x4 tr_read(int vb) {
    s16x4 r; asm volatile("ds_read_b64_tr_b16 %0, %1 offset:%2" : "=&v"(r) : "v"(vb), "i"(OFF) : "memory"); return r;
}
template <int D0> __device__ __forceinline__ void pv_one(f32x16& od, int vb, bf16x8 pa0, bf16x8 pa1, bf16x8 pa2, bf16x8 pa3) {
    const s16x4 l0 = tr_read<v_rd_off(D0, 0, 0)>(vb), h0 = tr_read<v_rd_off(D0, 0, 1)>(vb), l1 = tr_read<v_rd_off(D0, 1, 0)>(vb), h1 = tr_read<v_rd_off(D0, 1, 1)>(vb);
    const s16x4 l2 = tr_read<v_rd_off(D0, 2, 0)>(vb), h2 = tr_read<v_rd_off(D0, 2, 1)>(vb), l3 = tr_read<v_rd_off(D0, 3, 0)>(vb), h3 = tr_read<v_rd_off(D0, 3, 1)>(vb);
    asm volatile("s_waitcnt lgkmcnt(0)" ::: "memory"); SBAR();
#define PK(L, H) (bf16x8){L[0], L[1], L[2], L[3], H[0], H[1], H[2], H[3]}
    od = __builtin_amdgcn_mfma_f32_32x32x16_bf16(pa0, PK(l0, h0), od, 0, 0, 0);
    od = __builtin_amdgcn_mfma_f32_32x32x16_bf16(pa1, PK(l1, h1), od, 0, 0, 0);
    od = __builtin_amdgcn_mfma_f32_32x32x16_bf16(pa2, PK(l2, h2), od, 0, 0, 0);
    od = __builtin_amdgcn_mfma_f32_32x32x16_bf16(pa3, PK(l3, h3), od, 0, 0, 0);
#undef PK
}
__device__ __forceinline__ void pv_d0(f32x16* o, int vb, bf16x8 pa0, bf16x8 pa1, bf16x8 pa2, bf16x8 pa3) {
    pv_one<0>(o[0], vb, pa0, pa1, pa2, pa3); pv_one<1>(o[1], vb, pa0, pa1, pa2, pa3); pv_one<2>(o[2], vb, pa0, pa1, pa2, pa3); pv_one<3>(o[3], vb, pa0, pa1, pa2, pa3);
}
struct VFrag { s16x4 l0, h0, l1, h1, l2, h2, l3, h3; };
template <int D0> __device__ __forceinline__ void v_reads(VFrag& f, int vb) {
    f.l0 = tr_read<v_rd_off(D0, 0, 0)>(vb); f.h0 = tr_read<v_rd_off(D0, 0, 1)>(vb); f.l1 = tr_read<v_rd_off(D0, 1, 0)>(vb); f.h1 = tr_read<v_rd_off(D0, 1, 1)>(vb);
    f.l2 = tr_read<v_rd_off(D0, 2, 0)>(vb); f.h2 = tr_read<v_rd_off(D0, 2, 1)>(vb); f.l3 = tr_read<v_rd_off(D0, 3, 0)>(vb); f.h3 = tr_read<v_rd_off(D0, 3, 1)>(vb);
}
template <int N> __device__ __forceinline__ void v_wait(VFrag& f) {
    asm volatile("s_waitcnt lgkmcnt(%8)" : "+v"(f.l0), "+v"(f.h0), "+v"(f.l1), "+v"(f.h1), "+v"(f.l2), "+v"(f.h2), "+v"(f.l3), "+v"(f.h3) : "i"(N) : "memory");
}
__device__ __forceinline__ void v_mfmas(f32x16& od, const VFrag& f, bf16x8 pa0, bf16x8 pa1, bf16x8 pa2, bf16x8 pa3) {
#define PK(L, H) (bf16x8){L[0], L[1], L[2], L[3], H[0], H[1], H[2], H[3]}
    od = __builtin_amdgcn_mfma_f32_32x32x16_bf16(pa0, PK(f.l0, f.h0), od, 0, 0, 0);
    od = __builtin_amdgcn_mfma_f32_32x32x16_bf16(pa1, PK(f.l1, f.h1), od, 0, 0, 0);
    od = __builtin_amdgcn_mfma_f32_32x32x16_bf16(pa2, PK(f.l2, f.h2), od, 0, 0, 0);
    od = __builtin_amdgcn_mfma_f32_32x32x16_bf16(pa3, PK(f.l3, f.h3), od, 0, 0, 0);
#undef PK
}
template <bool EXP> __device__ __forceinline__ void pv_exp(f32x16* o, int vb, bf16x8 pa0, bf16x8 pa1, bf16x8 pa2, bf16x8 pa3, f32x16& x0) {
#define EX4(B) do { if constexpr (EXP) { x0[B] = __builtin_amdgcn_exp2f(x0[B]); x0[B + 1] = __builtin_amdgcn_exp2f(x0[B + 1]); x0[B + 2] = __builtin_amdgcn_exp2f(x0[B + 2]); x0[B + 3] = __builtin_amdgcn_exp2f(x0[B + 3]); } } while (0)
    VFrag fa, fb;
    v_reads<0>(fa, vb); v_reads<1>(fb, vb);
    v_wait<8>(fa); v_mfmas(o[0], fa, pa0, pa1, pa2, pa3); EX4(0);
    v_reads<2>(fa, vb);
    v_wait<8>(fb); v_mfmas(o[1], fb, pa0, pa1, pa2, pa3); EX4(4);
    v_reads<3>(fb, vb);
    v_wait<8>(fa); v_mfmas(o[2], fa, pa0, pa1, pa2, pa3); EX4(8);
    v_wait<0>(fb); v_mfmas(o[3], fb, pa0, pa1, pa2, pa3); EX4(12);
#undef EX4
}

__device__ __forceinline__ void attn_unit(const bf16_t* __restrict__ Qg, const bf16_t* __restrict__ KHg, const bf16_t* __restrict__ KVg, const bf16_t* __restrict__ Pg, bf16_t* __restrict__ mix,
                                          const float* __restrict__ qhw, const float* __restrict__ ropet,
                                          int h, int qrow0, int kc0, int kl0, int nct, int NT, float negMC, char* lds, int wave_) {
    int tid_ = wave_ * 64 + lane_id(); asm volatile("" : "+v"(tid_));
    const int tid = tid_, wid = tid >> 6, lane = tid & 63, r32 = lane & 31, hi = lane >> 5;
    char* V_lds = lds; char* K_lds = lds + 2 * SHM_V;
    bf16x8 qr[NQR];
    const bf16_t* Qw = Qg + (size_t)(qrow0 + wid * QBLK + r32) * LDQ + h * DQK + hi * 8;
    const unsigned qa = (unsigned)(uintptr_t)(lds + SHM_QR) + wid * QLB + lane * 16;
    {
        u32x4 qx[12]; f32x4 wr[4][2], rt[2][4];
        const bool latq = qrow0 < 16384; const int trow = (qrow0 + wid * QBLK + r32) & 4095;
#pragma unroll
        for (int d0 = 0; d0 < 12; ++d0) qx[d0] = *reinterpret_cast<const u32x4*>(Qw + d0 * 16);
#pragma unroll
        for (int i = 0; i < 4; ++i) { wr[i][0] = *(const f32x4*)(qhw + 128 + 16 * i + 8 * hi); wr[i][1] = *(const f32x4*)(qhw + 128 + 16 * i + 8 * hi + 4); }
#pragma unroll
        for (int pp = 0; pp < 2; ++pp) { const int pos = latq ? (pp == 0 ? (trow >> 6) : (trow & 63)) : 0;
            const f32x4* rp = (const f32x4*)(ropet + (size_t)(pos * 16 + 8 * hi) * 2);
#pragma unroll
            for (int q4 = 0; q4 < 4; ++q4) rt[pp][q4] = rp[q4]; }
        float ssq = 0.f;
#pragma unroll
        for (int d0 = 0; d0 < 12; ++d0) { float f[8]; unpack8(qx[d0], f);
#pragma unroll
            for (int e = 0; e < 8; ++e) ssq += f[e] * f[e]; }
        { auto pr = __builtin_amdgcn_permlane32_swap(__float_as_uint(ssq), __float_as_uint(ssq), false, false); ssq = __uint_as_float(pr[0]) + __uint_as_float(pr[1]); }
        const float rhq = (SCALE * 1.4426950408889634f) / sqrtf(ssq * (1.f / 192.f) + 1e-6f);
#pragma unroll
        for (int d0 = 0; d0 < 8; ++d0) { float f[8]; unpack8(qx[d0], f);
#pragma unroll
            for (int e = 0; e < 8; ++e) f[e] *= rhq;
            qx[d0] = pack8(f); }
#pragma unroll
        for (int pp = 0; pp < 2; ++pp) { float fa[8], fb[8]; unpack8(qx[8 + 2 * pp], fa); unpack8(qx[9 + 2 * pp], fb);
#pragma unroll
            for (int e = 0; e < 4; ++e) { fa[e] = fa[e] * rhq * wr[2 * pp][0][e]; fa[4 + e] = fa[4 + e] * rhq * wr[2 * pp][1][e]; fb[e] = fb[e] * rhq * wr[2 * pp + 1][0][e]; fb[4 + e] = fb[4 + e] * rhq * wr[2 * pp + 1][1][e]; }
            if (latq) {
#pragma unroll
                for (int q4 = 0; q4 < 4; ++q4) { const f32x4 v = rt[pp][q4];
#pragma unroll
                    for (int t2 = 0; t2 < 2; ++t2) { const int e = 2 * q4 + t2; const float cs = v[2 * t2], sn = v[2 * t2 + 1]; const float ya = fa[e], yb = fb[e];
                        fa[e] = ya * cs - yb * sn; fb[e] = yb * cs + ya * sn; } } }
            qx[8 + 2 * pp] = pack8(fa); qx[9 + 2 * pp] = pack8(fb); }
#pragma unroll
        for (int d0 = 0; d0 < NQR; ++d0) qr[d0] = __builtin_bit_cast(bf16x8, qx[d0]);
#pragma unroll
        for (int d0 = NQR; d0 < 12; ++d0) *(LAS u32x4*)(uintptr_t)(qa + (d0 - NQR) * 1024) = qx[d0];
    }
    float l_reg = 0; f32x16 o[4] = {};
    const int vb0 = (int)(uintptr_t)V_lds + v_rd_base(lane);
    const unsigned kad = (unsigned)(uintptr_t)K_lds + (unsigned)(r32 * KPITCH + hi * 16);
    const bf16_t* Kbase = KHg + h * DQK; const bf16_t* Vbase = KVg + h * 256 + 128;
    unsigned koff[3], voff[2];
#pragma unroll
    for (int i = 0; i < 3; ++i) { const int p = (wid + 8 * i) * 64 + lane, r = p / 25, c = p - r * 25; koff[i] = (unsigned)(r * LDKK * 2 + c * 16); }
#pragma unroll
    for (int i = 0; i < 2; ++i) { const int o = (wid * 2 + i) * 1024 + lane * 16, sub = o >> 9, kk = (sub >> 2) * 8 + ((o & 511) >> 6), k = (kk & ~0xC) | ((kk & 4) << 1) | ((kk & 8) >> 1), c = (sub & 3) * 32 + ((o & 63) >> 1);
        voff[i] = (unsigned)(k * LDV * 2 + c * 2); }
    LAS unsigned char* K3 = (LAS unsigned char*)(uintptr_t)(unsigned)(uintptr_t)K_lds; LAS unsigned char* V3 = (LAS unsigned char*)(uintptr_t)(unsigned)(uintptr_t)V_lds;
#define TROW(j) ((j) < nct ? kc0 + (j) * KVBLK : kl0 + ((j) - nct) * KVBLK)
#define DMA_K(j, slot) do { const char* kb_ = (const char*)Kbase + (size_t)TROW(j) * (LDKK * 2); _Pragma("unroll") for (int i_ = 0; i_ < 3; ++i_) \
    __builtin_amdgcn_global_load_lds((const unsigned*)(kb_ + koff[i_]), (LAS unsigned*)(K3 + (slot) * SHM_K + (wave_ + 8 * i_) * 1024), 16, 0, 0); \
    if (wave_ == 0) { int l4_ = lane_id(); const int p_ = 24 * 64 + l4_, r_ = p_ / 25, c_ = p_ - r_ * 25; \
        __builtin_amdgcn_global_load_lds((const unsigned*)(kb_ + (unsigned)(r_ * LDKK * 2 + c_ * 16)), (LAS unsigned*)(K3 + (slot) * SHM_K + 24 * 1024), 16, 0, 0); } } while (0)
#define DMA_V(j, slot) do { const char* vb_ = (const char*)Vbase + (size_t)TROW(j) * (LDV * 2); _Pragma("unroll") for (int i_ = 0; i_ < 2; ++i_) \
    __builtin_amdgcn_global_load_lds((const unsigned*)(vb_ + voff[i_]), (LAS unsigned*)(V3 + (slot) * SHM_V + (wave_ * 2 + i_) * 1024), 16, 0, 0); } while (0)
#define WAITBAR() do { asm volatile("s_waitcnt vmcnt(0)" ::: "memory"); __syncthreads(); } while (0)
    f32x16 pA0, pA1, pB0, pB1; bf16x8 pa0, pa1, pa2, pa3;
    DMA_K(0, 0); DMA_V(0, 0); DMA_K(1, 1);
    WAITBAR();
    const DmaPlan none0{nullptr, nullptr, K3, V3, 0u, 0u, 0u, 0u, 0u, wave_, false, false};
#define PLAN(tk, sk_, tv, sv_) DmaPlan{(const char*)Kbase + (size_t)TROW((tk) < NT ? (tk) : 0) * (LDKK * 2), (const char*)Vbase + (size_t)TROW((tv) < NT ? (tv) : 0) * (LDV * 2), \
        K3 + (sk_) * SHM_K, V3 + (sv_) * SHM_V, koff[0], koff[1], koff[2], voff[0], voff[1], wave_, (tk) < NT, (tv) < NT}
    if (wave_ < 4) {
#define STEPA(jj, ks, vs, PN0, PN1, PP0, PP1) do { const DmaPlan dp = PLAN((jj) + 1, 1 - (ks), (jj), 1 - (vs)); \
        qkt<0, true, true>(PN0, PN1, qr, kad + (ks) * SHM_K, qa, negMC, PP0, PP1, l_reg, pa0, pa1, pa2, pa3, dp); \
        pv_exp<true>(o, vb0 + (vs) * SHM_V, pa0, pa1, pa2, pa3, PN0); WAITBAR(); } while (0)
        qkt<0, false, false>(pA0, pA1, qr, kad, qa, negMC, pA0, pA1, l_reg, pa0, pa1, pa2, pa3, none0); partialSM(pA0, pA1, negMC);
        WAITBAR();
        for (int j = 1; j + 1 < NT; j += 2) { STEPA(j, 1, 0, pB0, pB1, pA0, pA1); STEPA(j + 1, 0, 1, pA0, pA1, pB0, pB1); }
        STEPA(NT - 1, 1, 0, pB0, pB1, pA0, pA1);
        finishSM(pB0, pB1, l_reg, pa0, pa1, pa2, pa3); SBAR();
        pv_d0(o, vb0 + SHM_V, pa0, pa1, pa2, pa3);
#undef STEPA
    } else {
#define STEPB(jj, ks, vs) do { const DmaPlan dp = PLAN((jj) + 1, 1 - (ks), (jj), 1 - (vs)); \
        pv_exp<false>(o, vb0 + (vs) * SHM_V, pa0, pa1, pa2, pa3, pA0); \
        qkt<0, false, true>(pA0, pA1, qr, kad + (ks) * SHM_K, qa, negMC, pA0, pA1, l_reg, pa0, pa1, pa2, pa3, dp); \
        partialSM(pA0, pA1, negMC); finishSM(pA0, pA1, l_reg, pa0, pa1, pa2, pa3); WAITBAR(); } while (0)
        qkt<0, false, false>(pA0, pA1, qr, kad, qa, negMC, pA0, pA1, l_reg, pa0, pa1, pa2, pa3, none0); partialSM(pA0, pA1, negMC);
        finishSM(pA0, pA1, l_reg, pa0, pa1, pa2, pa3);
        WAITBAR();
        for (int j = 1; j + 1 < NT; j += 2) { STEPB(j, 1, 0); STEPB(j + 1, 0, 1); }
        STEPB(NT - 1, 1, 0);
        pv_d0(o, vb0 + SHM_V, pa0, pa1, pa2, pa3);
#undef STEPB
    }
    {
        int te_ = wave_ * 64 + lane_id(); asm volatile("" : "+v"(te_));
        const int ewid = te_ >> 6, elane = te_ & 63, er32 = elane & 31, ehi = elane >> 5;
        float* eli = (float*)(lds + 2 * SHM_V + 2 * SHM_K) + ewid * 64;
        { auto rr = __builtin_amdgcn_permlane32_swap(__float_as_uint(l_reg), __float_as_uint(l_reg), false, false); l_reg = __uint_as_float(rr[0]) + __uint_as_float(rr[1]); }
        if (ehi == 0) eli[er32] = l_reg; asm volatile("s_waitcnt lgkmcnt(0)" ::: "memory");
        const size_t Rw = (size_t)(qrow0 + ewid * QBLK);
        unsigned short gtb[16][4];
#pragma unroll
        for (int r = 0; r < 16; ++r)
#pragma unroll
            for (int d0 = 0; d0 < 4; ++d0) gtb[r][d0] = Pg[(Rw + crow(r, ehi)) * NIN + OFF_MGATE + h * 128 + d0 * 32 + er32];
        asm volatile("" ::: "memory");
#pragma unroll
        for (int r = 0; r < 16; ++r) { const size_t R = Rw + crow(r, ehi); const float rl = __builtin_amdgcn_rcpf(eli[crow(r, ehi)]);
#pragma unroll
            for (int d0 = 0; d0 < 4; ++d0) { const int d = h * 128 + d0 * 32 + er32;
                mix[R * DM + 1024 + d] = (bf16_t)f2bf(o[d0][r] * rl * siluf(bf2f(gtb[r][d0]))); } }
    }
    __syncthreads();
#undef TROW
#undef DMA_K
#undef DMA_V
#undef WAITBAR
#undef PLAN
}
#undef SBAR
}

constexpr int CW_BAR = 4096, CW_FOLD = 8192;
constexpr int KFOLD = 2176;
#define XB_TMO      128
#define XB_XCNT(j)  (256  + 64 * (j))
#define XB_XSUB(j)  (1280 + 64 * (j))
#define XB_XGEN(j)  (2304 + 64 * (j))
#define XB_TOP      3328
#define XB_TOPGEN   3392
#define XCD_BAR_WORDS 3456
#define XB_SPIN_CAP (1u << 18)
__device__ __forceinline__ unsigned xb_ld(unsigned* p)              { return __hip_atomic_load(p, __ATOMIC_RELAXED, __HIP_MEMORY_SCOPE_AGENT); }
__device__ __forceinline__ unsigned xb_add(unsigned* p, unsigned v) { return __hip_atomic_fetch_add(p, v, __ATOMIC_RELAXED, __HIP_MEMORY_SCOPE_AGENT); }
__device__ __forceinline__ unsigned xb_xcc_id() { return (unsigned)__builtin_amdgcn_s_getreg((3 << 11) | 20) & 0xFu; }
#define XB_SPIN(cond, bar) do { unsigned _sp = 0; while (cond) { __builtin_amdgcn_s_sleep(1); \
    if ((++_sp & 255u) == 0u) { if (xb_ld(&(bar)[XB_TMO])) break; if (_sp > XB_SPIN_CAP) { atomicAdd(&(bar)[XB_TMO], 1u); break; } } } } while (0)
struct XcdBarrier { unsigned* bar; unsigned x; volatile LAS unsigned* st; };
__device__ __forceinline__ XcdBarrier xcd_barrier_post(unsigned* bar, volatile LAS unsigned* st, int tid) {
    XcdBarrier b; b.bar = bar; b.x = xb_xcc_id(); b.st = st;
    if (tid == 0) (void)xb_add(&bar[XB_XCNT(b.x)], 1u);
    return b;
}
__device__ __forceinline__ void xcd_barrier_complete(unsigned* bar, unsigned x, unsigned& nloc, unsigned& nx) {
    const unsigned G = gridDim.x * gridDim.y * gridDim.z;
    unsigned sum, cnt, mine, sp = 0u;
    for (;;) {
        sum = 0u; cnt = 0u; mine = 0u;
#pragma unroll
        for (unsigned j = 0; j < 16; ++j) { const unsigned c = xb_ld(&bar[XB_XCNT(j)]); sum += c; cnt += (c > 0u) ? 1u : 0u; mine = (j == x) ? c : mine; }
        if (sum == G) break;
        __builtin_amdgcn_s_sleep(1);
        if ((++sp & 255u) == 0u) { if (xb_ld(&bar[XB_TMO])) break; if (sp > XB_SPIN_CAP) { atomicAdd(&bar[XB_TMO], 1u); break; } }
    }
    nloc = mine > 0u ? mine : 1u; nx = cnt > 0u ? cnt : 1u;
}
__device__ __forceinline__ void xcd_barrier(const XcdBarrier& b, int tid) {
    asm volatile("s_waitcnt vmcnt(0)" ::: "memory");
    __syncthreads();
    if (tid == 0) {
        unsigned* bar = b.bar;
        __builtin_amdgcn_s_waitcnt(0);
        unsigned nloc = b.st[0], nx = b.st[1];
        if (nloc == 0u) { xcd_barrier_complete(bar, b.x, nloc, nx); b.st[0] = nloc; b.st[1] = nx; }
        const unsigned old = xb_add(&bar[XB_XSUB(b.x)], 1u);
        const unsigned gen = old / nloc;
        if (old + 1u == (gen + 1u) * nloc) {
            asm volatile("buffer_wbl2 sc1\n\tbuffer_inv sc1\n\ts_waitcnt vmcnt(0)" ::: "memory");
            const unsigned og = xb_add(&bar[XB_TOP], 1u);
            const unsigned tg = og / nx;
            if (og + 1u == (tg + 1u) * nx) xb_add(&bar[XB_TOPGEN], 1u);
            else XB_SPIN(xb_ld(&bar[XB_TOPGEN]) == tg, bar);
            asm volatile("" ::: "memory");
            xb_add(&bar[XB_XGEN(b.x)], 1u);
            asm volatile("s_waitcnt vmcnt(0)" ::: "memory");
        } else {
            __builtin_amdgcn_fence(__ATOMIC_ACQUIRE, "agent");
            asm volatile("s_waitcnt vmcnt(0)" ::: "memory");
            XB_SPIN(xb_ld(&bar[XB_XGEN(b.x)]) == gen, bar);
            asm volatile("" ::: "memory");
        }
    }
    __syncthreads();
}

constexpr int NWAVES = 8, NCU = 256;
constexpr int RING_BYTES = 150528, LDSCTL_OFF = RING_BYTES, MISC_OFF = LDSCTL_OFF + 320, LDS_BYTES = 151552;
static_assert(att::SHM_ATTN <= RING_BYTES && pg8::STAGE_BYTES <= RING_BYTES, "phase scratch fits the ring");

struct Args { const void* in[18]; float* out; unsigned char* ws; int ph_lo, ph_hi; };

struct Frame {
    unsigned char* lds;
    LAS unsigned char* lds3;
    int wave, vcu, G, bx;
};
__device__ __forceinline__ const void* ldptr(LAS unsigned char*, int i) {
    typedef __attribute__((address_space(4))) const unsigned long long* kaptr_t;
    kaptr_t ka = (kaptr_t)__builtin_amdgcn_kernarg_segment_ptr();
    asm volatile("" : "+s"(ka));
    return (const void*)ka[i];
}
#define FRESH_TID(name) int name = F.wave * 64 + lane_id(); asm volatile("" : "+v"(name))
#define F_IN(i) ((const float*)ldptr(F.lds3, (i)))
#define F_OUT ((float*)ldptr(F.lds3, 18))
#define F_WS ((unsigned char*)ldptr(F.lds3, 19))
#define WSP(T, off) ((T*)(ws + (off)))

__device__ __forceinline__ void transpose_item(const float* W, int K, int N, bf16_t* WT, int row_off, float* scr, int item, int lane, const float* kscale = nullptr) {
    const int nblk = N / 32, kb = item / nblk, nb = item % nblk, k0 = 64 * kb, n0 = 32 * nb;
    float wv[32];
#pragma unroll
    for (int i = 0; i < 32; ++i) { const int kk = 2 * i + (lane >> 5); wv[i] = W[(size_t)(k0 + kk) * N + n0 + (lane & 31)]; }
    if (kscale) {
#pragma unroll
        for (int i = 0; i < 32; ++i) wv[i] *= kscale[k0 + 2 * i + (lane >> 5)]; }
#pragma unroll
    for (int i = 0; i < 32; ++i) { const int kk = 2 * i + (lane >> 5); scr[kk * 33 + (lane & 31)] = wv[i]; }
    asm volatile("s_waitcnt lgkmcnt(0)" ::: "memory");
    const int c = lane & 7;
#pragma unroll
    for (int j = 0; j < 4; ++j) { const int n = (lane >> 3) + 8 * j; const float* s = scr + (8 * c) * 33 + n;
        u32x4 o; o.x = pk2(s[0 * 33], s[1 * 33]); o.y = pk2(s[2 * 33], s[3 * 33]); o.z = pk2(s[4 * 33], s[5 * 33]); o.w = pk2(s[6 * 33], s[7 * 33]);
        *(u32x4*)(WT + (size_t)(row_off + n0 + n) * K + k0 + 8 * c) = o; }
    asm volatile("s_waitcnt lgkmcnt(0)" ::: "memory");
}

__device__ __forceinline__ void phase_prep(Frame& F, int part, int wg, int nwg) {
    float* ldsf = (float*)F.lds;
    FRESH_TID(tid_); const int tid = tid_, lane = tid & 63, wave = F.wave;
    unsigned char* ws = F_WS;
    const float* in_win = F_IN(7);
    if (part == 0) {
        const float* in_c = F_IN(1); const float* in_cctx = F_IN(3); const float* in_wada = F_IN(5); const float* in_bada = F_IN(6);
        float* s_c = ldsf;
        float* red = ldsf + 5 * 2048;
        for (int idx = tid; idx < 5 * 2048; idx += 512) { const int r = idx >> 11, k = idx & 2047; const float v = (r < 4) ? in_c[r * 2048 + k] : in_cctx[k]; s_c[idx] = siluf(v); }
        __syncthreads();
        float* mods = WSP(float, WS_MODS);
        for (int rp = 0; rp < ((REP_P & 1) ? 2 : 1); ++rp)
        for (int item = wg; item < 192; item += nwg) {
            const int l = item / 96, nb = item % 96, col = nb * 64 + lane;
            const float* w = in_wada + (size_t)l * 2048 * 6144 + col;
            float a0 = 0.f, a1 = 0.f, a2 = 0.f, a3 = 0.f, a4 = 0.f;
            const int kb = wave * 256;
            for (int k0 = 0; k0 < 256; k0 += 32) { float wv[32];
#pragma unroll
                for (int k = 0; k < 32; ++k) wv[k] = w[(size_t)(kb + k0 + k) * 6144];
#pragma unroll
                for (int k = 0; k < 32; ++k) { const int kk = kb + k0 + k;
                    a0 += s_c[kk] * wv[k]; a1 += s_c[2048 + kk] * wv[k]; a2 += s_c[4096 + kk] * wv[k]; a3 += s_c[6144 + kk] * wv[k]; a4 += s_c[8192 + kk] * wv[k]; } }
            red[(wave * 5 + 0) * 64 + lane] = a0; red[(wave * 5 + 1) * 64 + lane] = a1; red[(wave * 5 + 2) * 64 + lane] = a2; red[(wave * 5 + 3) * 64 + lane] = a3; red[(wave * 5 + 4) * 64 + lane] = a4;
            __syncthreads();
            if (tid < 320) { const int r = tid >> 6, ln = tid & 63; float s = 0.f;
#pragma unroll
                for (int w8 = 0; w8 < 8; ++w8) s += red[(w8 * 5 + r) * 64 + ln];
                mods[((size_t)l * 5 + r) * 6144 + nb * 64 + ln] = s + in_bada[(size_t)l * 6144 + nb * 64 + ln]; }
            __syncthreads();
        }
    }
    if (part == 0) {
        const float* in_poolw = F_IN(8); const float* in_pools = F_IN(9);
        float* Ml = ldsf;
        float* Wt = ldsf + 128 * 128;
        for (int rp = 0; rp < ((REP_P & 2) ? 2 : 1); ++rp)
        for (int sh = 0; sh < ((wg >= 192 && nwg == 256) ? 3 : 1); ++sh)
        for (int item = ((nwg == 256) ? (wg < 192 ? wg : 192 + 3 * (wg - 192)) : wg) + sh; item < 512; item += ((nwg == 256) ? 384 : nwg)) {
            const int l = item >> 8, kind = (item >> 7) & 1, g = (item >> 5) & 3, kb = item & 31;
            __syncthreads();
            for (int idx = tid; idx < 128 * 128; idx += 512) { const int j = idx >> 7, n = idx & 127; float v;
                if (kind == 0) v = in_poolw[(((size_t)l * 4 + g) * 128 + j) * 128 + n] * in_pools[(size_t)l * 512 + g * 128 + n];
                else { const float sc = 0.08838834764831845f;
                    if (n <= 64) v = __builtin_amdgcn_cosf((float)((j * n) & 127) * (1.f / 128.f)) * sc;
                    else v = __builtin_amdgcn_sinf((float)((j * (n - 64)) & 127) * (1.f / 128.f)) * sc; }
                Ml[idx] = v; }
            const int colbase = (kind == 0 ? OFF_POOL : OFF_FNET) + g * 128;
            { float wv[16];
#pragma unroll
              for (int q = 0; q < 16; ++q) { const int idx = tid + q * 512, kk = idx >> 7, jj = idx & 127; wv[q] = in_win[((size_t)l * DM + kb * 64 + kk) * DIN + colbase + jj]; }
#pragma unroll
              for (int q = 0; q < 16; ++q) { const int idx = tid + q * 512, kk = idx >> 7, jj = idx & 127; Wt[jj * 68 + kk] = wv[q]; } }
            __syncthreads();
            const int n4 = (tid & 31) * 4, k4 = (tid >> 5) * 4;
            f32x4 acc4[4];
#pragma unroll
            for (int i = 0; i < 4; ++i) acc4[i] = (f32x4){0.f, 0.f, 0.f, 0.f};
#pragma unroll 8
            for (int j = 0; j < 128; ++j) { const f32x4 mv = *(const f32x4*)(Ml + j * 128 + n4), wq = *(const f32x4*)(Wt + j * 68 + k4);
#pragma unroll
                for (int i = 0; i < 4; ++i) acc4[i] += mv * wq[i]; }
            bf16_t* dst = WSP(bf16_t, WS_WIN) + ((size_t)l * NIN + colbase + n4) * DM + kb * 64 + k4;
#pragma unroll
            for (int e = 0; e < 4; ++e) { u32x2 w; w.x = pk2(acc4[0][e], acc4[1][e]); w.y = pk2(acc4[2][e], acc4[3][e]); *(u32x2*)(dst + (size_t)e * DM) = w; }
        }
        __syncthreads();
    }
    {
        const float* in_wuq = F_IN(12); const float* in_wukv = F_IN(14); const float* in_wout = F_IN(17); const float* in_qnw = F_IN(11); const float* in_kvnw = F_IN(13);
        float* scr = ldsf + wave * (64 * 33 + 16);
        const bool vsh = (part == 0 && nwg == 256);
        const int vw0 = vsh ? (wg < 192 ? wg : 192 + 3 * (wg - 192)) : wg, nsh = (vsh && wg >= 192) ? 3 : 1, NGW = (vsh ? 384 : nwg) * NWAVES;
        constexpr int I_IN = 32 * 130, I_UQ = 8 * 48, I_UKV = 8 * 64, I_OUT = 32 * 64, I_REST = I_UQ + I_UKV + I_OUT;
        const int ntot = (part == 0) ? 2 * I_IN : I_REST;
        for (int rp = 0; rp < ((REP_P & 4) ? 2 : 1); ++rp)
        for (int sh = 0; sh < nsh; ++sh)
        for (int it = (vw0 + sh) * NWAVES + wave; it < ntot; it += NGW) {
            int r = it;
            if (part == 0) { const int l = r / I_IN; r -= l * I_IN; const int nb = r % 130; if (nb < 16 || (nb >= 32 && nb < 48)) continue;
                transpose_item(in_win + (size_t)l * DM * DIN, DM, DIN, WSP(bf16_t, WS_WIN) + (size_t)l * NIN * DM, 0, scr, r, lane); continue; }
            const int l = part - 1;
            if (r < I_UQ) { transpose_item(in_wuq + (size_t)l * 512 * NQ, 512, NQ, WSP(bf16_t, WS_WUQ) + (size_t)l * NQ * 512, 0, scr, r, lane, in_qnw + (size_t)l * 512); continue; } r -= I_UQ;
            if (r < I_UKV) { transpose_item(in_wukv + (size_t)l * 512 * NKV, 512, NKV, WSP(bf16_t, WS_WUKV) + (size_t)l * NKV * 512, 0, scr, r, lane, in_kvnw + (size_t)l * 512); continue; } r -= I_UKV;
            transpose_item(in_wout + (size_t)l * DM * DM, DM, DM, WSP(bf16_t, WS_WOUT) + (size_t)l * DM * DM, 0, scr, r, lane);
        }
    }
    {
        const int gt = wg * 512 + tid, NGT = nwg * 512;
        if (part == 1) {
            const float* in_fnetw = F_IN(10);
            for (int idx = gt; idx < NL * 512 * 512; idx += NGT) { const int l = idx >> 18, n = (idx >> 9) & 511, kidx = idx & 511;
                const int g = n >> 7, d = n & 127; const int g2 = (kidx & 255) >> 6, s = kidx & 63; float v = 0.f;
                if (g2 == g) { const float* fw = in_fnetw + (((size_t)l * 4 + g) * 128) * 128 + d;
                    if (kidx < 256) v = (s == 0) ? fw[0] : fw[(size_t)s * 128] + fw[(size_t)(128 - s) * 128];
                    else v = (s == 0) ? 0.f : fw[(size_t)s * 128] - fw[(size_t)(128 - s) * 128]; }
                WSP(bf16_t, WS_FWAB)[idx] = (bf16_t)f2bf(v); }
        }
        if (part == 0) {
            const float* in_qhw = F_IN(15); const float* in_khw = F_IN(16);
            for (int idx = gt; idx < 256 * 256; idx += NGT) { const int k = idx >> 8, n = idx & 255; const float ph = (float)((k * n) & 255) * (1.f / 256.f);
                WSP(bf16_t, WS_DCTX)[idx] = (bf16_t)f2bf(__builtin_amdgcn_cosf(ph) * 0.0625f);
                WSP(bf16_t, WS_DCTX)[65536 + idx] = (bf16_t)f2bf(-__builtin_amdgcn_sinf(ph) * 0.0625f); }
            if (wg == 0 && F.wave == 0) { for (int l = 0; l < NL; ++l) { float mq = 0.f, mk = 0.f;
                    for (int i = lane; i < DQK; i += 64) { mq = fmaxf(mq, fabsf(in_qhw[l * DQK + i])); mk = fmaxf(mk, fabsf(in_khw[l * DQK + i])); }
                    mq = wave_max(mq); mk = wave_max(mk);
                    if (lane == 0) WSP(float, WS_SMB)[l] = -(att::SCALE * (float)DQK * mq * mk) * 1.4426950408889634f; } }
            for (int idx = gt; idx < 1024; idx += NGT) { const int p = idx >> 4, i = idx & 15; const float inv = powf(10000.f, -(float)i / 16.f); const float ang = (float)p * inv;
                WSP(float, WS_ROPE)[2 * idx] = cosf(ang); WSP(float, WS_ROPE)[2 * idx + 1] = sinf(ang); }
        }
    }
}

__device__ __forceinline__ void phase_norm(Frame& F, int l) {
    FRESH_TID(tid_); const int lane = tid_ & 63;
    const int gw = F.vcu * NWAVES + F.wave, NGW = F.G * NWAVES;
    unsigned char* ws = F_WS;
    if (l == 0) {
        const float* mods = WSP(float, WS_MODS);
        const float* nw = F_IN(4);
        const float* src_lat = F_IN(0); const float* src_ctx = F_IN(2);
        bf16_t* H = WSP(bf16_t, WS_HMIX);
        for (int it = gw; it < MT / 2; it += NGW) {
            const int rowa = 2 * it;
            const bool lat = rowa < MLAT; const int rr = lat ? rowa : rowa - MLAT; const int mr = lat ? (rowa >> 12) : 4;
            const float* shp = mods + (size_t)mr * 6144; const float* scp = shp + 2048;
            f32x4 v[2][8], w4[8], sc4[8], sh4[8];
#pragma unroll
            for (int q = 0; q < 2; ++q) { const f32x4* xr = (const f32x4*)((lat ? src_lat : src_ctx) + (size_t)(rr + q) * DM) + lane;
#pragma unroll
                for (int j = 0; j < 8; ++j) v[q][j] = xr[64 * j]; }
#pragma unroll
            for (int j = 0; j < 8; ++j) { const int c0 = 4 * (lane + 64 * j); w4[j] = *(const f32x4*)(nw + c0); sc4[j] = *(const f32x4*)(scp + c0); sh4[j] = *(const f32x4*)(shp + c0); }
            float ssq[2];
#pragma unroll
            for (int q = 0; q < 2; ++q) { float s8 = 0.f;
#pragma unroll
                for (int j = 0; j < 8; ++j) s8 += (v[q][j][0] * v[q][j][0] + v[q][j][1] * v[q][j][1]) + (v[q][j][2] * v[q][j][2] + v[q][j][3] * v[q][j][3]);
                ssq[q] = wave_sum(s8); }
#pragma unroll
            for (int q = 0; q < 2; ++q) { const float rstd = 1.0f / sqrtf(ssq[q] * (1.f / DM) + EPS);
                u32x2* o8 = (u32x2*)(H + (size_t)(rowa + q) * DM) + lane;
#pragma unroll
                for (int j = 0; j < 8; ++j) { f32x4 hv;
#pragma unroll
                    for (int e = 0; e < 4; ++e) hv[e] = (v[q][j][e] * rstd * w4[j][e]) * (1.f + sc4[j][e]) + sh4[j][e];
                    u32x2 w; w.x = pk2(hv[0], hv[1]); w.y = pk2(hv[2], hv[3]); o8[64 * j] = w; } }
        }
        const float* mods1 = mods + (size_t)5 * 6144;
        LAS float* shl = (LAS float*)F.lds3;
        { float sv[20];
#pragma unroll
          for (int i = 0; i < 20; ++i) { const int e = tid_ + i * NWAVES * 64; sv[i] = mods1[(size_t)(e >> 11) * 6144 + (e & 2047)]; }
#pragma unroll
          for (int i = 0; i < 20; ++i) shl[tid_ + i * NWAVES * 64] = sv[i]; }
        __syncthreads();
        const bf16_t* WT = WSP(bf16_t, WS_WIN) + (size_t)NIN * DM; float* BI = WSP(float, WS_BIAS);
        u32x4 wv3[3][4];
#pragma unroll
        for (int ci = 0; ci < 3; ++ci) { const int c = gw + ci * NGW;
#pragma unroll
            for (int j = 0; j < 4; ++j) wv3[ci][j] = *(const u32x4*)(WT + (size_t)(c < NIN ? c : 0) * DM + (size_t)(lane + 64 * j) * 8); }
#pragma unroll
        for (int ci = 0; ci < 3; ++ci) { const int c = gw + ci * NGW; if (c >= NIN) break;
            float acc5[5] = {0.f, 0.f, 0.f, 0.f, 0.f};
#pragma unroll
            for (int j = 0; j < 4; ++j) { float wf[8]; unpack8(wv3[ci][j], wf);
#pragma unroll
                for (int b = 0; b < 5; ++b) { const f32x4 s0 = *(const LAS f32x4*)(shl + b * DM + (lane + 64 * j) * 8), s1 = *(const LAS f32x4*)(shl + b * DM + (lane + 64 * j) * 8 + 4);
                    acc5[b] += ((wf[0] * s0[0] + wf[1] * s0[1]) + (wf[2] * s0[2] + wf[3] * s0[3])) + ((wf[4] * s1[0] + wf[5] * s1[1]) + (wf[6] * s1[2] + wf[7] * s1[3])); } }
#pragma unroll
            for (int b = 0; b < 5; ++b) { const float t = wave_sum(acc5[b]); if (lane == 0) BI[(size_t)b * NIN + c] = t; } }
        __syncthreads();
    } else {
        const float* mods = WSP(float, WS_MODS) + (size_t)l * 5 * 6144;
        const float* nw = F_IN(4) + (size_t)l * DM;
        const float* src_ctx = F_IN(2);
        const float* part = WSP(float, WS_Q); const float* gate_c0 = WSP(float, WS_MODS) + (size_t)4 * 6144 + 4096;
        bf16_t* XB = WSP(bf16_t, WS_KV); float* RS = WSP(float, WS_RS);
        if ((gw & 1) == 0) { const int row = gw >> 1;
            if (row < MCTX) {
                f32x4 v[8], p0[8], p1[8], p2[8], p3[8], g4[8];
#pragma unroll
                for (int j = 0; j < 8; ++j) { const int c0 = 4 * (lane + 64 * j); const size_t po = (size_t)row * DM + c0;
                    v[j] = *(const f32x4*)(src_ctx + po); p0[j] = *(const f32x4*)(part + po); p1[j] = *(const f32x4*)(part + (size_t)MCTX * DM + po);
                    p2[j] = *(const f32x4*)(part + (size_t)2 * MCTX * DM + po); p3[j] = *(const f32x4*)(part + (size_t)3 * MCTX * DM + po); g4[j] = *(const f32x4*)(gate_c0 + c0); }
                float s8 = 0.f;
#pragma unroll
                for (int j = 0; j < 8; ++j) { v[j] = v[j] + g4[j] * ((p0[j] + p1[j]) + (p2[j] + p3[j]));
                    s8 += (v[j][0] * v[j][0] + v[j][1] * v[j][1]) + (v[j][2] * v[j][2] + v[j][3] * v[j][3]); }
                const float ssq = wave_sum(s8);
                if (lane == 0) RS[MLAT + row] = 1.0f / sqrtf(ssq * (1.f / DM) + EPS);
                const float* scp = mods + (size_t)4 * 6144 + 2048;
                u32x2* o8 = (u32x2*)(XB + (size_t)(MLAT + row) * DM) + lane;
#pragma unroll
                for (int j = 0; j < 8; ++j) { const int c0 = 4 * (lane + 64 * j); const f32x4 w4 = *(const f32x4*)(nw + c0), sc4 = *(const f32x4*)(scp + c0); f32x4 hv;
#pragma unroll
                    for (int e = 0; e < 4; ++e) hv[e] = (v[j][e] * w4[e]) * (1.f + sc4[e]);
                    u32x2 w; w.x = pk2(hv[0], hv[1]); w.y = pk2(hv[2], hv[3]); o8[64 * j] = w; }
            }
        } else {
            const float* SS = WSP(float, WS_SS);
            for (int r = (gw >> 1) * 64 + lane; r < MLAT; r += (NGW >> 1) * 64) { f32x4 a[8];
#pragma unroll
                for (int j = 0; j < 8; ++j)
#pragma unroll
                    for (int e = 0; e < 4; ++e) a[j][e] = SS[(size_t)(4 * j + e) * MLAT + r];
                float t = 0.f;
#pragma unroll
                for (int j = 0; j < 8; ++j) t += (a[j][0] + a[j][1]) + (a[j][2] + a[j][3]);
                RS[r] = 1.0f / sqrtf(t * (1.f / DM) + EPS); }
        }
    }
}

__device__ __forceinline__ void dft_gen(Frame& F, int l, int wg, int nwg) {
    FRESH_TID(tidl_); const int tidl = tidl_;
    unsigned char* ws = F_WS;
    bf16_t* Dc = (l == 0) ? (bf16_t*)F_OUT : WSP(bf16_t, WS_WIN); bf16_t* Ds = Dc + (size_t)2048 * KFOLD;
    for (int idx = wg * 512 + tidl; idx < 2048 * (KFOLD / 8); idx += nwg * 512) { const int k = idx / (KFOLD / 8), n0 = (idx - k * (KFOLD / 8)) * 8;
        float cv[8], sv[8];
#pragma unroll
        for (int e = 0; e < 8; ++e) { const float ph = (float)((k * (n0 + e)) & 4095) * (1.f / 4096.f);
            cv[e] = __builtin_amdgcn_cosf(ph) * 0.015625f; sv[e] = -__builtin_amdgcn_sinf(ph) * 0.015625f; }
        *(u32x4*)(Dc + (size_t)k * KFOLD + n0) = pack8(cv); *(u32x4*)(Ds + (size_t)k * KFOLD + n0) = pack8(sv); }
}

__device__ __forceinline__ void phase_heads_pool(Frame& F, int l, bool inplace) {
    FRESH_TID(tidl_); const int tidl = tidl_, lane = tidl & 63;
    const int npost = (l == 0) ? 136 : 128;
    const int nshare = (F.bx < npost) ? 1 : 2, vwg0 = (F.bx < npost) ? F.bx : npost + 2 * (F.bx - npost), NVWG = npost + 2 * (F.G - npost);
    unsigned char* ws = F_WS;
    const bf16_t* P = WSP(bf16_t, WS_P); bf16_t* KH = WSP(bf16_t, WS_KH);
    const float* rope = WSP(float, WS_ROPE);
    const float* kw = F_IN(16) + (size_t)l * DQK;
    const int h = lane >> 3, sub = lane & 7;
    const float sgn = (sub & 2) ? 1.f : -1.f;
    float kwr[8];
#pragma unroll
    for (int e = 0; e < 8; ++e) kwr[e] = kw[128 + sub * 8 + e];
    const float* RHp = WSP(float, WS_RH);
    for (int rf = 0; rf < ((REP_F & 1) ? 2 : 1); ++rf)
    for (int sh = 0; sh < nshare; ++sh)
    for (int row0 = (vwg0 + sh) * NWAVES + F.wave; row0 < MT; row0 += 4 * NVWG * NWAVES) {
        u32x4 l_kr[4]; float l_rh[4]; f32x4 rt[4][4];
#pragma unroll
        for (int k = 0; k < 4; ++k) { const int row = row0 + k * NVWG * NWAVES; const int rc = row < MT ? row : row0;
            l_kr[k] = *(const u32x4*)(P + (size_t)rc * NIN + OFF_KROPE + sub * 8); l_rh[k] = RHp[(size_t)rc * 8 + h];
            const int t = rc & (SEQ - 1); const int pos = (sub < 4) ? (t >> 6) : (t & 63);
            const f32x4* rp = (const f32x4*)(rope + (size_t)(pos * 16 + (sub & 1) * 8) * 2);
#pragma unroll
            for (int q4 = 0; q4 < 4; ++q4) rt[k][q4] = rp[q4]; }
        asm volatile("" ::: "memory");
#pragma unroll
        for (int k = 0; k < 4; ++k) { const int row = row0 + k * NVWG * NWAVES;
            if (row < MT) { const bool lat = row < MLAT;
                float r8[8], y[8]; unpack8(l_kr[k], r8);
#pragma unroll
                for (int e = 0; e < 8; ++e) { const float cs = lat ? rt[k][e >> 1][2 * (e & 1)] : 1.f, sn = lat ? rt[k][e >> 1][2 * (e & 1) + 1] : 0.f;
                    const float yy = r8[e] * l_rh[k] * kwr[e]; const float pr = lane_xor<2>(yy); y[e] = yy * cs + sgn * pr * sn; }
                *(u32x4*)(KH + (size_t)row * NQ + h * DQK + 128 + sub * 8) = pack8(y); } }
    }
    {
        bf16_t* mix = WSP(bf16_t, WS_HMIX);
        const int nrows = (l == 0) ? MT : MLAT;
        for (int rf = 0; rf < ((REP_F & 2) ? 2 : 1); ++rf)
        for (int sh = 0; sh < nshare; ++sh)
        for (int idx = (vwg0 + sh) * 512 + tidl; idx < nrows * 64; idx += NVWG * 512) { const int row = idx >> 6, cc = idx & 63, g = cc >> 4;
            const int w = 2 << g, lo = w >> 1, hi = w - lo - 1;
            const bool lat = row < MLAT; const int rr = lat ? row : row - MLAT;
            const int n = lat ? SEQ : CTX, t = rr & (n - 1), base = row - t;
            const int a = (t - lo) < 0 ? 0 : (t - lo), e = (t + hi) > (n - 1) ? (n - 1) : (t + hi);
            float s[8];
#pragma unroll
            for (int q = 0; q < 8; ++q) s[q] = 0.f;
            u32x4 wv[16]; const int cnt = e - a + 1;
#pragma unroll
            for (int k = 0; k < 16; ++k) wv[k] = (k < cnt) ? *(const u32x4*)(P + (size_t)(base + a + k) * NIN + OFF_POOL + cc * 8) : (u32x4){0u, 0u, 0u, 0u};
#pragma unroll
            for (int k = 0; k < 16; ++k) { float f[8]; unpack8(wv[k], f);
#pragma unroll
                for (int q = 0; q < 8; ++q) s[q] += f[q]; }
            float self[8], gt8[8]; unpack8(*(const u32x4*)(P + (size_t)row * NIN + OFF_POOL + cc * 8), self); unpack8(*(const u32x4*)(P + (size_t)row * NIN + OFF_PGATE + cc * 8), gt8);
            const float inv = 1.f / (float)(e - a + 1);
#pragma unroll
            for (int q = 0; q < 8; ++q) s[q] = siluf(gt8[q]) * (s[q] * inv - self[q]);
            *(u32x4*)(mix + (size_t)row * DM + cc * 8) = pack8(s); }
    }
}

__global__ void __launch_bounds__(NWAVES * 64, 2) fwd_kernel(Args args) {
    extern __shared__ __attribute__((aligned(16))) unsigned char lds[];
    Frame F;
    F.lds = lds;
    const int tid0 = threadIdx.x; F.wave = __builtin_amdgcn_readfirstlane(tid0 >> 6);
    F.G = NCU; F.bx = blockIdx.x; F.vcu = (F.bx % 8) * (NCU / 8) + F.bx / 8;
    LAS unsigned char* lds3 = (LAS unsigned char*)lds; F.lds3 = lds3;
    volatile LAS unsigned* MISC = (volatile LAS unsigned*)(lds3 + MISC_OFF);
    for (int u = tid0; u < (LDS_BYTES - LDSCTL_OFF) / 4; u += NWAVES * 64) ((LAS unsigned*)(lds3 + LDSCTL_OFF))[u] = 0u;
    __syncthreads();
    unsigned char* ws = F_WS;
    unsigned* ctl = (unsigned*)(ws + WS_CTL);
    XcdBarrier bar; bar.bar = ctl + CW_BAR; bar.x = 0; bar.st = nullptr;
    const int lo = MK_ONE_LAUNCH ? 0 : args.ph_lo, hi = MK_ONE_LAUNCH ? (1 + 6 * NL) : args.ph_hi;
    const bool multi = (hi - lo) > 1;
    if (multi) bar = xcd_barrier_post(ctl + CW_BAR, MISC + 8, tid0);
#ifndef PHM
#define PHM 0xff
#endif
#ifndef REP_MASK
#define REP_MASK 0
#endif
#define NREP(bit) ((REP_MASK & (bit)) ? 2 : 1)

    for (int ph = lo; ph < hi; ++ph) {
        const int l = (ph > 6) ? 1 : 0, kind = (ph == 0) ? 0 : ph - 6 * l;
        unsigned char* ws = F_WS;
        if ((PHM & 1) && kind == 0) { for (int rep = 0; rep < NREP(1); ++rep) { phase_prep(F, 0, F.vcu, F.G); __syncthreads(); } }
        if ((PHM & 2) && kind == 1) for (int rep = 0; rep < NREP(2); ++rep) phase_norm(F, l);
        if ((PHM & 4) && kind == 2) for (int rep = 0; rep < NREP(4); ++rep) {
            pg8::Gemm g{l == 0 ? WSP(bf16_t, WS_HMIX) : WSP(bf16_t, WS_KV), WSP(bf16_t, WS_WIN) + (size_t)l * NIN * DM, DM, DM, DM, 1 << 20, 0};
            pg8::StaticOrder S; S.init(MT / 256, NIN / 256, F.G, F.bx);
            pg8::Epi E{}; E.kind = 0; E.O = WSP(bf16_t, WS_P); E.ldc = NIN; E.rowoff = 0; E.cmul = 256; E.cadd = 0; E.csplit = 1 << 20; E.cadd2 = 0;
            E.xt_lat = WSP(bf16_t, WS_XTC); E.xt_ctx = WSP(bf16_t, WS_XTCC);
            if (l != 0) { E.rs = WSP(float, WS_RS); E.bias = WSP(float, WS_BIAS); }
            E.sqo = WSP(float, WS_SQ);
            for (int rc = 0; rc < ((REP_P & 16) ? 2 : 1); ++rc)
            pg8::gemm_phase<pg8::Epi, pg8::StaticOrder, true, true>(lds3, g, S, E, F.wave);
            { const int nfull = (MT / 256) * (NIN / 256) % F.G; const bool sub = nfull > 0 && nfull < F.G;
              if (!sub || F.bx >= nfull) { const int wgi = sub ? F.bx - nfull : F.bx, nwgi = sub ? F.G - nfull : F.G;
                  dft_gen(F, l, wgi, nwgi); __syncthreads(); phase_prep(F, l == 0 ? 1 : 2, wgi, nwgi); } }
        }
        if ((PHM & 16) && kind == 3) for (int rep = 0; rep < NREP(16); ++rep) {
            constexpr int split = 72;
            const int nrest = F.G - split;
            constexpr int NFOLD = 112;
            const int fidx = (F.bx < split) ? F.bx : (F.bx >= F.G - 40 ? split + (F.bx - (F.G - 40)) : -1);
            if (rep == 0 && fidx >= 0) {
                FRESH_TID(tz_); const int lz = tz_ & 63; const int gwz = fidx * NWAVES + F.wave, NGWZ = NFOLD * NWAVES;
                bf16_t* XC = WSP(bf16_t, WS_XTC); bf16_t* PC = WSP(bf16_t, WS_PCS) + (size_t)2048 * PCSW;
                for (int r = gwz; r < 1040 + 1024; r += NGWZ) {
                    const bool cosr = r < 1040;
                    bf16_t* xr = XC + (size_t)(cosr ? r : r + 240) * DPITCH;
                    u32x4 lo[4], hi[4]; unsigned short f0[4];
#pragma unroll
                    for (int i = 0; i < 4; ++i) { const int c = i * 64 + lz;
                        lo[i] = *(const u32x4*)(xr + 8 * c); hi[i] = *(const u32x4*)(xr + 8 * (511 - c)); f0[i] = *(const unsigned short*)(xr + 4096 - 8 * c); }
                    asm volatile("s_waitcnt vmcnt(0)" ::: "memory");
                    float a = 0.f; const float sg = cosr ? 1.f : -1.f;
#pragma unroll
                    for (int i = 0; i < 4; ++i) { const int c = i * 64 + lz;
                        float L[8], H[8], f[8]; unpack8(lo[i], L); unpack8(hi[i], H);
                        f[0] = (c == 0) ? L[0] : L[0] + sg * bf2f(f0[i]);
#pragma unroll
                        for (int q = 1; q < 8; ++q) f[q] = L[q] + sg * H[8 - q];
                        a += ((f[0] - f[1]) + (f[2] - f[3])) + ((f[4] - f[5]) + (f[6] - f[7]));
                        st16_wt(xr + 8 * c, pack8(f)); }
                    unsigned zz = 0u; asm volatile("" : "+v"(zz));
                    if (lz == 63) { a += bf2f((unsigned short)(hi[3].x & 0xffffu)); u32x4 z; z.x = hi[3].x & 0xffffu; z.y = zz; z.z = zz; z.w = zz; st16_wt(xr + 2048, z); }
                    if (lz < 15) { u32x4 z; z.x = zz; z.y = zz; z.z = zz; z.w = zz; st16_wt(xr + 2056 + 8 * lz, z); }
                    a = wave_sum(a) * 0.015625f;
                    if (cosr) { const int col = (r < 1024) ? ((r >> 8) * 512 + (r & 255)) : (2048 + (r - 1024)); if (lz == 0) PC[col] = (bf16_t)f2bf(a); }
                    else { const int q = r - 1040; if (lz == 0) PC[(q >> 8) * 512 + 256 + (q & 255)] = 0; }
                }
                asm volatile("s_waitcnt vmcnt(0)" ::: "memory");
                __syncthreads();
                if (tz_ == 0) (void)xb_add(WSP(unsigned, WS_CTL) + CW_FOLD + 64 * l, 1u);
            }
            for (int jj = 0; jj < 7; ++jj) { const int job = (jj == 0) ? 5 : (jj < 6 ? jj - 1 : 6);
                pg8::Gemm g{}; pg8::RangeOrder S; pg8::Epi E{}; E.kind = 0; E.rowoff = 0; E.cmul = 256; E.cadd = 0; E.csplit = 1 << 20; E.cadd2 = 0; E.xt_lat = nullptr; E.xt_ctx = nullptr; E.mirror = 0;
                if (job == 0) {
                    if (F.bx < split) {
                        FRESH_TID(tw_);
                        if (tw_ == 0) { unsigned* cw = WSP(unsigned, WS_CTL); XB_SPIN(xb_ld(cw + CW_FOLD + 64 * l) < (unsigned)NFOLD, cw + CW_BAR); __builtin_amdgcn_fence(__ATOMIC_ACQUIRE, "agent"); asm volatile("s_waitcnt vmcnt(0)" ::: "memory"); }
                        __syncthreads(); }
                    g = pg8::Gemm{(l == 0) ? (const bf16_t*)F_OUT : WSP(bf16_t, WS_WIN), WSP(bf16_t, WS_XTC), KFOLD, DPITCH, KFOLD, 1 << 20, 0};
                    S.init(8, 5, 40, F.bx);
                    E.O = WSP(bf16_t, WS_PCS); E.ldc = PCSW; E.cmul = 512; E.csplit = 4; E.cadd2 = 2048; E.mirror = 1;
                } else if (job == 1) {
                    g = pg8::Gemm{((l == 0) ? (const bf16_t*)F_OUT : WSP(bf16_t, WS_WIN)) + (size_t)2048 * KFOLD, WSP(bf16_t, WS_XTS), KFOLD, DPITCH, KFOLD, 1 << 20, 0};
                    S.init(8, 4, 32, F.bx - 40);
                    E.O = WSP(bf16_t, WS_PCS); E.ldc = PCSW; E.cmul = 512; E.cadd = 256; E.mirror = -1;
                } else if (job == 2) {
                    if (l != 0) continue;
                    g = pg8::Gemm{WSP(bf16_t, WS_DCTX), WSP(bf16_t, WS_XTCC), 256, 256, 256, 1 << 20, 0};
                    S.init(1, 5, 5, F.bx - split - 144);
                    E.O = WSP(bf16_t, WS_PCSC); E.ldc = PCSW; E.cmul = 512; E.csplit = 4; E.cadd2 = 2048;
                } else if (job == 3) {
                    if (l != 0) continue;
                    g = pg8::Gemm{WSP(bf16_t, WS_DCTX) + 65536, WSP(bf16_t, WS_XTSC), 256, 256, 256, 1 << 20, 0};
                    S.init(1, 4, 4, F.bx - split - 149);
                    E.O = WSP(bf16_t, WS_PCSC); E.ldc = PCSW; E.cmul = 512; E.cadd = 256;
                } else if (job == 4) {
                    g = pg8::Gemm{WSP(bf16_t, WS_P) + OFF_CQ, WSP(bf16_t, WS_WUQ) + (size_t)l * NQ * 512, NIN, 512, 512, 1 << 20, 0};
                    S.init(l == 0 ? MT / 256 : MLAT / 256, NQ / 256, nrest, F.bx - split);
                    E.O = WSP(bf16_t, WS_Q); E.ldc = NQ; E.sq8 = WSP(float, WS_SQ);
                } else {
                    g = pg8::Gemm{WSP(bf16_t, WS_P) + OFF_CKV, WSP(bf16_t, WS_WUKV) + (size_t)l * NKV * 512, NIN, 512, 512, 1 << 20, 0};
                    if (job == 5) S.init_range(MT / 256, NKV / 256, 0, split, split, F.bx);
                    else S.init_range(MT / 256, NKV / 256, split, (MT / 256) * (NKV / 256), nrest, F.bx >= split ? (F.bx - split + 144) % nrest : -1);
                    E.O = (l == 0) ? WSP(bf16_t, WS_KV) : (bf16_t*)F_OUT; E.ldc = NKV; E.sq8 = WSP(float, WS_SQ) + (size_t)8 * MT;
                    E.kind = 4; E.kr2 = WSP(float, WS_SQ) + (size_t)16 * MT; E.kh = WSP(bf16_t, WS_KH); E.rh = WSP(float, WS_RH); E.kw = F_IN(16) + (size_t)l * DQK; E.qwk = F_IN(15) + (size_t)l * DQK;
                    E.part = (LAS float*)(lds3 + 132096);
                }
                if (job >= 5) { pg8::Epi4 E4{E}; pg8::gemm_phase<pg8::Epi4, pg8::RangeOrder, true, true>(lds3, g, S, E4, F.wave); }
                else
                for (int rj = 0; rj < (((REP_EJ >> job) & 1) ? 2 : 1); ++rj)
                pg8::gemm_phase<pg8::Epi, pg8::RangeOrder, true, true>(lds3, g, S, E, F.wave);
            }
        }
        if ((PHM & 32) && kind == 4) for (int rep = 0; rep < NREP(32); ++rep) {
            phase_heads_pool(F, l, rep == 0);
            __syncthreads();
            for (int job = 0; job < 2; ++job) {
                if (job == 1 && l != 0) continue;
                pg8::Gemm g{}; pg8::RangeOrder S; pg8::Epi E{}; E.kind = 1; E.O = WSP(bf16_t, WS_HMIX); E.ldc = DM; E.P = WSP(bf16_t, WS_P);
                E.fw = F_IN(10) + (size_t)l * 4 * 128 * 128;
                if (job == 0) { g = pg8::Gemm{WSP(bf16_t, WS_PCS), WSP(bf16_t, WS_FWAB) + (size_t)l * 512 * 512, PCSW, 512, 512, 16, 512};
                    S.init(64, 2, F.G, F.bx); E.rowoff = 0; E.NY = WSP(bf16_t, WS_PCS); E.nseq = SEQ; E.lgseq = 12; }
                else { g = pg8::Gemm{WSP(bf16_t, WS_PCSC), WSP(bf16_t, WS_FWAB) + (size_t)l * 512 * 512, PCSW, 512, 512, 1, 512};
                    S.init_range(4, 2, 0, 8, 8, F.bx - 128); E.rowoff = MLAT; E.NY = WSP(bf16_t, WS_PCSC); E.nseq = CTX; E.lgseq = 8; }
                for (int rf = 0; rf < ((REP_F & 4) ? 2 : 1); ++rf)
                pg8::gemm_phase<pg8::Epi, pg8::RangeOrder, true, true>(lds3, g, S, E, F.wave);
            }
        }
        if ((PHM & 64) && kind == 5) for (int rep = 0; rep < NREP(64); ++rep) {
            const bf16_t* Qg = WSP(bf16_t, WS_Q); const bf16_t* KHg = WSP(bf16_t, WS_KH); const bf16_t* KVg = (l == 0) ? WSP(bf16_t, WS_KV) : (const bf16_t*)F_OUT; const bf16_t* Pg = WSP(bf16_t, WS_P); bf16_t* mix = WSP(bf16_t, WS_HMIX);
            const float* qhw = F_IN(15) + (size_t)l * DQK; const float* ropet = WSP(float, WS_ROPE);
            const float negMC = __builtin_bit_cast(float, __builtin_amdgcn_readfirstlane(__builtin_bit_cast(int, WSP(float, WS_SMB)[l])));
            for (int u = F.vcu; u < NB * NH * 16; u += F.G) {
                const int bh = u >> 4, qb = u & 15, b = bh >> 3, h = bh & 7;
                att::attn_unit(Qg, KHg, KVg, Pg, mix, qhw, ropet, h, b * SEQ + qb * 256, MLAT + b * CTX, b * SEQ, 4, 68, negMC, (char*)lds, F.wave);
            }
            if (l == 0) for (int u = F.vcu; u < NB * NH; u += F.G) {
                const int b = u >> 3, h = u & 7;
                att::attn_unit(Qg, KHg, KVg, Pg, mix, qhw, ropet, h, MLAT + b * CTX, MLAT + b * CTX, 0, 4, 4, negMC, (char*)lds, F.wave);
            }
        }
        if ((PHM & 128) && kind == 6) for (int rep = 0; rep < (l == 0 ? NREP(128) : 1); ++rep) {
            if (l == 0) for (int kq = 0; kq < 4; ++kq) {
                pg8::Gemm g{WSP(bf16_t, WS_HMIX) + (size_t)MLAT * DM + kq * 512, WSP(bf16_t, WS_WOUT) + kq * 512, DM, DM, 512, 1 << 20, 0};
                pg8::RangeOrder S; if (F.G >= 128) S.init(MCTX / 256, DM / 256, 32, F.bx - kq * 32); else S.init(MCTX / 256, DM / 256, F.G, F.bx);
                pg8::Epi E{}; E.kind = 3; E.out_ctx = WSP(float, WS_Q) + (size_t)kq * MCTX * DM;
                pg8::gemm_phase<pg8::Epi, pg8::RangeOrder, true, true>(lds3, g, S, E, F.wave);
            }
            { pg8::Gemm g{WSP(bf16_t, WS_HMIX), WSP(bf16_t, WS_WOUT) + (size_t)l * DM * DM, DM, DM, DM, 1 << 20, 0};
              pg8::StaticOrder S; S.init(MLAT / 256, DM / 256, F.G, F.bx);
              pg8::Epi E{}; E.kind = 2; E.mods = WSP(float, WS_MODS) + (size_t)l * 5 * 6144;
              E.xin_lat = (l == 0) ? F_IN(0) : (const float*)F_OUT; E.xin_ctx = nullptr; E.out_lat = F_OUT; E.out_ctx = nullptr;
              E.nw1 = F_IN(4) + DM; E.sc1 = WSP(float, WS_MODS) + (size_t)5 * 6144 + 2048;
              if (l == 0) { E.xb = WSP(bf16_t, WS_KV); E.ss = WSP(float, WS_SS); } else E.xbr = WSP(bf16_t, WS_KV);
              pg8::gemm_phase<pg8::Epi, pg8::StaticOrder, true, true>(lds3, g, S, E, F.wave); }
        }
        if (ph + 1 < hi) { FRESH_TID(tb_); xcd_barrier(bar, tb_); }
    }
}

constexpr int N_PHASES = 1 + 6 * NL;
extern "C" void kernel_launch(void* const* d_in, const int* in_sizes, int n_in, void* d_out, int out_size, void* d_ws, size_t ws_size, hipStream_t stream) {
    static int grid = 0;
    if (grid == 0) {
        if (n_in != 18 || out_size != MLAT * DM || ws_size < WS_END) { fprintf(stderr, "kernel_launch: unexpected shapes (n_in %d out %d ws %zu need %zu)\n", n_in, out_size, ws_size, (size_t)WS_END); grid = -1; return; }
        int dev = 0, cus = 0;
        if (hipGetDevice(&dev) != hipSuccess || hipDeviceGetAttribute(&cus, hipDeviceAttributeMultiprocessorCount, dev) != hipSuccess) { grid = -1; return; }
        if (hipFuncSetAttribute((const void*)fwd_kernel, hipFuncAttributeMaxDynamicSharedMemorySize, LDS_BYTES) != hipSuccess) { fprintf(stderr, "kernel_launch: hipFuncSetAttribute failed\n"); grid = -1; return; }
        if (cus != NCU) fprintf(stderr, "kernel_launch: built for %d CUs, device reports %d\n", NCU, cus);
        grid = NCU;
    }
    if (grid < 0) return;
    (void)hipMemsetAsync((char*)d_ws + WS_CTL, 0, 65536, stream);
    Args a{};
    for (int i = 0; i < 18; ++i) a.in[i] = d_in[i];
    a.out = (float*)d_out; a.ws = (unsigned char*)d_ws;
#if MK_ONE_LAUNCH
    a.ph_lo = 0; a.ph_hi = N_PHASES;
    hipLaunchKernelGGL(fwd_kernel, dim3(grid), dim3(NWAVES * 64), LDS_BYTES, stream, a);
#else
    for (int p = 0; p < N_PHASES; ++p) { a.ph_lo = p; a.ph_hi = p + 1; hipLaunchKernelGGL(fwd_kernel, dim3(grid), dim3(NWAVES * 64), LDS_BYTES, stream, a); }
#endif
}
```
